# Optimizing an MI355X kernel written in HIP

```python
import jax, jax.numpy as jnp
from jax import lax
import numpy as np

D_MODEL = 1024
BATCH = 8
SEQ = 8192
DEPTH = 4

CTX_LEN = 256
GRID_W = 64
D_MIX = D_MODEL
MLA_HEADS = 8
MLA_NOPE = 64
MLA_ROPE = 32
MLA_V = 64
MLA_Q_RANK = 384
MLA_KV_RANK = 256
MLA_OUT = MLA_HEADS * MLA_V
ATTN_SCALE = (MLA_NOPE + MLA_ROPE) ** -0.5
Q_BLOCK = 128
ROPE_BASE = 10000.0
CONV_CH = 256
CONV_WIDTH = 31
SGU_HEADS = 4
SGU_HEAD_DIM = 64
SGU_CH = SGU_HEADS * SGU_HEAD_DIM
CHUNK = 128
D_FF = 4 * D_MODEL
EPS = 1e-6
IN_Q = MLA_Q_RANK
IN_KV = MLA_KV_RANK
IN_KR = MLA_ROPE
IN_CONV = 2 * CONV_CH
IN_SGU = 2 * SGU_CH
D_IN = IN_Q + IN_KV + IN_KR + IN_CONV + IN_SGU
IN_SPLITS = (IN_Q, IN_Q + IN_KV, IN_Q + IN_KV + IN_KR, IN_Q + IN_KV + IN_KR + IN_CONV)

kernel_name = "hybrid_mla_conv_sgu_dit_block"


def rmsnorm(x, g):
    xf = x.astype(jnp.float32)
    y = xf * lax.rsqrt(jnp.mean(xf * xf, -1, keepdims=True) + EPS)
    return (y * g.astype(jnp.float32)).astype(x.dtype)


def layernorm(x, g, b):
    xf = x.astype(jnp.float32)
    mu = jnp.mean(xf, -1, keepdims=True)
    var = jnp.mean(jnp.square(xf - mu), -1, keepdims=True)
    y = (xf - mu) * lax.rsqrt(var + EPS) * g.astype(jnp.float32) + b.astype(jnp.float32)
    return y.astype(x.dtype)


def modulate(h, shift, scale):
    return h * (1 + scale) + shift


def _rot(x, pos):
    n = x.shape[-1] // 2
    inv = 1.0 / (ROPE_BASE ** (jnp.arange(n, dtype=jnp.float32) / n))
    ang = pos.astype(jnp.float32)[:, None] * inv
    cos = jnp.cos(ang)[:, None, :]
    sin = jnp.sin(ang)[:, None, :]
    x1, x2 = x[..., :n], x[..., n:]
    return jnp.concatenate([x1 * cos - x2 * sin, x2 * cos + x1 * sin], -1).astype(x.dtype)


def rope_2d(x, row, col):
    h = x.shape[-1] // 2
    return jnp.concatenate([_rot(x[..., :h], row), _rot(x[..., h:], col)], -1)


def mla_q(z_q, qn_g, w_uq, row, col):
    b, l, _ = z_q.shape
    q = (rmsnorm(z_q, qn_g) @ w_uq).reshape(b, l, MLA_HEADS, MLA_NOPE + MLA_ROPE)
    q_nope, q_rope = q[..., :MLA_NOPE], q[..., MLA_NOPE:]
    if row is not None:
        q_rope = rope_2d(q_rope, row, col)
    return jnp.concatenate([q_nope, q_rope], -1)


def mla_kv(z_kv, z_kr, kvn_g, w_ukv, row, col):
    b, l, _ = z_kv.shape
    kv = (rmsnorm(z_kv, kvn_g) @ w_ukv).reshape(b, l, MLA_HEADS, MLA_NOPE + MLA_V)
    k_nope, v = kv[..., :MLA_NOPE], kv[..., MLA_NOPE:]
    k_rope = z_kr[:, :, None, :]
    if row is not None:
        k_rope = rope_2d(k_rope, row, col)
    k_rope = jnp.broadcast_to(k_rope, (b, l, MLA_HEADS, MLA_ROPE))
    return jnp.concatenate([k_nope, k_rope], -1), v


def attend(q, k, v):
    s = jnp.einsum('bqhd,bkhd->bhqk', q, k).astype(jnp.float32) * ATTN_SCALE
    p = jax.nn.softmax(s, axis=-1).astype(v.dtype)
    return jnp.einsum('bhqk,bkhd->bqhd', p, v)


def attend_blocked(q, k, v):
    b, l, h, dq = q.shape
    qb = q.reshape(b, l // Q_BLOCK, Q_BLOCK, h, dq).transpose(1, 0, 2, 3, 4)
    out = lax.map(lambda qi: attend(qi, k, v), qb)
    return out.transpose(1, 0, 2, 3, 4).reshape(b, l, h * v.shape[-1])


def conv_module(z, w, b, ln_g, ln_b):
    a, gate = jnp.split(z, 2, axis=-1)
    y = a * jax.nn.sigmoid(gate)
    y = lax.conv_general_dilated(
        y, w[:, None, :].astype(y.dtype), window_strides=(1,), padding='SAME',
        dimension_numbers=('NWC', 'WIO', 'NWC'), feature_group_count=CONV_CH) + b
    return jax.nn.silu(layernorm(y, ln_g, ln_b))


def sgu_module(z, ln_g, ln_b, w_s, b_s):
    z = jax.nn.gelu(z)
    u, v = jnp.split(z, 2, axis=-1)
    v = layernorm(v, ln_g, ln_b)
    bsz, l, _ = v.shape
    v = v.reshape(bsz, l // CHUNK, CHUNK, SGU_HEADS, SGU_HEAD_DIM)
    mixed = jnp.einsum('hpq,bnqhd->bnphd', w_s, v) + b_s.T[None, None, :, :, None]
    return u * mixed.reshape(bsz, l, SGU_CH)


def sq_relu_mlp(h, w1, w2):
    return jnp.square(jax.nn.relu(h @ w1)) @ w2


def setup_inputs(seed: int = 0) -> dict:
    key = jax.random.key(seed)
    ks = jax.random.split(key, 32)
    f32 = jnp.float32
    L = DEPTH

    def nrm(k, shape, scale):
        return jax.random.normal(k, shape, f32) * scale

    def gain(k, shape):
        return 1.0 + 0.05 * jax.random.normal(k, shape, f32)

    return {
        "x": nrm(ks[0], (BATCH, SEQ, D_MODEL), 1.0),
        "c": nrm(ks[1], (BATCH, D_MODEL), 1.0),
        "ctx": nrm(ks[2], (BATCH, CTX_LEN, D_MODEL), 1.0),
        "c_ctx": nrm(ks[3], (D_MODEL,), 1.0),
        "ada_w": nrm(ks[4], (L, D_MODEL, 6 * D_MODEL), 0.5 * D_MODEL ** -0.5),
        "ada_b": nrm(ks[5], (L, 6 * D_MODEL), 0.02),
        "norm1_g": gain(ks[6], (L, D_MODEL)),
        "norm2_g": gain(ks[7], (L, D_MODEL)),
        "w_in": nrm(ks[8], (L, D_MODEL, D_IN), D_MODEL ** -0.5),
        "q_norm_g": gain(ks[9], (L, MLA_Q_RANK)),
        "w_uq": nrm(ks[10], (L, MLA_Q_RANK, MLA_HEADS * (MLA_NOPE + MLA_ROPE)), MLA_Q_RANK ** -0.5),
        "kv_norm_g": gain(ks[11], (L, MLA_KV_RANK)),
        "w_ukv": nrm(ks[12], (L, MLA_KV_RANK, MLA_HEADS * (MLA_NOPE + MLA_V)), MLA_KV_RANK ** -0.5),
        "conv_w": nrm(ks[13], (L, CONV_WIDTH, CONV_CH), CONV_WIDTH ** -0.5),
        "conv_b": nrm(ks[14], (L, CONV_CH), 0.02),
        "conv_ln_g": gain(ks[15], (L, CONV_CH)),
        "conv_ln_b": nrm(ks[16], (L, CONV_CH), 0.02),
        "sgu_ln_g": gain(ks[17], (L, SGU_CH)),
        "sgu_ln_b": nrm(ks[18], (L, SGU_CH), 0.02),
        "sgu_w": nrm(ks[19], (L, SGU_HEADS, CHUNK, CHUNK), CHUNK ** -0.5),
        "sgu_b": gain(ks[20], (L, SGU_HEADS, CHUNK)),
        "w_out": nrm(ks[21], (L, D_MIX, D_MODEL), D_MIX ** -0.5),
        "w_ff1": nrm(ks[22], (L, D_MODEL, D_FF), D_MODEL ** -0.5),
        "w_ff2": nrm(ks[23], (L, D_FF, D_MODEL), D_FF ** -0.5),
        "final_g": gain(ks[24], (D_MODEL,)),
    }


def reference(x, c, ctx, c_ctx, ada_w, ada_b, norm1_g, norm2_g, w_in, q_norm_g, w_uq,
              kv_norm_g, w_ukv, conv_w, conv_b, conv_ln_g, conv_ln_b, sgu_ln_g, sgu_ln_b,
              sgu_w, sgu_b, w_out, w_ff1, w_ff2, final_g):
    bsz, seq, _ = x.shape
    n_ctx = ctx.shape[1]
    rows = seq // GRID_W
    row = jnp.repeat(jnp.arange(rows, dtype=jnp.int32), GRID_W)
    col = jnp.tile(jnp.arange(GRID_W, dtype=jnp.int32), rows)
    s_lat = jax.nn.silu(c)
    s_ctx = jax.nn.silu(c_ctx)
    cx = ctx
    for l in range(DEPTH):
        last = l == DEPTH - 1
        m_x = (s_lat @ ada_w[l] + ada_b[l])[:, None, :]
        m_c = s_ctx @ ada_w[l] + ada_b[l]
        sh1, sc1, g1, sh2, sc2, g2 = jnp.split(m_x, 6, axis=-1)
        csh1, csc1, cg1, csh2, csc2, cg2 = jnp.split(m_c, 6, axis=-1)

        zx = modulate(rmsnorm(x, norm1_g[l]), sh1, sc1) @ w_in[l]
        zc = modulate(rmsnorm(cx, norm1_g[l]), csh1, csc1) @ w_in[l]
        xq, xkv, xkr, xconv, xsgu = jnp.split(zx, IN_SPLITS, axis=-1)
        cq, ckv, ckr, cconv, csgu = jnp.split(zc, IN_SPLITS, axis=-1)

        q_x = mla_q(xq, q_norm_g[l], w_uq[l], row, col)
        k_x, v_x = mla_kv(xkv, xkr, kv_norm_g[l], w_ukv[l], row, col)
        k_c, v_c = mla_kv(ckv, ckr, kv_norm_g[l], w_ukv[l], None, None)
        a_x = attend_blocked(q_x, jnp.concatenate([k_c, k_x], 1), jnp.concatenate([v_c, v_x], 1))
        y_x = jnp.concatenate([
            a_x,
            conv_module(xconv, conv_w[l], conv_b[l], conv_ln_g[l], conv_ln_b[l]),
            sgu_module(xsgu, sgu_ln_g[l], sgu_ln_b[l], sgu_w[l], sgu_b[l]),
        ], axis=-1) @ w_out[l]
        x = x + g1 * y_x

        if not last:
            q_c = mla_q(cq, q_norm_g[l], w_uq[l], None, None)
            a_c = attend(q_c, k_c, v_c).reshape(bsz, n_ctx, MLA_OUT)
            y_c = jnp.concatenate([
                a_c,
                conv_module(cconv, conv_w[l], conv_b[l], conv_ln_g[l], conv_ln_b[l]),
                sgu_module(csgu, sgu_ln_g[l], sgu_ln_b[l], sgu_w[l], sgu_b[l]),
            ], axis=-1) @ w_out[l]
            cx = cx + cg1 * y_c

        x = x + g2 * sq_relu_mlp(modulate(rmsnorm(x, norm2_g[l]), sh2, sc2), w_ff1[l], w_ff2[l])
        if not last:
            cx = cx + cg2 * sq_relu_mlp(modulate(rmsnorm(cx, norm2_g[l]), csh2, csc2), w_ff1[l], w_ff2[l])

    return rmsnorm(x, final_g)
```

```cpp
#include <hip/hip_runtime.h>
#include <hip/hip_bf16.h>
#include <hip/hip_cooperative_groups.h>
#include <cstdio>
#include <cstdint>
namespace cg = cooperative_groups;
#ifndef PHM
#define PHM 0xffff
#endif
#ifndef DUPM
#define DUPM 0
#endif
#define REPS(bit) for (int rep_ = 0, nrep_ = nrep_of((DUPM & (bit)) ? 2 : 1); rep_ < nrep_; ++rep_)
#ifndef ONE_LAUNCH
#define ONE_LAUNCH 1
#endif
typedef unsigned short bf16_t;
__device__ __forceinline__ float shx(float v, int o, int lane) { return __int_as_float(__builtin_amdgcn_ds_bpermute((lane ^ o) << 2, __float_as_int(v))); }
constexpr int T_LAT = 65536, ZP = 1792, LK = 8448;
namespace pg8 {
#define PG8_LAS __attribute__((address_space(3)))
typedef unsigned short bf16_t;
typedef short bf16x8 __attribute__((ext_vector_type(8)));
typedef float f32x4 __attribute__((ext_vector_type(4)));
typedef unsigned u32x4 __attribute__((ext_vector_type(4)));
constexpr int BM = 256, BK = 64, HALF = 128, HTB = HALF * BK * 2  , STAGE_BYTES = 8 * HTB, NXCD = 8, WGM = 8;

__host__ __device__ __forceinline__ int lds_byte(int r, int c) { const int st = (r >> 4) * 2 + (c >> 5), rr = r & 15, cc = c & 31, ob = rr * 64 + cc * 2; return st * 1024 + (ob ^ (((ob >> 9) & 1) << 5)); }
__host__ __device__ __forceinline__ void stage_rc(int b, int& R, int& C) { const int st = b / 1024, sb = b % 1024, swz = sb ^ (((sb >> 9) & 1) << 5); R = (st >> 1) * 16 + swz / 64; C = (st & 1) * 32 + (swz % 64) / 2; }
__host__ __device__ __forceinline__ int perm32(int rho) { const int n = rho >> 4, i = rho & 15; return 8 * (i >> 2) + 4 * n + (i & 3); }

struct Unit { int pm, pn; };
struct Gemm { const bf16_t* A; const bf16_t* Bt; int M, N, K, lda; };

struct StaticOrder {
    int nM, nN, nwg, G, c;
    __host__ __device__ void init(int M, int N, int G_, int c_) { nM = M / BM; nN = N / BM; nwg = nM * nN; G = G_; c = c_; }
    __host__ __device__ bool next(int i, Unit& u) const {
        const long L = (long)i * G + c; if (L >= nwg) return false;
        int wgid = (int)L; { const int q = nwg / NXCD, r = nwg % NXCD, xcd = wgid % NXCD, off = wgid / NXCD; wgid = (xcd < r ? xcd * (q + 1) : r * (q + 1) + (xcd - r) * q) + off; }
        const int nig = WGM * nN, gid = wgid / nig, fm = gid * WGM, gsz = (nM - fm) < WGM ? (nM - fm) : WGM;
        u.pm = fm + ((wgid % nig) % gsz); u.pn = (wgid % nig) / gsz; return true;
    }
    __device__ __forceinline__ void a_ready(const Unit&) const {}
    __device__ __forceinline__ void done(const Unit&) const {}
};

struct OneUnit {
    int pm, pn; bool valid;
    __device__ __forceinline__ bool next(int i, Unit& u) const { if (i != 0 || !valid) return false; u.pm = pm; u.pn = pn; return true; }
    __device__ __forceinline__ void a_ready(const Unit&) const {}
    __device__ __forceinline__ void done(const Unit&) const {}
};
struct CountingOrder {
    StaticOrder S; unsigned* cnt;
    __device__ __forceinline__ bool next(int i, Unit& u) const { return S.next(i, u); }
    __device__ __forceinline__ void a_ready(const Unit&) const {}
    __device__ __forceinline__ void done(const Unit&) const {
        __builtin_amdgcn_fence(__ATOMIC_RELEASE, "agent"); asm volatile("s_waitcnt vmcnt(0)" ::: "memory");
        int ln_; asm volatile("v_mbcnt_lo_u32_b32 %0, -1, 0\n\tv_mbcnt_hi_u32_b32 %0, -1, %0" : "=&v"(ln_));
        if (ln_ == 0) __hip_atomic_fetch_add(cnt, 1u, __ATOMIC_RELAXED, __HIP_MEMORY_SCOPE_AGENT);
    }
};
__device__ __forceinline__ unsigned cvt_pk_bf16(float lo, float hi) { unsigned r; asm volatile("v_cvt_pk_bf16_f32 %0, %1, %2" : "=v"(r) : "v"(lo), "v"(hi)); return r; }
__device__ __forceinline__ u32x4 pack8(f32x4 v0, f32x4 v1) { u32x4 w; w.x = cvt_pk_bf16(v0[0], v0[1]); w.y = cvt_pk_bf16(v0[2], v0[3]); w.z = cvt_pk_bf16(v1[0], v1[1]); w.w = cvt_pk_bf16(v1[2], v1[3]); return w; }

__device__ __forceinline__ float sum_fq(float s) {
    { auto r = __builtin_amdgcn_permlane16_swap(__float_as_uint(s), __float_as_uint(s), false, false); s = __uint_as_float(r[0]) + __uint_as_float(r[1]); }
    { auto r = __builtin_amdgcn_permlane32_swap(__float_as_uint(s), __float_as_uint(s), false, false); s = __uint_as_float(r[0]) + __uint_as_float(r[1]); }
    return s;
}
__device__ __forceinline__ float row_rstd16_q(const float* ssqx, int row, int fq) {
    const f32x4 s0 = *(const f32x4*)(ssqx + (size_t)row * 16 + 4 * fq); float s = (s0[0] + s0[1]) + (s0[2] + s0[3]);
    { auto r = __builtin_amdgcn_permlane16_swap(__float_as_uint(s), __float_as_uint(s), false, false); s = __uint_as_float(r[0]) + __uint_as_float(r[1]); }
    { auto r = __builtin_amdgcn_permlane32_swap(__float_as_uint(s), __float_as_uint(s), false, false); s = __uint_as_float(r[0]) + __uint_as_float(r[1]); }
    return rsqrtf(s * (1.0f / 1024.0f) + 1e-6f);
}
__device__ __forceinline__ float row_rstd16(const float* ssqx, int row) {
    const f32x4* sp = (const f32x4*)(ssqx + (size_t)row * 16); const f32x4 s0 = sp[0], s1 = sp[1], s2 = sp[2], s3 = sp[3];
    const float ss = (((s0[0] + s0[1]) + (s0[2] + s0[3])) + ((s1[0] + s1[1]) + (s1[2] + s1[3]))) + (((s2[0] + s2[1]) + (s2[2] + s2[3])) + ((s3[0] + s3[1]) + (s3[2] + s3[3])));
    return rsqrtf(ss * (1.0f / 1024.0f) + 1e-6f);
}
struct EpiZ {
    static constexpr bool PERM = true, AFTER_DRAIN = false, PREFETCH = false;
    bf16_t* Z; float* ssq; const float* ssqx; const float* shw;
    __device__ __forceinline__ void operator()(const f32x4 (&acc)[2][2][4][2], const Unit& u, int wr, int wc, int fr, int fq) const {
        const int row0 = u.pm * BM + wr * 64 + fr, col0 = u.pn * BM + wc * 32 + 8 * fq;
        const int mi = (u.pm * BM >= T_LAT) ? 8 : ((u.pm * BM) >> 13);
        float rs[2][4];
#pragma unroll
        for (int ai = 0; ai < 2; ++ai) {
#pragma unroll
            for (int m = 0; m < 4; ++m) { rs[ai][m] = row_rstd16_q(ssqx, row0 + ai * HALF + m * 16, fq); if (m & 1) asm volatile("" : "+v"(rs[ai][m - 1]), "+v"(rs[ai][m]) :: "memory"); } }
        f32x4 sw[2][2];
#pragma unroll
        for (int bj = 0; bj < 2; ++bj) { sw[bj][0] = *(const f32x4*)(shw + mi * 1792 + col0 + bj * HALF); sw[bj][1] = *(const f32x4*)(shw + mi * 1792 + col0 + bj * HALF + 4); }
#pragma unroll
        for (int ai = 0; ai < 2; ++ai)
#pragma unroll
            for (int m = 0; m < 4; ++m) { const int row = row0 + ai * HALF + m * 16; bf16_t* rowp = Z + (size_t)row * ZP + col0; const float r_ = rs[ai][m];
#pragma unroll
                for (int bj = 0; bj < 2; ++bj) { const f32x4 v0 = acc[ai][bj][m][0] * r_ + sw[bj][0], v1 = acc[ai][bj][m][1] * r_ + sw[bj][1];
                    *(u32x4*)(rowp + bj * HALF) = pack8(v0, v1);
                    const int hh = u.pn * 2 + bj;
                    if (hh < 5) { float s = (v0[0] * v0[0] + v0[1] * v0[1]) + (v0[2] * v0[2] + v0[3] * v0[3]) + (v1[0] * v1[0] + v1[1] * v1[1]) + (v1[2] * v1[2] + v1[3] * v1[3]);
                        s = sum_fq(s);
                        if (fq == 0) ssq[(size_t)row * 20 + hh * 4 + wc] = s; } }
                asm volatile("" ::: "memory"); }
    }
};
struct EpiQ {
    static constexpr bool PERM = true, AFTER_DRAIN = false, PREFETCH = false;
    bf16_t* Q; const float* ssq; const float* rope;
    __device__ __forceinline__ void operator()(const f32x4 (&acc)[2][2][4][2], const Unit& u, int wr, int wc, int fr, int fq) const {
        const int row0 = u.pm * BM + wr * 64 + fr, col0 = u.pn * BM + wc * 32 + 8 * fq;
        float rsq[2][4];
#pragma unroll
        for (int ai = 0; ai < 2; ++ai) {
#pragma unroll
            for (int m = 0; m < 4; ++m) { f32x4 s0 = {0.f, 0.f, 0.f, 0.f}; if (fq < 3) s0 = *(const f32x4*)(ssq + (size_t)(row0 + ai * HALF + m * 16) * 20 + 4 * fq);
                const float ss = sum_fq((s0[0] + s0[1]) + (s0[2] + s0[3]));
                rsq[ai][m] = rsqrtf(ss * (1.0f / 384.0f) + 1e-6f) * 0.14724444653041276f;
                if (m & 1) asm volatile("" : "+v"(rsq[ai][m - 1]), "+v"(rsq[ai][m]) :: "memory"); } }
#pragma unroll
        for (int ai = 0; ai < 2; ++ai)
#pragma unroll
            for (int m = 0; m < 4; ++m) { const int row = row0 + ai * HALF + m * 16;
                const float rstd = rsq[ai][m];
                const bool lat = row < T_LAT; const int t = row & 8191;
#pragma unroll
                for (int bj = 0; bj < 2; ++bj) { const int c = col0 + bj * HALF; const int d = c % 96;
                    f32x4 v0 = acc[ai][bj][m][0] * rstd, v1 = acc[ai][bj][m][1] * rstd;
                    if (lat && d >= 64) { const int p0 = d - 64, g = p0 >> 4, j0 = (p0 & 15) >> 1; const int pos = g ? (t & 63) : (t >> 6);
                        const f32x4* tb = (const f32x4*)(rope + (pos * 8 + j0) * 2); const f32x4 c0 = tb[0], c1 = tb[1];
                        f32x4 r0, r1;
                        r0[0] = v0[0] * c0[0] - v0[1] * c0[1]; r0[1] = v0[1] * c0[0] + v0[0] * c0[1];
                        r0[2] = v0[2] * c0[2] - v0[3] * c0[3]; r0[3] = v0[3] * c0[2] + v0[2] * c0[3];
                        r1[0] = v1[0] * c1[0] - v1[1] * c1[1]; r1[1] = v1[1] * c1[0] + v1[0] * c1[1];
                        r1[2] = v1[2] * c1[2] - v1[3] * c1[3]; r1[3] = v1[3] * c1[2] + v1[2] * c1[3];
                        v0 = r0; v1 = r1; }
                    *(u32x4*)(Q + (size_t)row * 768 + c) = pack8(v0, v1); }
                asm volatile("" ::: "memory"); }
    }
};
struct EpiKV {
    static constexpr bool PERM = true, AFTER_DRAIN = false, PREFETCH = false;
    bf16_t* KN; bf16_t* V; const float* ssq;
    __device__ __forceinline__ void operator()(const f32x4 (&acc)[2][2][4][2], const Unit& u, int wr, int wc, int fr, int fq) const {
        const int row0 = u.pm * BM + wr * 64 + fr; const int d = (wc & 1) * 32 + 8 * fq; bf16_t* dst = (wc < 2) ? KN : V;
        float rsq[2][4];
#pragma unroll
        for (int ai = 0; ai < 2; ++ai)
#pragma unroll
            for (int m = 0; m < 4; ++m) { f32x4 s0 = {0.f, 0.f, 0.f, 0.f}; if (fq < 2) s0 = *(const f32x4*)(ssq + (size_t)(row0 + ai * HALF + m * 16) * 20 + 12 + 4 * fq);
                const float ss = sum_fq((s0[0] + s0[1]) + (s0[2] + s0[3]));
                rsq[ai][m] = rsqrtf(ss * (1.0f / 256.0f) + 1e-6f); if (m == 3) asm volatile("" : "+v"(rsq[ai][0]), "+v"(rsq[ai][1]), "+v"(rsq[ai][2]), "+v"(rsq[ai][3]) :: "memory"); }
#pragma unroll
        for (int ai = 0; ai < 2; ++ai)
#pragma unroll
            for (int m = 0; m < 4; ++m) { const int row = row0 + ai * HALF + m * 16;
                const float rstd = rsq[ai][m];
                int b, kpos; if (row < T_LAT) { b = row >> 13; kpos = 256 + (row & 8191); } else { const int rc = row - T_LAT; b = rc >> 8; kpos = rc & 255; }
#pragma unroll
                for (int bj = 0; bj < 2; ++bj) { const int head = u.pn * 2 + bj;
                    const f32x4 v0 = acc[ai][bj][m][0] * rstd, v1 = acc[ai][bj][m][1] * rstd;
                    *(u32x4*)(dst + ((size_t)(b * 8 + head) * LK + kpos) * 64 + d) = pack8(v0, v1); }
                asm volatile("" ::: "memory"); }
    }
};
struct EpiRes {
    static constexpr bool PERM = true, AFTER_DRAIN = false, PREFETCH = false;
    bf16_t* XB; const float* gate;
    bf16_t* XS; float* ssqx; const float* stab;
    __device__ __forceinline__ void operator()(const f32x4 (&acc)[2][2][4][2], const Unit& u, int wr, int wc, int fr, int fq) const {
        const int trow = u.pm * BM; const int mi = (trow >= T_LAT) ? 8 : (trow >> 13);
        const int row0 = trow + wr * 64 + fr, col0 = u.pn * BM + wc * 32 + 8 * fq;
        f32x4 gv[2][2];
#pragma unroll
        for (int bj = 0; bj < 2; ++bj) { gv[bj][0] = *(const f32x4*)(gate + mi * 6144 + col0 + bj * HALF); gv[bj][1] = *(const f32x4*)(gate + mi * 6144 + col0 + bj * HALF + 4); }
        f32x4 tv[2][2] = {};
        if (stab) {
#pragma unroll
            for (int bj = 0; bj < 2; ++bj) { tv[bj][0] = *(const f32x4*)(stab + mi * 1024 + col0 + bj * HALF); tv[bj][1] = *(const f32x4*)(stab + mi * 1024 + col0 + bj * HALF + 4); } }
#pragma unroll
        for (int ai = 0; ai < 2; ++ai) {
            u32x4 xv[4][2];
#pragma unroll
            for (int m = 0; m < 4; ++m) { const size_t off = (size_t)(row0 + ai * HALF + m * 16) * 1024 + col0;
#pragma unroll
                for (int bj = 0; bj < 2; ++bj) xv[m][bj] = *(const u32x4*)(XB + off + bj * HALF); }
#pragma unroll
            for (int m = 0; m < 4; ++m) { const size_t off = (size_t)(row0 + ai * HALF + m * 16) * 1024 + col0;
                float sq = 0.f;
#pragma unroll
                for (int bj = 0; bj < 2; ++bj) { const u32x4 xr = xv[m][bj];
                    const f32x4 x0 = {__uint_as_float(xr[0] << 16), __uint_as_float(xr[0] & 0xffff0000u), __uint_as_float(xr[1] << 16), __uint_as_float(xr[1] & 0xffff0000u)};
                    const f32x4 x1 = {__uint_as_float(xr[2] << 16), __uint_as_float(xr[2] & 0xffff0000u), __uint_as_float(xr[3] << 16), __uint_as_float(xr[3] & 0xffff0000u)};
                    const f32x4 y0 = x0 + gv[bj][0] * acc[ai][bj][m][0], y1 = x1 + gv[bj][1] * acc[ai][bj][m][1];
                    *(u32x4*)(XB + off + bj * HALF) = pack8(y0, y1);
                    if (stab) { *(u32x4*)(XS + off + bj * HALF) = pack8(y0 * tv[bj][0], y1 * tv[bj][1]);
                        sq += ((y0[0] * y0[0] + y0[1] * y0[1]) + (y0[2] * y0[2] + y0[3] * y0[3])) + ((y1[0] * y1[0] + y1[1] * y1[1]) + (y1[2] * y1[2] + y1[3] * y1[3])); } }
                if (stab) { sq = sum_fq(sq); if (fq == 0) ssqx[(size_t)(row0 + ai * HALF + m * 16) * 16 + u.pn * 4 + wc] = sq; } }
            asm volatile("" ::: "memory"); }
    }
};
struct EpiPart {
    static constexpr bool PERM = true, AFTER_DRAIN = false, PREFETCH = false;
    float* P;
    __device__ __forceinline__ void operator()(const f32x4 (&acc)[2][2][4][2], const Unit& u, int wr, int wc, int fr, int fq) const {
        const int row0 = u.pm * BM + wr * 64 + fr, col0 = u.pn * BM + wc * 32 + 8 * fq;
#pragma unroll
        for (int ai = 0; ai < 2; ++ai)
#pragma unroll
            for (int m = 0; m < 4; ++m) { float* rowp = P + (size_t)(row0 + ai * HALF + m * 16) * 1024 + col0;
#pragma unroll
                for (int bj = 0; bj < 2; ++bj) { *(f32x4*)(rowp + bj * HALF) = acc[ai][bj][m][0]; *(f32x4*)(rowp + bj * HALF + 4) = acc[ai][bj][m][1]; }
                asm volatile("" ::: "memory"); }
    }
};
struct EpiFF1 {
    static constexpr bool PERM = true, AFTER_DRAIN = false, PREFETCH = true;
    bf16_t* H; const float* ssqx; const float* shw; int row_base;
    mutable float rsv[2][4]; mutable f32x4 sw[2][2];
    __device__ __forceinline__ void prefetch(const Unit& u, int wr, int wc, int fr, int fq) const {
        const int row0 = row_base + u.pm * BM + wr * 64 + fr, col0 = u.pn * BM + wc * 32 + 8 * fq;
        const int mi = (row_base + u.pm * BM >= T_LAT) ? 8 : ((row_base + u.pm * BM) >> 13);
#pragma unroll
        for (int bj = 0; bj < 2; ++bj) { sw[bj][0] = *(const f32x4*)(shw + mi * 4096 + col0 + bj * HALF); sw[bj][1] = *(const f32x4*)(shw + mi * 4096 + col0 + bj * HALF + 4); }
#pragma unroll
        for (int ai = 0; ai < 2; ++ai)
#pragma unroll
            for (int m = 0; m < 4; ++m) rsv[ai][m] = row_rstd16_q(ssqx, row0 + ai * HALF + m * 16, fq);
    }
    __device__ __forceinline__ void operator()(const f32x4 (&acc)[2][2][4][2], const Unit& u, int wr, int wc, int fr, int fq) const {
        const int row0 = row_base + u.pm * BM + wr * 64 + fr, col0 = u.pn * BM + wc * 32 + 8 * fq;
#pragma unroll
        for (int ai = 0; ai < 2; ++ai)
#pragma unroll
            for (int m = 0; m < 4; ++m) { const int row = row0 + ai * HALF + m * 16; bf16_t* rowp = H + (size_t)row * 4096 + col0; const float rs = rsv[ai][m];
#pragma unroll
                for (int bj = 0; bj < 2; ++bj) { f32x4 v0 = acc[ai][bj][m][0] * rs + sw[bj][0], v1 = acc[ai][bj][m][1] * rs + sw[bj][1];
#pragma unroll
                    for (int e = 0; e < 4; ++e) { const float a = fmaxf(v0[e], 0.f), b = fmaxf(v1[e], 0.f); v0[e] = a * a; v1[e] = b * b; }
                    *(u32x4*)(rowp + bj * HALF) = pack8(v0, v1); }
                asm volatile("" ::: "memory"); }
    }
};
template <class Epi, class Sched, bool ALIGN_EPI, bool SP2, int KC, int LDAC, int LDBC = KC>
__device__ __forceinline__ void gemm_phase(PG8_LAS unsigned char* lds, const Gemm g, const Sched& S, const Epi& E, int tid_in) {
    int tid_l = tid_in; asm volatile("" : "+v"(tid_l));
    const int tid = tid_l, wid = __builtin_amdgcn_readfirstlane(tid >> 6), lane = tid & 63, wr = wid >> 2, wc = wid & 3, fr = lane & 15, fq = lane >> 4;
    constexpr int K = KC, nt = KC / BK;
    unsigned voffA[2], voffB[2];
#pragma unroll
    for (int i = 0; i < 2; ++i) { int R, C; stage_rc(tid * 16 + i * 8192, R, C); const int Rb = Epi::PERM ? ((R & ~31) + perm32(R & 31)) : R;
        voffA[i] = (unsigned)(R * LDAC + C) * 2u; voffB[i] = (unsigned)(Rb * LDBC + C) * 2u; }
    constexpr size_t kstep = (size_t)(BK * 2);
    constexpr size_t hstepA = (size_t)HALF * LDAC * 2, hstepB = (size_t)HALF * LDBC * 2;
    constexpr size_t tstepA = 2 * hstepA, tstepB = 2 * hstepB;
    const unsigned ldsw = (unsigned)wid * 1024u;
    const int aoff = lds_byte(wr * 64 + fr, fq * 8), boff = lds_byte(wc * 32 + fr, fq * 8);
#define PG8_SA(b, h) (((b) * 2 + (h)) * HTB)
#define PG8_SB(b, h) ((4 + (b) * 2 + (h)) * HTB)
#define PG8_STAGE(bufoff, gbase, voff) do { _Pragma("unroll") for (int _i = 0; _i < 2; ++_i) \
        __builtin_amdgcn_global_load_lds((const unsigned*)((const char*)(gbase) + (voff)[_i]), (PG8_LAS unsigned*)(lds + (bufoff) + ldsw + _i * 8192), 16, 0, 0); } while (0)
#define PG8_LDA(dst, b, h) do { _Pragma("unroll") for (int m = 0; m < 4; ++m) _Pragma("unroll") for (int k = 0; k < 2; ++k) dst[m][k] = *(const PG8_LAS bf16x8*)(lds + PG8_SA(b, h) + aoff + m * 2048 + k * 1024); } while (0)
#define PG8_LDB(dst, b, h) do { _Pragma("unroll") for (int n = 0; n < 2; ++n) _Pragma("unroll") for (int k = 0; k < 2; ++k) dst[n][k] = *(const PG8_LAS bf16x8*)(lds + PG8_SB(b, h) + boff + n * 2048 + k * 1024); } while (0)
#define PG8_MMA(ai, bj, At, Bt) do { __builtin_amdgcn_s_setprio(1); _Pragma("unroll") for (int m = 0; m < 4; ++m) _Pragma("unroll") for (int n = 0; n < 2; ++n) _Pragma("unroll") for (int k = 0; k < 2; ++k) \
        acc[ai][bj][m][n] = __builtin_amdgcn_mfma_f32_16x16x32_bf16(Bt[n][k], At[m][k], acc[ai][bj][m][n], 0, 0, 0); __builtin_amdgcn_s_setprio(0); } while (0)
#define PG8_WAIT_V(n) asm volatile("s_waitcnt vmcnt(" #n ")" ::: "memory")
#define PG8_WAIT_L(n) asm volatile("s_waitcnt lgkmcnt(" #n ")" ::: "memory")
#define PG8_BAR __builtin_amdgcn_s_barrier()
#define PG8_SCHED __builtin_amdgcn_sched_barrier(0)
    Unit cur, nxt; int ui = 0;
    if (!S.next(0, cur)) return;
    f32x4 acc[2][2][4][2];
#pragma unroll
    for (int a = 0; a < 2; ++a)
#pragma unroll
        for (int b = 0; b < 2; ++b)
#pragma unroll
            for (int m = 0; m < 4; ++m)
#pragma unroll
                for (int n = 0; n < 2; ++n) acc[a][b][m][n] = (f32x4){0.f, 0.f, 0.f, 0.f};
    bf16x8 At[4][2], B0[2][2], B1[2][2];
    const char* cA = (const char*)g.A + (size_t)cur.pm * tstepA; const char* cB = (const char*)g.Bt + (size_t)cur.pn * tstepB;
    S.a_ready(cur);
    if constexpr (SP2) {
        PG8_STAGE(PG8_SB(0, 0), cB, voffB); PG8_STAGE(PG8_SB(0, 1), cB + hstepB, voffB); PG8_STAGE(PG8_SA(0, 0), cA, voffA); PG8_STAGE(PG8_SA(0, 1), cA + hstepA, voffA);
        if (wr == 1) PG8_BAR;
        PG8_WAIT_V(2); PG8_BAR;
        PG8_STAGE(PG8_SB(1, 0), cB + kstep, voffB); PG8_STAGE(PG8_SA(1, 0), cA + kstep, voffA); PG8_STAGE(PG8_SB(1, 1), cB + hstepB + kstep, voffB);
        PG8_WAIT_V(6); PG8_BAR;
    } else {
        PG8_STAGE(PG8_SB(0, 0), cB, voffB); PG8_STAGE(PG8_SA(0, 0), cA, voffA); PG8_STAGE(PG8_SB(0, 1), cB + hstepB, voffB); PG8_STAGE(PG8_SA(0, 1), cA + hstepA, voffA);
        if (wr == 1) PG8_BAR;
        PG8_WAIT_V(4); PG8_BAR;
        PG8_STAGE(PG8_SB(1, 0), cB + kstep, voffB); PG8_STAGE(PG8_SA(1, 0), cA + kstep, voffA); PG8_STAGE(PG8_SB(1, 1), cB + hstepB + kstep, voffB);
        PG8_WAIT_V(6); PG8_BAR;
    }
    for (;;) {
        if constexpr (Epi::PREFETCH) { int lp_; asm volatile("v_mbcnt_lo_u32_b32 %0, -1, 0\n\tv_mbcnt_hi_u32_b32 %0, -1, %0" : "=&v"(lp_)); E.prefetch(cur, wr, wc, lp_ & 15, lp_ >> 4); }
        const bool has_next = S.next(ui + 1, nxt);
        const char* nA = has_next ? (const char*)g.A + (size_t)nxt.pm * tstepA : cA; const char* nB = has_next ? (const char*)g.Bt + (size_t)nxt.pn * tstepB : cB;
        for (int t = 0; t < nt; t += 2) {
            const bool last = (t == nt - 2);
            const char* a1 = cA + (size_t)(t + 1) * kstep;
            const char* a2 = last ? nA : cA + (size_t)(t + 2) * kstep; const char* b2 = last ? nB : cB + (size_t)(t + 2) * kstep;
            const char* a3 = a2 + kstep; const char* b3 = b2 + kstep;
            if (last && has_next) S.a_ready(nxt);
            if constexpr (SP2) {
            PG8_LDB(B0, 0, 0); PG8_LDB(B1, 0, 1); PG8_SCHED; PG8_LDA(At, 0, 0); PG8_STAGE(PG8_SA(1, 1), a1 + hstepA, voffA);
            PG8_WAIT_V(8); PG8_WAIT_L(0); PG8_BAR; PG8_MMA(0, 0, At, B0); PG8_MMA(0, 1, At, B1); PG8_BAR; PG8_SCHED;
            PG8_LDA(At, 0, 1); PG8_STAGE(PG8_SB(0, 0), b2, voffB); PG8_STAGE(PG8_SB(0, 1), b2 + hstepB, voffB); PG8_STAGE(PG8_SA(0, 0), a2, voffA);
            PG8_WAIT_V(8); PG8_WAIT_L(0); PG8_BAR; PG8_MMA(1, 0, At, B0); PG8_MMA(1, 1, At, B1); PG8_BAR; PG8_SCHED;
            PG8_LDB(B0, 1, 0); PG8_LDB(B1, 1, 1); PG8_SCHED; PG8_LDA(At, 1, 0); PG8_STAGE(PG8_SA(0, 1), a2 + hstepA, voffA);
            PG8_WAIT_V(8); PG8_WAIT_L(0); PG8_BAR; PG8_MMA(0, 0, At, B0); PG8_MMA(0, 1, At, B1); PG8_BAR; PG8_SCHED;
            PG8_LDA(At, 1, 1); PG8_STAGE(PG8_SB(1, 0), b3, voffB); PG8_STAGE(PG8_SB(1, 1), b3 + hstepB, voffB); PG8_STAGE(PG8_SA(1, 0), a3, voffA);
            PG8_WAIT_V(8); PG8_WAIT_L(0); PG8_BAR; PG8_MMA(1, 0, At, B0); PG8_MMA(1, 1, At, B1); PG8_BAR; PG8_SCHED;
            } else {
            PG8_LDB(B0, 0, 0); PG8_SCHED; PG8_LDA(At, 0, 0); PG8_STAGE(PG8_SA(1, 1), a1 + hstepA, voffA);
            PG8_WAIT_L(8); PG8_BAR; PG8_WAIT_L(0); PG8_MMA(0, 0, At, B0); PG8_BAR; PG8_SCHED;
            PG8_LDB(B1, 0, 1); PG8_STAGE(PG8_SB(0, 0), b2, voffB);
            PG8_BAR; PG8_WAIT_L(0); PG8_MMA(0, 1, At, B1); PG8_BAR;
            PG8_LDA(At, 0, 1); PG8_STAGE(PG8_SA(0, 0), a2, voffA);
            PG8_BAR; PG8_WAIT_L(0); PG8_MMA(1, 0, At, B0); PG8_BAR; PG8_SCHED;
            PG8_STAGE(PG8_SB(0, 1), b2 + hstepB, voffB);
            PG8_WAIT_V(6); PG8_BAR; PG8_MMA(1, 1, At, B1); PG8_BAR;
            PG8_LDB(B0, 1, 0); PG8_SCHED; PG8_LDA(At, 1, 0); PG8_STAGE(PG8_SA(0, 1), a2 + hstepA, voffA);
            PG8_WAIT_L(8); PG8_BAR; PG8_WAIT_L(0); PG8_MMA(0, 0, At, B0); PG8_BAR; PG8_SCHED;
            PG8_LDB(B1, 1, 1); PG8_STAGE(PG8_SB(1, 0), b3, voffB);
            PG8_BAR; PG8_WAIT_L(0); PG8_MMA(0, 1, At, B1); PG8_BAR;
            PG8_LDA(At, 1, 1); PG8_STAGE(PG8_SA(1, 0), a3, voffA);
            PG8_BAR; PG8_WAIT_L(0); PG8_MMA(1, 0, At, B0); PG8_BAR; PG8_SCHED;
            PG8_STAGE(PG8_SB(1, 1), b3 + hstepB, voffB);
            PG8_WAIT_V(6); PG8_BAR; PG8_MMA(1, 1, At, B1); PG8_BAR;
            }
        }
        if constexpr (ALIGN_EPI) { if (wr == 0) PG8_BAR; }
        if constexpr (!Epi::AFTER_DRAIN) { Unit ue = cur; int ln_; asm volatile("v_mbcnt_lo_u32_b32 %0, -1, 0\n\tv_mbcnt_hi_u32_b32 %0, -1, %0" : "=&v"(ln_), "+s"(ue.pm), "+s"(ue.pn)); E(acc, ue, wr, wc, ln_ & 15, ln_ >> 4); S.done(cur); }
        if (!has_next) break;
#pragma unroll
        for (int a = 0; a < 2; ++a)
#pragma unroll
            for (int b = 0; b < 2; ++b)
#pragma unroll
                for (int m = 0; m < 4; ++m)
#pragma unroll
                    for (int n = 0; n < 2; ++n) acc[a][b][m][n] = (f32x4){0.f, 0.f, 0.f, 0.f};
        cur = nxt; cA = nA; cB = nB; ++ui;
        if constexpr (ALIGN_EPI) { if (wr == 1) PG8_BAR; }
    }
    PG8_WAIT_V(0);
    if constexpr (!ALIGN_EPI) { if (wr == 0) PG8_BAR; }
    PG8_BAR;
    if constexpr (Epi::AFTER_DRAIN) { E.fused(acc, cur, wr, wc, fr, fq, lds, wid, lane); S.done(cur); }
#undef PG8_SA
#undef PG8_SB
#undef PG8_STAGE
#undef PG8_LDA
#undef PG8_LDB
#undef PG8_MMA
#undef PG8_WAIT_V
#undef PG8_WAIT_L
#undef PG8_BAR
#undef PG8_SCHED
}
}
namespace att {
using bf16x8 = __attribute__((ext_vector_type(8))) short;
using s16x4  = __attribute__((ext_vector_type(4))) short;
using f32x16 = __attribute__((ext_vector_type(16))) float;
using u32x4  = __attribute__((ext_vector_type(4))) unsigned;
constexpr int NW = 8, QBLK = 32, KVBLK = 64;
constexpr float SCALE = 0.10206207261596575f;
constexpr float THR2 = 11.0f;
constexpr int SHM_V = KVBLK * 64 * 2, SHM_K = KVBLK * 208, SHM_ATTN = 3 * SHM_V + 2 * SHM_K + NW * 64 * 4;
#define KSWZ(row, colB) ((row) * 208 + (colB))
#define SBAR() __builtin_amdgcn_sched_barrier(0)
__device__ __forceinline__ int crow(int r, int hi) { return (r & 3) + 8 * (r >> 2) + 4 * hi; }
__device__ __forceinline__ unsigned cvtpk(float lo, float hi) { unsigned r; asm volatile("v_cvt_pk_bf16_f32 %0, %1, %2" : "=v"(r) : "v"(lo), "v"(hi)); return r; }
#define MX3(a, b, c) __builtin_fmaxf(__builtin_fmaxf((a), (b)), (c))
template <bool FIRST>
__device__ __forceinline__ void partialSM(f32x16& p0, f32x16& p1, float& m_reg, f32x16& negm, float& alpha) {
  float a = MX3(p0[0], p0[1], p1[0]), b = MX3(p0[2], p0[3], p1[1]); a = MX3(a, p1[2], p1[3]);
#pragma unroll
  for (int r = 4; r < 16; r += 4) { a = MX3(a, p0[r], p0[r + 1]); b = MX3(b, p0[r + 2], p0[r + 3]); a = MX3(a, p1[r], p1[r + 1]); b = MX3(b, p1[r + 2], p1[r + 3]); }
  float pmax = __builtin_fmaxf(a, b);
  { auto rr = __builtin_amdgcn_permlane32_swap(__float_as_uint(pmax), __float_as_uint(pmax), false, false);
    pmax = __builtin_fmaxf(__uint_as_float(rr[0]), __uint_as_float(rr[1])); }
  alpha = 1.f;
  if (FIRST || __builtin_expect(__any(pmax > THR2), 0)) {
    const float dl = FIRST ? pmax : __builtin_fmaxf(pmax, 0.f); m_reg += dl;
#pragma unroll
    for (int r = 0; r < 16; ++r) { p0[r] -= dl; p1[r] -= dl; }
#pragma unroll
    for (int r = 0; r < 16; ++r) negm[r] = -m_reg;
    if (!FIRST) alpha = __builtin_amdgcn_exp2f(-dl);
  }
#pragma unroll
  for (int r = 0; r < 16; ++r) p0[r] = __builtin_amdgcn_exp2f(p0[r]);
}
__device__ __forceinline__ void finishSM(f32x16& p0, f32x16& p1, float& l_reg, bf16x8& pa0, bf16x8& pa1, bf16x8& pa2, bf16x8& pa3) {
#pragma unroll
  for (int r = 0; r < 16; ++r) { p0[r] = __builtin_amdgcn_exp2f(p0[r]); p1[r] = __builtin_amdgcn_exp2f(p1[r]); }
#pragma unroll
  for (int r = 0; r < 16; ++r) l_reg += p0[r] + p1[r];
#define PK4(P, BASE, OUT) do { u32x4 w = {cvtpk(P[BASE + 0], P[BASE + 1]), cvtpk(P[BASE + 2], P[BASE + 3]), cvtpk(P[BASE + 4], P[BASE + 5]), cvtpk(P[BASE + 6], P[BASE + 7])}; OUT = *reinterpret_cast<bf16x8*>(&w); } while (0)
  PK4(p0, 0, pa0); PK4(p0, 8, pa1); PK4(p1, 0, pa2); PK4(p1, 8, pa3);
#undef PK4
}
__device__ __forceinline__ void qkt(f32x16& p0, f32x16& p1, const char* Ks, const bf16x8* qr, const f32x16& negm, int r32, int hi) {
#pragma unroll
  for (int d0 = 0; d0 < 6; ++d0) { int cb = (d0 * 16 + hi * 8) * 2;
    bf16x8 b0 = *reinterpret_cast<const bf16x8*>(Ks + KSWZ(r32, cb));
    bf16x8 b1 = *reinterpret_cast<const bf16x8*>(Ks + KSWZ(32 + r32, cb));
    if (d0 == 0) { p0 = __builtin_amdgcn_mfma_f32_32x32x16_bf16(b0, qr[0], negm, 0, 0, 0); p1 = __builtin_amdgcn_mfma_f32_32x32x16_bf16(b1, qr[0], negm, 0, 0, 0); }
    else { p0 = __builtin_amdgcn_mfma_f32_32x32x16_bf16(b0, qr[d0], p0, 0, 0, 0); p1 = __builtin_amdgcn_mfma_f32_32x32x16_bf16(b1, qr[d0], p1, 0, 0, 0); } }
}
__device__ __forceinline__ int v_st(int k, int c) { const int kk = (k & ~0xC) | ((k & 4) << 1) | ((k & 8) >> 1); return ((kk >> 3) * 2 + (c >> 5)) * 512 + ((kk & 7) * 32 + (c & 31)) * 2; }
__device__ __forceinline__ int v_st_nat(int k, int c) { return ((k >> 3) * 2 + (c >> 5)) * 512 + ((k & 7) * 32 + (c & 31)) * 2; }
__device__ __forceinline__ int v_rd_base(int lane) { return ((lane & 3) << 3) | (((lane >> 2) & 3) << 6) | (((lane >> 4) & 1) << 5) | (((lane >> 5) & 1) << 8); }
constexpr int v_rd_off(int d0, int ks, int half) { return d0 * 512 + ks * 2048 + half * 1024; }
template <int OFF> __device__ __forceinline__ s16x4 tr_read(int vb) {
  s16x4 r; asm volatile("ds_read_b64_tr_b16 %0, %1 offset:%2" : "=&v"(r) : "v"(vb), "i"(OFF) : "memory"); return r;
}
template <int D0> __device__ __forceinline__ void pv_one(f32x16& od, int vb, bf16x8 pa0, bf16x8 pa1, bf16x8 pa2, bf16x8 pa3) {
  const s16x4 l0 = tr_read<v_rd_off(D0, 0, 0)>(vb), h0 = tr_read<v_rd_off(D0, 0, 1)>(vb), l1 = tr_read<v_rd_off(D0, 1, 0)>(vb), h1 = tr_read<v_rd_off(D0, 1, 1)>(vb);
  const s16x4 l2 = tr_read<v_rd_off(D0, 2, 0)>(vb), h2 = tr_read<v_rd_off(D0, 2, 1)>(vb), l3 = tr_read<v_rd_off(D0, 3, 0)>(vb), h3 = tr_read<v_rd_off(D0, 3, 1)>(vb);
  asm volatile("s_waitcnt lgkmcnt(0)" ::: "memory"); SBAR();
#define PK(L, H) (bf16x8){L[0], L[1], L[2], L[3], H[0], H[1], H[2], H[3]}
  od = __builtin_amdgcn_mfma_f32_32x32x16_bf16(pa0, PK(l0, h0), od, 0, 0, 0);
  od = __builtin_amdgcn_mfma_f32_32x32x16_bf16(pa1, PK(l1, h1), od, 0, 0, 0);
  od = __builtin_amdgcn_mfma_f32_32x32x16_bf16(pa2, PK(l2, h2), od, 0, 0, 0);
  od = __builtin_amdgcn_mfma_f32_32x32x16_bf16(pa3, PK(l3, h3), od, 0, 0, 0);
}
__device__ __forceinline__ void pv_d0(f32x16* o, int vb, bf16x8 ones, bf16x8 pa0, bf16x8 pa1, bf16x8 pa2, bf16x8 pa3) {
  s16x4 a0 = tr_read<v_rd_off(0, 0, 0)>(vb), b0 = tr_read<v_rd_off(0, 0, 1)>(vb), c0 = tr_read<v_rd_off(1, 0, 0)>(vb), d0 = tr_read<v_rd_off(1, 0, 1)>(vb);
  s16x4 a1 = tr_read<v_rd_off(0, 1, 0)>(vb), b1 = tr_read<v_rd_off(0, 1, 1)>(vb), c1 = tr_read<v_rd_off(1, 1, 0)>(vb), d1 = tr_read<v_rd_off(1, 1, 1)>(vb);
  s16x4 a2 = tr_read<v_rd_off(0, 2, 0)>(vb), b2 = tr_read<v_rd_off(0, 2, 1)>(vb), c2 = tr_read<v_rd_off(1, 2, 0)>(vb), d2 = tr_read<v_rd_off(1, 2, 1)>(vb);
  s16x4 a3 = tr_read<v_rd_off(0, 3, 0)>(vb), b3 = tr_read<v_rd_off(0, 3, 1)>(vb), c3 = tr_read<v_rd_off(1, 3, 0)>(vb), d3 = tr_read<v_rd_off(1, 3, 1)>(vb);
  asm volatile("s_waitcnt lgkmcnt(0)" : "+v"(a0), "+v"(b0), "+v"(c0), "+v"(d0), "+v"(a1), "+v"(b1), "+v"(c1), "+v"(d1), "+v"(a2), "+v"(b2), "+v"(c2), "+v"(d2), "+v"(a3), "+v"(b3), "+v"(c3), "+v"(d3) :: "memory");
  o[2] = __builtin_amdgcn_mfma_f32_32x32x16_bf16(pa0, ones, o[2], 0, 0, 0); o[0] = __builtin_amdgcn_mfma_f32_32x32x16_bf16(pa0, PK(a0, b0), o[0], 0, 0, 0); o[1] = __builtin_amdgcn_mfma_f32_32x32x16_bf16(pa0, PK(c0, d0), o[1], 0, 0, 0);
  o[2] = __builtin_amdgcn_mfma_f32_32x32x16_bf16(pa1, ones, o[2], 0, 0, 0); o[0] = __builtin_amdgcn_mfma_f32_32x32x16_bf16(pa1, PK(a1, b1), o[0], 0, 0, 0); o[1] = __builtin_amdgcn_mfma_f32_32x32x16_bf16(pa1, PK(c1, d1), o[1], 0, 0, 0);
  o[2] = __builtin_amdgcn_mfma_f32_32x32x16_bf16(pa2, ones, o[2], 0, 0, 0); o[0] = __builtin_amdgcn_mfma_f32_32x32x16_bf16(pa2, PK(a2, b2), o[0], 0, 0, 0); o[1] = __builtin_amdgcn_mfma_f32_32x32x16_bf16(pa2, PK(c2, d2), o[1], 0, 0, 0);
  o[2] = __builtin_amdgcn_mfma_f32_32x32x16_bf16(pa3, ones, o[2], 0, 0, 0); o[0] = __builtin_amdgcn_mfma_f32_32x32x16_bf16(pa3, PK(a3, b3), o[0], 0, 0, 0); o[1] = __builtin_amdgcn_mfma_f32_32x32x16_bf16(pa3, PK(c3, d3), o[1], 0, 0, 0);
#undef PK
}
template <int OFF> __device__ __forceinline__ bf16x8 rd128(int addr) { bf16x8 r; asm volatile("ds_read_b128 %0, %1 offset:%2" : "=v"(r) : "v"(addr), "i"(OFF) : "memory"); return r; }
#define WAIT4(a, b, c, d) asm volatile("s_waitcnt lgkmcnt(0)" : "+v"(a), "+v"(b), "+v"(c), "+v"(d) :: "memory")
#define EXP4(P, B) do { P[B] = __builtin_amdgcn_exp2f(P[B]); P[B + 1] = __builtin_amdgcn_exp2f(P[B + 1]); P[B + 2] = __builtin_amdgcn_exp2f(P[B + 2]); P[B + 3] = __builtin_amdgcn_exp2f(P[B + 3]); } while (0)
struct VFr { s16x4 a0, b0, c0, d0, a1, b1, c1, d1; };
template <int KS0> __device__ __forceinline__ void vfr_issue(VFr& f, int vb) {
  f.a0 = tr_read<v_rd_off(0, KS0, 0)>(vb); f.b0 = tr_read<v_rd_off(0, KS0, 1)>(vb); f.c0 = tr_read<v_rd_off(1, KS0, 0)>(vb); f.d0 = tr_read<v_rd_off(1, KS0, 1)>(vb);
  f.a1 = tr_read<v_rd_off(0, KS0 + 1, 0)>(vb); f.b1 = tr_read<v_rd_off(0, KS0 + 1, 1)>(vb); f.c1 = tr_read<v_rd_off(1, KS0 + 1, 0)>(vb); f.d1 = tr_read<v_rd_off(1, KS0 + 1, 1)>(vb);
}
#define MF(A, B, C) __builtin_amdgcn_mfma_f32_32x32x16_bf16(A, B, C, 0, 0, 0)
#define KOFF(KB, hb, d0) ((KB) * SHM_K + (hb) * 32 * 208 + (d0) * 32)
#define SUM4(P, B) do { ls += (P[B] + P[B + 1]) + (P[B + 2] + P[B + 3]); } while (0)
#define PACK8(P, B, OUT) do { u32x4 w_ = {cvtpk(P[B + 0], P[B + 1]), cvtpk(P[B + 2], P[B + 3]), cvtpk(P[B + 4], P[B + 5]), cvtpk(P[B + 6], P[B + 7])}; OUT = *reinterpret_cast<bf16x8*>(&w_); } while (0)
template <int KB, bool HASY>
__device__ __forceinline__ void phaseA(f32x16& X0, f32x16& X1, f32x16& Y0, f32x16& Y1, bf16x8& pa0, bf16x8& pa1, bf16x8& pa2, bf16x8& pa3,
                                       const bf16x8* qr, const f32x16& negm, int kaddr, VFr& vf, int vb, float& l_reg) {
  SBAR();
  float ls = 0.f;
  bf16x8 k0 = rd128<KOFF(KB, 0, 0)>(kaddr), k1 = rd128<KOFF(KB, 1, 0)>(kaddr), k2 = rd128<KOFF(KB, 0, 1)>(kaddr), k3 = rd128<KOFF(KB, 1, 1)>(kaddr);
  if (HASY) { EXP4(Y0, 0); EXP4(Y0, 4); }
  SBAR(); WAIT4(k0, k1, k2, k3);
  bf16x8 k4 = rd128<KOFF(KB, 0, 2)>(kaddr), k5 = rd128<KOFF(KB, 1, 2)>(kaddr), k6 = rd128<KOFF(KB, 0, 3)>(kaddr), k7 = rd128<KOFF(KB, 1, 3)>(kaddr);
  SBAR();
  X0 = MF(k0, qr[0], negm); if (HASY) { EXP4(Y0, 8); SUM4(Y0, 0); } SBAR();
  X1 = MF(k1, qr[0], negm); if (HASY) { EXP4(Y0, 12); SUM4(Y0, 4); } SBAR();
  X0 = MF(k2, qr[1], X0); if (HASY) { PACK8(Y0, 0, pa0); } SBAR();
  X1 = MF(k3, qr[1], X1); if (HASY) { EXP4(Y1, 0); SUM4(Y0, 8); } SBAR();
  WAIT4(k4, k5, k6, k7);
  bf16x8 k8 = rd128<KOFF(KB, 0, 4)>(kaddr), k9 = rd128<KOFF(KB, 1, 4)>(kaddr), k10 = rd128<KOFF(KB, 0, 5)>(kaddr), k11 = rd128<KOFF(KB, 1, 5)>(kaddr);
  SBAR();
  X0 = MF(k4, qr[2], X0); if (HASY) { EXP4(Y1, 4); SUM4(Y0, 12); } SBAR();
  X1 = MF(k5, qr[2], X1); if (HASY) { PACK8(Y0, 8, pa1); } SBAR();
  X0 = MF(k6, qr[3], X0); if (HASY) { EXP4(Y1, 8); SUM4(Y1, 0); } SBAR();
  X1 = MF(k7, qr[3], X1); if (HASY) { EXP4(Y1, 12); SUM4(Y1, 4); } SBAR();
  WAIT4(k8, k9, k10, k11);
  SBAR();
  X0 = MF(k8, qr[4], X0); if (HASY) { PACK8(Y1, 0, pa2); } SBAR();
  X1 = MF(k9, qr[4], X1); if (HASY) { SUM4(Y1, 8); SUM4(Y1, 12); } SBAR();
  X0 = MF(k10, qr[5], X0); if (HASY) { PACK8(Y1, 8, pa3); } SBAR();
  X1 = MF(k11, qr[5], X1); if (HASY) vfr_issue<0>(vf, vb);
  l_reg += ls;
  SBAR();
}
#define PKV(L, H) (bf16x8){L[0], L[1], L[2], L[3], H[0], H[1], H[2], H[3]}
#define VWAIT(f) asm volatile("s_waitcnt lgkmcnt(0)" : "+v"(f.a0), "+v"(f.b0), "+v"(f.c0), "+v"(f.d0), "+v"(f.a1), "+v"(f.b1), "+v"(f.c1), "+v"(f.d1) :: "memory")
template <bool HASX>
__device__ __forceinline__ float phaseB(f32x16* o, bf16x8 pa0, bf16x8 pa1, bf16x8 pa2, bf16x8 pa3, VFr& f, int vb, const f32x16& X0, const f32x16& X1) {
  SBAR(); VWAIT(f); VFr g; vfr_issue<2>(g, vb); SBAR();
  float a = 0.f, b = 0.f;
  o[0] = MF(pa0, PKV(f.a0, f.b0), o[0]); SBAR(); o[1] = MF(pa0, PKV(f.c0, f.d0), o[1]);
  if (HASX) { a = MX3(X0[0], X0[1], X1[0]); b = MX3(X0[2], X0[3], X1[1]); a = MX3(a, X1[2], X1[3]); b = MX3(b, X0[4], X0[5]); } SBAR();
  o[0] = MF(pa1, PKV(f.a1, f.b1), o[0]); if (HASX) { a = MX3(a, X0[6], X0[7]); b = MX3(b, X1[4], X1[5]); } SBAR();
  o[1] = MF(pa1, PKV(f.c1, f.d1), o[1]); if (HASX) { a = MX3(a, X1[6], X1[7]); b = MX3(b, X0[8], X0[9]); a = MX3(a, X0[10], X0[11]); } SBAR();
  VWAIT(g); SBAR();
  o[0] = MF(pa2, PKV(g.a0, g.b0), o[0]); if (HASX) { b = MX3(b, X1[8], X1[9]); a = MX3(a, X1[10], X1[11]); } SBAR();
  o[1] = MF(pa2, PKV(g.c0, g.d0), o[1]); if (HASX) { b = MX3(b, X0[12], X0[13]); a = MX3(a, X0[14], X0[15]); } SBAR();
  o[0] = MF(pa3, PKV(g.a1, g.b1), o[0]); if (HASX) { b = MX3(b, X1[12], X1[13]); a = MX3(a, X1[14], X1[15]); } SBAR();
  o[1] = MF(pa3, PKV(g.c1, g.d1), o[1]); SBAR();
  float pmax = __builtin_fmaxf(a, b);
  if (HASX) { auto rr = __builtin_amdgcn_permlane32_swap(__float_as_uint(pmax), __float_as_uint(pmax), false, false); pmax = __builtin_fmaxf(__uint_as_float(rr[0]), __uint_as_float(rr[1])); }
  return pmax;
}
__device__ __forceinline__ float rowmax32(const f32x16& p0, const f32x16& p1) {
  float a = MX3(p0[0], p0[1], p1[0]), b = MX3(p0[2], p0[3], p1[1]); a = MX3(a, p1[2], p1[3]);
#pragma unroll
  for (int r = 4; r < 16; r += 4) { a = MX3(a, p0[r], p0[r + 1]); b = MX3(b, p0[r + 2], p0[r + 3]); a = MX3(a, p1[r], p1[r + 1]); b = MX3(b, p1[r + 2], p1[r + 3]); }
  float pmax = __builtin_fmaxf(a, b);
  auto rr = __builtin_amdgcn_permlane32_swap(__float_as_uint(pmax), __float_as_uint(pmax), false, false);
  return __builtin_fmaxf(__uint_as_float(rr[0]), __uint_as_float(rr[1]));
}
template <bool FIRST>
__device__ __forceinline__ float decide(float pmax, f32x16& p0, f32x16& p1, float& m_reg, f32x16& negm) {
  float alpha = 1.f;
  if (FIRST || __builtin_expect(__any(pmax > THR2), 0)) {
    const float dl = FIRST ? pmax : __builtin_fmaxf(pmax, 0.f); m_reg += dl;
#pragma unroll
    for (int r = 0; r < 16; ++r) { p0[r] -= dl; p1[r] -= dl; }
#pragma unroll
    for (int r = 0; r < 16; ++r) negm[r] = -m_reg;
    if (!FIRST) alpha = __builtin_amdgcn_exp2f(-dl);
  }
  return alpha;
}
__device__ __forceinline__ void attn_unit(const bf16_t* __restrict__ Qb, const bf16_t* __restrict__ KNh, const bf16_t* __restrict__ KRb, const bf16_t* __restrict__ Vh,
                                          bf16_t* __restrict__ Ob, int nkeys, char* lds, int tid_in) {
  int tid_l = tid_in; asm volatile("" : "+v"(tid_l));
  const int tid = tid_l, wid = tid >> 6, lane = tid & 63, r32 = lane & 31, hi = lane >> 5;
  char* V_lds = lds; char* K_lds = lds + 3 * SHM_V;
  float* ws = (float*)(lds + 3 * SHM_V + 2 * SHM_K) + wid * 64; float* li_l = ws; float* al_l = ws + 32;
  float m_reg = 0.f, l_reg = 0.f; f32x16 o[2] = {}; f32x16 negm = {}; bf16x8 qr[6];
  const bf16_t* Qw = Qb + (long)(wid * QBLK + r32) * 768 + hi * 8;
#pragma unroll
  for (int d0 = 0; d0 < 6; ++d0) qr[d0] = *reinterpret_cast<const bf16x8*>(Qw + d0 * 16);
  const int sr = tid >> 3, sc = (tid & 7) * 8, vst0 = v_st_nat(sr, sc), kst0 = KSWZ(sr, sc * 2);
  const bool krt = tid < 256; const int rr_ = (tid >> 2) & 63, rc_ = (tid & 3) * 8, kst1 = KSWZ(rr_, 128 + rc_ * 2);
  const int vb0 = (int)(uintptr_t)V_lds + v_rd_base(lane);
  const int kaddr = (int)(uintptr_t)K_lds + r32 * 208 + hi * 16;
  struct { bf16x8 vs, ks, kr; } sr_[2];
#define SLOAD(i, k0) do { sr_[i].vs = *reinterpret_cast<const bf16x8*>(&Vh[(long)((k0) + sr) * 64 + sc]); sr_[i].ks = *reinterpret_cast<const bf16x8*>(&KNh[(long)((k0) + sr) * 64 + sc]); \
    if (krt) sr_[i].kr = *reinterpret_cast<const bf16x8*>(&KRb[(long)((k0) + rr_) * 32 + rc_]); } while (0)
#define SWRITE(b, voff, i) do { *(bf16x8*)(V_lds + (voff) + vst0) = sr_[i].vs; *(bf16x8*)(K_lds + (b) * SHM_K + kst0) = sr_[i].ks; \
    if (krt) *(bf16x8*)(K_lds + (b) * SHM_K + kst1) = sr_[i].kr; } while (0)
#define SWAIT() do { asm volatile("s_waitcnt vmcnt(3)" ::: "memory"); } while (0)
#define RESC(a) do { if (__any((a) < 1.f)) { if (hi == 0) al_l[r32] = (a); asm volatile("s_waitcnt lgkmcnt(0)" ::: "memory"); l_reg *= (a); \
    _Pragma("unroll") for (int d = 0; d < 2; ++d) _Pragma("unroll") for (int r = 0; r < 16; ++r) o[d][r] *= al_l[crow(r, hi)]; } } while (0)
  f32x16 pA0, pA1, pB0, pB1; float alA, alB; bf16x8 pa0, pa1, pa2, pa3; VFr vf; const int NT = nkeys / KVBLK;
  constexpr int SE = 0, SO = 1;
  int vprev = 0, vcur = SHM_V, vnext = 2 * SHM_V;
#define ROT() do { const int t_ = vprev; vprev = vcur; vcur = vnext; vnext = t_; } while (0)
  SLOAD(SE, 0); asm volatile("s_waitcnt vmcnt(0)" ::: "memory"); SWRITE(0, 0, SE); __syncthreads();
  phaseA<0, false>(pA0, pA1, pB0, pB1, pa0, pa1, pa2, pa3, qr, negm, kaddr, vf, vb0, l_reg);
  alA = decide<true>(rowmax32(pA0, pA1), pA0, pA1, m_reg, negm);
  SLOAD(SO, KVBLK); if (2 < NT) SLOAD(SE, 2 * KVBLK);
  SWAIT(); SWRITE(1, SHM_V, SO); __syncthreads();
  for (int j = 1; j + 1 < NT; j += 2) {
    phaseA<1, true>(pB0, pB1, pA0, pA1, pa0, pa1, pa2, pa3, qr, negm, kaddr, vf, vb0 + vprev, l_reg);
    SLOAD(SO, (j + 2) * KVBLK); SBAR();
    alB = decide<false>(phaseB<true>(o, pa0, pa1, pa2, pa3, vf, vb0 + vprev, pB0, pB1), pB0, pB1, m_reg, negm);
    SWAIT(); SWRITE(0, vnext, SE);
    RESC(alB); __syncthreads(); ROT();
    phaseA<0, true>(pA0, pA1, pB0, pB1, pa0, pa1, pa2, pa3, qr, negm, kaddr, vf, vb0 + vprev, l_reg);
    if (j + 3 < NT) SLOAD(SE, (j + 3) * KVBLK); SBAR();
    alA = decide<false>(phaseB<true>(o, pa0, pa1, pa2, pa3, vf, vb0 + vprev, pA0, pA1), pA0, pA1, m_reg, negm);
    SWAIT(); SWRITE(1, vnext, SO);
    RESC(alA); __syncthreads(); ROT();
  }
  phaseA<1, true>(pB0, pB1, pA0, pA1, pa0, pa1, pa2, pa3, qr, negm, kaddr, vf, vb0 + vprev, l_reg);
  alB = decide<false>(phaseB<true>(o, pa0, pa1, pa2, pa3, vf, vb0 + vprev, pB0, pB1), pB0, pB1, m_reg, negm);
  RESC(alB);
  finishSM(pB0, pB1, l_reg, pa0, pa1, pa2, pa3);
  vfr_issue<0>(vf, vb0 + vcur);
  (void)phaseB<false>(o, pa0, pa1, pa2, pa3, vf, vb0 + vcur, pB0, pB1);
#undef ROT
  { auto rr = __builtin_amdgcn_permlane32_swap(__float_as_uint(l_reg), __float_as_uint(l_reg), false, false); l_reg = __uint_as_float(rr[0]) + __uint_as_float(rr[1]); }
  if (hi == 0) li_l[r32] = l_reg;
  asm volatile("s_waitcnt lgkmcnt(0)" ::: "memory");
  float rli[16];
#pragma unroll
  for (int r = 0; r < 16; ++r) rli[r] = __builtin_amdgcn_rcpf(li_l[crow(r, hi)]);
  bf16_t* Ow = Ob + (long)(wid * QBLK) * 1024;
#pragma unroll
  for (int r = 0; r < 16; ++r) { int orow = crow(r, hi);
#pragma unroll
    for (int d0 = 0; d0 < 2; ++d0) { const float v = o[d0][r] * rli[r]; Ow[(long)orow * 1024 + d0 * 32 + r32] = (bf16_t)(cvtpk(v, v) & 0xffffu); } }
  __syncthreads();
#undef SLOAD
#undef SWRITE
#undef SWAIT
#undef RESC
}
}
#define LAS __attribute__((address_space(3)))
typedef unsigned short bf16_t;
typedef float f32x4 __attribute__((ext_vector_type(4)));
typedef unsigned u32x4 __attribute__((ext_vector_type(4)));
typedef unsigned u32x2 __attribute__((ext_vector_type(2)));
typedef short bf16x8 __attribute__((ext_vector_type(8)));
using att::f32x16;
#define LDS_WAIT() asm volatile("s_waitcnt lgkmcnt(0)" ::: "memory")

constexpr int NWAVES = 8, NTHREADS = 512;
constexpr int D = 1024, BATCH = 8, SEQ = 8192, DEPTH = 4, CTXL = 256, DFF = 4096, DIN = 1696;
constexpr int TL = BATCH * SEQ, TC = BATCH * CTXL, MALL = TL + TC;
constexpr size_t MiB = 1u << 20;
constexpr size_t WS_ROPE = 64 * 1024, WS_MODS = 1 * MiB, WS_SSQ = 2 * MiB, WS_WIN = 8 * MiB, WS_WUQ = 22 * MiB, WS_WUKV = 25 * MiB, WS_WOUT = 27 * MiB,
                 WS_W1 = 35 * MiB, WS_W2 = 67 * MiB, WS_CX = 99 * MiB, WS_XN = 107 * MiB, WS_Z = 239 * MiB, WS_Q = 470 * MiB, WS_KN = 569 * MiB, WS_KR = 635 * MiB,
                 WS_V = 640 * MiB, WS_Y = 706 * MiB, WS_H = 239 * MiB, WS_END = 838 * MiB,
                 WS_SSQX = 838 * MiB, WS_SHW = 843 * MiB, WS_STAB = 844 * MiB, WS_XB = 845 * MiB, WS_PART = 977 * MiB, WS_END2 = 1009 * MiB;
static_assert(WS_SSQ + (size_t)MALL * 20 * 4 <= WS_WIN && WS_XN + (size_t)MALL * D * 2 <= WS_Z && WS_Z + (size_t)MALL * ZP * 2 <= WS_Q && WS_Q + (size_t)MALL * 768 * 2 <= WS_KN &&
              WS_KN + (size_t)64 * LK * 64 * 2 <= WS_KR && WS_KR + (size_t)8 * LK * 32 * 2 <= WS_V && WS_V + (size_t)64 * LK * 64 * 2 <= WS_Y && WS_Y + (size_t)MALL * D * 2 <= WS_END &&
              WS_H + (size_t)MALL * DFF * 2 <= WS_END && WS_MODS + (size_t)DEPTH * 9 * 6144 * 4 <= WS_SSQ, "ws map");
constexpr int SHW_IN = 1792, SHW_L = 9 * (1792 + 4096);
static_assert(WS_SSQX + (size_t)MALL * 16 * 4 <= WS_SHW && WS_SHW + (size_t)DEPTH * SHW_L * 4 <= WS_STAB && WS_STAB + (size_t)DEPTH * 2 * 9 * 1024 * 4 <= WS_XB && WS_XB + (size_t)MALL * D * 2 <= WS_PART && WS_PART + (size_t)4 * TC * D * 4 <= WS_END2, "ws map 2");
constexpr int LDS_BYTES = 147456;

struct Args { const float* in[25]; float* out; unsigned char* ws; int ph_lo, ph_hi; };

__device__ __forceinline__ float row16_sum(float v) {
    v += __int_as_float(__builtin_amdgcn_update_dpp(0, __float_as_int(v), 0xB1, 0xF, 0xF, false));
    v += __int_as_float(__builtin_amdgcn_update_dpp(0, __float_as_int(v), 0x4E, 0xF, 0xF, false));
    v += __int_as_float(__builtin_amdgcn_update_dpp(0, __float_as_int(v), 0x141, 0xF, 0xF, false));
    v += __int_as_float(__builtin_amdgcn_update_dpp(0, __float_as_int(v), 0x140, 0xF, 0xF, false));
    return v;
}
__device__ __forceinline__ float half_sum(float v) {
    v = row16_sum(v);
    { auto r = __builtin_amdgcn_permlane16_swap(__float_as_uint(v), __float_as_uint(v), false, false); v = __uint_as_float(r[0]) + __uint_as_float(r[1]); }
    return v;
}
__device__ __forceinline__ float wave_sum(float v, int lane) {
    v = half_sum(v);
    { auto r = __builtin_amdgcn_permlane32_swap(__float_as_uint(v), __float_as_uint(v), false, false); v = __uint_as_float(r[0]) + __uint_as_float(r[1]); }
    return v;
}
__device__ __forceinline__ float sigmoid_f(float x) { return __builtin_amdgcn_rcpf(1.f + __expf(-x)); }
__device__ __forceinline__ float gelu_tanh(float x) { const float u = 0.7978845608028654f * (x + 0.044715f * x * x * x); return x * __builtin_amdgcn_rcpf(1.f + __expf(-2.f * u)); }
__device__ __forceinline__ float bf2f(unsigned short h) { return __uint_as_float((unsigned)h << 16); }
__device__ __forceinline__ unsigned pk2(float lo, float hi) { return pg8::cvt_pk_bf16(lo, hi); }
__device__ __forceinline__ int rope_new(int i) { const int g = i >> 4, w = i & 15; return 16 * g + 2 * (w & 7) + (w >> 3); }
__device__ __forceinline__ int rowmap(int mode, int n) {
    if (mode == 1) return (n >= 640 && n < 672) ? 640 + rope_new(n - 640) : n;
    if (mode == 2) { const int h = n / 96, d = n - h * 96; return d >= 64 ? h * 96 + 64 + rope_new(d - 64) : n; }
    return n;
}
__device__ __forceinline__ void transpose_item(const float* W, int K, int N, bf16_t* WT, const float* kscale, int mode, LAS float* scr, int item, int lane) {
    const int nblk = N / 32, kb = item / nblk, nb = item % nblk, k0 = 64 * kb, n0 = 32 * nb;
#pragma unroll 8
    for (int i = 0; i < 32; ++i) { const int kk = 2 * i + (lane >> 5); float w = W[(size_t)(k0 + kk) * N + n0 + (lane & 31)]; if (kscale) w *= kscale[k0 + kk]; scr[kk * 33 + (lane & 31)] = w; }
    LDS_WAIT(); asm volatile("" ::: "memory");
    const int c = lane & 7;
#pragma unroll
    for (int j = 0; j < 4; ++j) { const int n = (lane >> 3) + 8 * j; const LAS float* s = scr + (8 * c) * 33 + n;
        u32x4 o; o.x = pk2(s[0 * 33], s[1 * 33]); o.y = pk2(s[2 * 33], s[3 * 33]); o.z = pk2(s[4 * 33], s[5 * 33]); o.w = pk2(s[6 * 33], s[7 * 33]);
        *(u32x4*)(WT + (size_t)rowmap(mode, n0 + n) * K + k0 + 8 * c) = o; }
    LDS_WAIT(); asm volatile("" ::: "memory");
}

typedef __attribute__((address_space(1))) unsigned gu32;
#define RLX_AGENT __ATOMIC_RELAXED, __HIP_MEMORY_SCOPE_AGENT
#define XB_TMO      128
#define XB_XCNT(j)  (256  + 64 * (j))
#define XB_XSUB(j)  (1280 + 64 * (j))
#define XB_XGEN(j)  (2304 + 64 * (j))
#define XB_TOP      3328
#define XB_TOPGEN   3392
#define XCD_BAR_WORDS 3456
#define XB_SPIN_CAP (1u << 18)

__device__ __forceinline__ unsigned xb_ld(unsigned* p)              { return __hip_atomic_load(p, __ATOMIC_RELAXED, __HIP_MEMORY_SCOPE_AGENT); }
__device__ __forceinline__ unsigned xb_add(unsigned* p, unsigned v) { return __hip_atomic_fetch_add(p, v, __ATOMIC_RELAXED, __HIP_MEMORY_SCOPE_AGENT); }
__device__ __forceinline__ unsigned xb_xcc_id() { return (unsigned)__builtin_amdgcn_s_getreg((3 << 11) | 20) & 0xFu; }
#define XB_SPIN(cond, bar) do { unsigned _sp = 0; while (cond) { __builtin_amdgcn_s_sleep(1); \
    if ((++_sp & 255u) == 0u) { if (xb_ld(&(bar)[XB_TMO])) break; if (_sp > XB_SPIN_CAP) { atomicAdd(&(bar)[XB_TMO], 1u); break; } } } } while (0)

struct XcdBarrier {
    unsigned* bar; unsigned x;
    volatile LAS unsigned* st;
};

__device__ __forceinline__ XcdBarrier xcd_barrier_post(unsigned* bar, volatile LAS unsigned* st) {
    XcdBarrier b; b.bar = bar; b.x = xb_xcc_id(); b.st = st;
    if (threadIdx.x == 0) (void)xb_add(&bar[XB_XCNT(b.x)], 1u);
    return b;
}
__device__ __forceinline__ void xcd_barrier_complete(unsigned* bar, unsigned x, unsigned& nloc, unsigned& nx) {
    const unsigned G = gridDim.x * gridDim.y * gridDim.z;
    unsigned sum, cnt, mine, sp = 0u;
    for (;;) {
        sum = 0u; cnt = 0u; mine = 0u;
#pragma unroll
        for (unsigned j = 0; j < 16; ++j) { const unsigned c = xb_ld(&bar[XB_XCNT(j)]); sum += c; cnt += (c > 0u) ? 1u : 0u; mine = (j == x) ? c : mine; }
        if (sum == G) break;
        __builtin_amdgcn_s_sleep(1);
        if ((++sp & 255u) == 0u) { if (xb_ld(&bar[XB_TMO])) break; if (sp > XB_SPIN_CAP) { atomicAdd(&bar[XB_TMO], 1u); break; } }
    }
    nloc = mine > 0u ? mine : 1u; nx = cnt > 0u ? cnt : 1u;
}

__device__ __forceinline__ void xcd_barrier(const XcdBarrier& b) {
    asm volatile("s_waitcnt vmcnt(0)" ::: "memory");
    __syncthreads();
    if (threadIdx.x == 0) {
        unsigned* bar = b.bar;
        __builtin_amdgcn_s_waitcnt(0);
        unsigned nloc = b.st[0], nx = b.st[1];
        if (nloc == 0u) { xcd_barrier_complete(bar, b.x, nloc, nx); b.st[0] = nloc; b.st[1] = nx; }
        const unsigned old = xb_add(&bar[XB_XSUB(b.x)], 1u);
        const unsigned gen = old / nloc;
        if (old + 1u == (gen + 1u) * nloc) {
            __builtin_amdgcn_fence(__ATOMIC_RELEASE, "agent");
            asm volatile("s_waitcnt vmcnt(0)" ::: "memory");
            const unsigned og = xb_add(&bar[XB_TOP], 1u);
            const unsigned tg = og / nx;
            if (og + 1u == (tg + 1u) * nx) xb_add(&bar[XB_TOPGEN], 1u);
            else XB_SPIN(xb_ld(&bar[XB_TOPGEN]) == tg, bar);
            __builtin_amdgcn_fence(__ATOMIC_ACQUIRE, "agent");
            xb_add(&bar[XB_XGEN(b.x)], 1u);
            asm volatile("s_waitcnt vmcnt(0)" ::: "memory");
        } else {
            XB_SPIN(xb_ld(&bar[XB_XGEN(b.x)]) == gen, bar);
            __builtin_amdgcn_fence(__ATOMIC_ACQUIRE, "agent");
            asm volatile("s_waitcnt vmcnt(0)" ::: "memory");
        }
    }
    __syncthreads();
}
__device__ __forceinline__ int nrep_of(int n) { asm volatile("" : "+s"(n)); return n; }
struct Ctx {
    LAS unsigned char* lds; unsigned char* ldsg; const float* const* in; float* out; unsigned char* ws;
    int tid, lane, wave, G, bx, vcu;
};

__device__ __forceinline__ void phase_prologue(const Ctx& F) {
    LAS float* scr = (LAS float*)(F.lds + F.wave * 16384);
    const int gw = F.bx * NWAVES + F.wave, NGW = F.G * NWAVES;
    constexpr int I_IN = 16 * 53, I_UQ = 6 * 24, I_UKV = 4 * 32, I_OUT = 16 * 32, I_1 = 16 * 128, I_2 = 64 * 32, I_L = I_IN + I_UQ + I_UKV + I_OUT + I_1 + I_2;
    for (int it = gw; it < DEPTH * I_L; it += NGW) {
        const int l = it / I_L; int r = it - l * I_L;
        if (r < I_IN) { transpose_item(F.in[8] + (size_t)l * D * DIN, D, DIN, (bf16_t*)(F.ws + WS_WIN) + (size_t)l * ZP * D, nullptr, 1, scr, r, F.lane); continue; } r -= I_IN;
        if (r < I_UQ) { transpose_item(F.in[10] + (size_t)l * 384 * 768, 384, 768, (bf16_t*)(F.ws + WS_WUQ) + (size_t)l * 768 * 384, F.in[9] + l * 384, 2, scr, r, F.lane); continue; } r -= I_UQ;
        if (r < I_UKV) { transpose_item(F.in[12] + (size_t)l * 256 * 1024, 256, 1024, (bf16_t*)(F.ws + WS_WUKV) + (size_t)l * 1024 * 256, F.in[11] + l * 256, 0, scr, r, F.lane); continue; } r -= I_UKV;
        if (r < I_OUT) { transpose_item(F.in[21] + (size_t)l * D * D, D, D, (bf16_t*)(F.ws + WS_WOUT) + (size_t)l * D * D, nullptr, 0, scr, r, F.lane); continue; } r -= I_OUT;
        if (r < I_1) { transpose_item(F.in[22] + (size_t)l * D * DFF, D, DFF, (bf16_t*)(F.ws + WS_W1) + (size_t)l * DFF * D, nullptr, 0, scr, r, F.lane); continue; } r -= I_1;
        transpose_item(F.in[23] + (size_t)l * DFF * D, DFF, D, (bf16_t*)(F.ws + WS_W2) + (size_t)l * D * DFF, nullptr, 0, scr, r, F.lane);
    }
    for (int i = F.bx * NTHREADS + F.tid; i < DEPTH * 96 * D / 8; i += F.G * NTHREADS) { const int l = i / (96 * D / 8), r = i - l * (96 * D / 8);
        unsigned zz_ = 0u; asm volatile("" : "+v"(zz_)); *(u32x4*)((bf16_t*)(F.ws + WS_WIN) + ((size_t)l * ZP + DIN) * D + (size_t)r * 8) = (u32x4){zz_, zz_, zz_, zz_}; }
    if (F.bx == 0) for (int i = F.tid; i < 128 * 8; i += NTHREADS) { const int pos = i >> 3, j = i & 7; const float inv = 1.0f / powf(10000.0f, (float)j / 8.0f); const float ang = (float)pos * inv;
        float* rp = (float*)(F.ws + WS_ROPE) + i * 2; rp[0] = cosf(ang); rp[1] = sinf(ang); }
    __syncthreads();
    LAS float* sv = (LAS float*)F.lds;
    LAS float* red = (LAS float*)(F.lds + 40960);
    for (int i = F.tid; i < 9 * 1024; i += NTHREADS) { const int j = i >> 10, k = i & 1023; const float cvl = j < 8 ? F.in[1][j * 1024 + k] : F.in[3][k]; sv[i] = cvl * sigmoid_f(cvl); }
    __syncthreads();
    float* mods = (float*)(F.ws + WS_MODS);
    for (int it = F.bx; it < DEPTH * 96; it += F.G) {
        const int l = it / 96, cg_ = it - l * 96, col = F.tid & 63, kg = F.tid >> 6;
        const float* wp = F.in[4] + (size_t)l * D * 6144 + (size_t)(kg * 128) * 6144 + cg_ * 64 + col;
        float acc[9];
#pragma unroll
        for (int j = 0; j < 9; ++j) acc[j] = 0.f;
#pragma unroll 16
        for (int k = 0; k < 128; ++k) { const float w = wp[(size_t)k * 6144];
#pragma unroll
            for (int j = 0; j < 9; ++j) acc[j] += sv[j * 1024 + kg * 128 + k] * w; }
#pragma unroll
        for (int j = 0; j < 9; ++j) red[(kg * 9 + j) * 64 + col] = acc[j];
        __syncthreads();
        for (int i = F.tid; i < 9 * 64; i += NTHREADS) { const int j = i >> 6, c2 = i & 63; float s = F.in[5][l * 6144 + cg_ * 64 + c2];
#pragma unroll
            for (int g = 0; g < 8; ++g) s += red[(g * 9 + j) * 64 + c2];
            mods[((size_t)l * 9 + j) * 6144 + cg_ * 64 + c2] = s;
            const int cidx = cg_ * 64 + c2;
            if (cidx >= 1024 && cidx < 2048) ((float*)(F.ws + WS_STAB))[(((size_t)l * 2 + 0) * 9 + j) * 1024 + cidx - 1024] = F.in[6][l * 1024 + cidx - 1024] * (1.f + s);
            if (cidx >= 4096 && cidx < 5120) ((float*)(F.ws + WS_STAB))[(((size_t)l * 2 + 1) * 9 + j) * 1024 + cidx - 4096] = F.in[7][l * 1024 + cidx - 4096] * (1.f + s); }
        __syncthreads();
    }
}

__device__ __forceinline__ void phase_norm0(const Ctx& F) {
    const int gw = F.bx * NWAVES + F.wave, NGW = F.G * NWAVES; bf16_t* XS = (bf16_t*)(F.ws + WS_XN); float* ssqx = (float*)(F.ws + WS_SSQX);
    const float* stab = (const float*)(F.ws + WS_STAB);
    for (int wu = gw; wu < MALL / 16; wu += NGW) {
        const int r0 = wu * 16; const bool isctx = r0 >= TL; const int mi = isctx ? 8 : (r0 >> 13);
        const float* base = isctx ? F.in[2] + (size_t)(r0 - TL) * D : F.in[0] + (size_t)r0 * D;
        f32x4 S[4];
#pragma unroll
        for (int j = 0; j < 4; ++j) S[j] = *(const f32x4*)(stab + (size_t)mi * 1024 + 4 * F.lane + 256 * j);
        for (int i = 0; i < 16; ++i) {
            const f32x4* xr = (const f32x4*)(base + (size_t)i * D) + F.lane;
            f32x4 v[4]; float s = 0.f;
#pragma unroll
            for (int j = 0; j < 4; ++j) { v[j] = xr[64 * j]; s += (v[j][0] * v[j][0] + v[j][1] * v[j][1]) + (v[j][2] * v[j][2] + v[j][3] * v[j][3]); }
            bf16_t* orow = XS + (size_t)(r0 + i) * D + 4 * F.lane;
#pragma unroll
            for (int j = 0; j < 4; ++j) { const f32x4 o = v[j] * S[j]; u32x2 w; w.x = pk2(o[0], o[1]); w.y = pk2(o[2], o[3]); *(u32x2*)(orow + 256 * j) = w;
                u32x2 wb; wb.x = pk2(v[j][0], v[j][1]); wb.y = pk2(v[j][2], v[j][3]); *(u32x2*)((bf16_t*)(F.ws + WS_XB) + (size_t)(r0 + i) * D + 4 * F.lane + 256 * j) = wb; }
            const float tot = wave_sum(s, F.lane);
            if (F.lane < 4) { f32x4 q = {0.f, 0.f, 0.f, 0.f}; if (F.lane == 0) q[0] = tot; *(f32x4*)(ssqx + (size_t)(r0 + i) * 16 + 4 * F.lane) = q; }
        }
    }
    __syncthreads();
    LAS float* sv = (LAS float*)F.lds;
    LAS float* red = (LAS float*)(F.lds + 40960);
    const float* mods = (const float*)(F.ws + WS_MODS); float* shw = (float*)(F.ws + WS_SHW);
    constexpr int G_IN = 28, G_FF = 64, G_L = G_IN + G_FF;
    for (int it = F.bx; it < DEPTH * G_L; it += F.G) {
        const int l = it / G_L, gi = it - l * G_L; const bool isin = gi < G_IN; const int cg_ = isin ? gi : gi - G_IN;
        const int shoff = isin ? 0 : 3072, N = isin ? DIN : DFF; const float* W = isin ? F.in[8] + (size_t)l * D * DIN : F.in[22] + (size_t)l * D * DFF;
        __syncthreads();
        for (int i = F.tid; i < 9 * 1024; i += NTHREADS) { const int j = i >> 10, k = i & 1023; sv[i] = mods[((size_t)l * 9 + j) * 6144 + shoff + k]; }
        __syncthreads();
        const int col = F.tid & 63, kg = F.tid >> 6, n = cg_ * 64 + col; const bool valid = n < N;
        float acc[9];
#pragma unroll
        for (int j = 0; j < 9; ++j) acc[j] = 0.f;
        if (valid) { const float* wp = W + (size_t)(kg * 128) * N + n;
#pragma unroll 16
            for (int k = 0; k < 128; ++k) { const float w = wp[(size_t)k * N];
#pragma unroll
                for (int j = 0; j < 9; ++j) acc[j] += sv[j * 1024 + kg * 128 + k] * w; } }
#pragma unroll
        for (int j = 0; j < 9; ++j) red[(kg * 9 + j) * 64 + col] = acc[j];
        __syncthreads();
        for (int i = F.tid; i < 9 * 64; i += NTHREADS) { const int j = i >> 6, c2 = i & 63, n2 = cg_ * 64 + c2; float sm = 0.f;
#pragma unroll
            for (int g = 0; g < 8; ++g) sm += red[(g * 9 + j) * 64 + c2];
            if (isin) { if (n2 < DIN) shw[(size_t)l * SHW_L + j * SHW_IN + rowmap(1, n2)] = sm; else shw[(size_t)l * SHW_L + j * SHW_IN + n2] = 0.f; }
            else shw[(size_t)l * SHW_L + 9 * SHW_IN + j * DFF + n2] = sm; }
    }
    __syncthreads();
}
__device__ __forceinline__ void phase_final_norm(const Ctx& F) {
    const int gw = F.bx * NWAVES + F.wave, NGW = F.G * NWAVES; const float* g = F.in[24]; const bf16_t* XB = (const bf16_t*)(F.ws + WS_XB);
    f32x4 S[4];
#pragma unroll
    for (int j = 0; j < 4; ++j) S[j] = *(const f32x4*)(g + 4 * F.lane + 256 * j);
    for (int r = gw; r < TL; r += NGW) {
        f32x4* orow = (f32x4*)(F.out + (size_t)r * D) + F.lane;
        f32x4 v[4]; float s = 0.f;
#pragma unroll
        for (int j = 0; j < 4; ++j) { const u32x2 w = *(const u32x2*)(XB + (size_t)r * D + 4 * F.lane + 256 * j);
            v[j] = (f32x4){__uint_as_float(w.x << 16), __uint_as_float(w.x & 0xffff0000u), __uint_as_float(w.y << 16), __uint_as_float(w.y & 0xffff0000u)};
            s += (v[j][0] * v[j][0] + v[j][1] * v[j][1]) + (v[j][2] * v[j][2] + v[j][3] * v[j][3]); }
        const float rstd = rsqrtf(wave_sum(s, F.lane) * (1.0f / D) + 1e-6f);
#pragma unroll
        for (int j = 0; j < 4; ++j) orow[64 * j] = v[j] * rstd * S[j];
    }
}

__device__ __forceinline__ void phase_ctx_finish(const Ctx& F, const float* gate  , const float* stab  ) {
    const int gw = F.bx * NWAVES + F.wave, NGW = F.G * NWAVES; bf16_t* XB = (bf16_t*)(F.ws + WS_XB); bf16_t* XS = (bf16_t*)(F.ws + WS_XN); float* ssqx = (float*)(F.ws + WS_SSQX);
    const float* P = (const float*)(F.ws + WS_PART);
    for (int rc = gw; rc < TC; rc += NGW) {
        const int row = TL + rc; float s = 0.f;
#pragma unroll
        for (int j = 0; j < 4; ++j) { const int c = 4 * F.lane + 256 * j; const size_t po = (size_t)rc * D + c;
            const f32x4 p = (*(const f32x4*)(P + po) + *(const f32x4*)(P + (size_t)TC * D + po)) + (*(const f32x4*)(P + (size_t)2 * TC * D + po) + *(const f32x4*)(P + (size_t)3 * TC * D + po));
            const u32x2 xr = *(const u32x2*)(XB + (size_t)row * D + c);
            const f32x4 x = {__uint_as_float(xr.x << 16), __uint_as_float(xr.x & 0xffff0000u), __uint_as_float(xr.y << 16), __uint_as_float(xr.y & 0xffff0000u)};
            const f32x4 y = x + *(const f32x4*)(gate + c) * p, t = y * *(const f32x4*)(stab + c);
            u32x2 w; w.x = pk2(y[0], y[1]); w.y = pk2(y[2], y[3]); *(u32x2*)(XB + (size_t)row * D + c) = w;
            u32x2 w2; w2.x = pk2(t[0], t[1]); w2.y = pk2(t[2], t[3]); *(u32x2*)(XS + (size_t)row * D + c) = w2;
            s += (y[0] * y[0] + y[1] * y[1]) + (y[2] * y[2] + y[3] * y[3]); }
        const float tot = wave_sum(s, F.lane);
        if (F.lane < 4) { f32x4 q = {0.f, 0.f, 0.f, 0.f}; if (F.lane == 0) q[0] = tot; *(f32x4*)(ssqx + (size_t)row * 16 + 4 * F.lane) = q; }
    }
}

__device__ __forceinline__ void phase_krope(const Ctx& F) {
    const bf16_t* Z = (const bf16_t*)(F.ws + WS_Z); bf16_t* KR = (bf16_t*)(F.ws + WS_KR); const float* rope = (const float*)(F.ws + WS_ROPE);
    for (int i = F.bx * NTHREADS + F.tid; i < MALL * 4; i += F.G * NTHREADS) {
        const int row = i >> 2, ch = i & 3;
        const u32x4 raw = *(const u32x4*)(Z + (size_t)row * ZP + 640 + ch * 8);
        float a[8];
#pragma unroll
        for (int e = 0; e < 4; ++e) { a[2 * e] = __uint_as_float(raw[e] << 16); a[2 * e + 1] = __uint_as_float(raw[e] & 0xffff0000u); }
        int b, kpos;
        if (row < TL) { b = row >> 13; const int t = row & 8191; kpos = 256 + t; const int g = ch >> 1, j0 = (ch & 1) * 4; const int pos = g ? (t & 63) : (t >> 6);
            const f32x4* tb = (const f32x4*)(rope + (pos * 8 + j0) * 2); const f32x4 c0 = tb[0], c1 = tb[1];
            const float cs[8] = {c0[0], c0[1], c0[2], c0[3], c1[0], c1[1], c1[2], c1[3]};
#pragma unroll
            for (int p = 0; p < 4; ++p) { const float x1 = a[2 * p], x2 = a[2 * p + 1], c = cs[2 * p], s = cs[2 * p + 1]; a[2 * p] = x1 * c - x2 * s; a[2 * p + 1] = x2 * c + x1 * s; } }
        else { const int rc = row - TL; b = rc >> 8; kpos = rc & 255; }
        u32x4 o; o.x = pk2(a[0], a[1]); o.y = pk2(a[2], a[3]); o.z = pk2(a[4], a[5]); o.w = pk2(a[6], a[7]);
        *(u32x4*)(KR + ((size_t)b * LK + kpos) * 32 + ch * 8) = o;
    }
}

__device__ __forceinline__ void phase_conv(const Ctx& F, int l, int nrows, int rot) {
    const bf16_t* Z = (const bf16_t*)(F.ws + WS_Z); bf16_t* Y = (bf16_t*)(F.ws + WS_Y);
    LAS float* yin = (LAS float*)F.lds;
    LAS float* yout = (LAS float*)(F.lds + 65536);
    const float* cw = F.in[13] + (size_t)l * 31 * 256; const float* cb = F.in[14] + l * 256; const float* lg = F.in[15] + l * 256; const float* lb = F.in[16] + l * 256;
    const int c = F.tid & 255, th = F.tid >> 8;
    float w[31];
#pragma unroll
    for (int j = 0; j < 31; ++j) w[j] = cw[j * 256 + c];
    const float bias = cb[c];
    const f32x4 g4 = *(const f32x4*)(lg + 4 * F.lane), b4 = *(const f32x4*)(lb + 4 * F.lane);
    const int nunits = nrows / 32;
    for (int un = (F.bx - rot + F.G) % F.G; un < nunits; un += F.G) {
        const int r0 = un * 32; int s0, s1;
        if (r0 < TL) { s0 = r0 & ~8191; s1 = s0 + 8192; } else { s0 = TL + ((r0 - TL) & ~255); s1 = s0 + 256; }
        __syncthreads();
#pragma unroll
        for (int it_ = 0; it_ < 4; ++it_) { const int it = F.tid + it_ * NTHREADS; if (it >= 62 * 32) break; const int i = it >> 5, ch = it & 31; const int row = r0 - 15 + i;
            f32x4 o0 = {0.f, 0.f, 0.f, 0.f}, o1 = o0;
            if (row >= s0 && row < s1) { const u32x4 ra = *(const u32x4*)(Z + (size_t)row * ZP + 672 + ch * 8), rg = *(const u32x4*)(Z + (size_t)row * ZP + 928 + ch * 8);
#pragma unroll
                for (int e = 0; e < 4; ++e) { const float a0 = __uint_as_float(ra[e] << 16), a1 = __uint_as_float(ra[e] & 0xffff0000u), g0 = __uint_as_float(rg[e] << 16), g1 = __uint_as_float(rg[e] & 0xffff0000u);
                    const float y0 = a0 * sigmoid_f(g0), y1 = a1 * sigmoid_f(g1);
                    if (e < 2) { o0[2 * e] = y0; o0[2 * e + 1] = y1; } else { o1[2 * e - 4] = y0; o1[2 * e - 3] = y1; } } }
            *(LAS f32x4*)(yin + i * 256 + ch * 8) = o0; *(LAS f32x4*)(yin + i * 256 + ch * 8 + 4) = o1; }
        __syncthreads();
        for (int ob = 0; ob < 2; ++ob) {
            const LAS float* xp = yin + (16 * th + 8 * ob) * 256 + c;
            float x[38];
#pragma unroll
            for (int k = 0; k < 38; ++k) x[k] = xp[k * 256];
#pragma unroll
            for (int oo = 0; oo < 8; ++oo) { float a = bias;
#pragma unroll
                for (int j = 0; j < 31; ++j) a += x[oo + j] * w[j];
                yout[(16 * th + 8 * ob + oo) * 256 + c] = a; }
        }
        __syncthreads();
#pragma unroll
        for (int i = 0; i < 4; ++i) { const int tk = F.wave * 4 + i; const f32x4 v = *(LAS f32x4*)(yout + tk * 256 + 4 * F.lane);
            const float mu = wave_sum((v[0] + v[1]) + (v[2] + v[3]), F.lane) * (1.0f / 256.0f); const f32x4 dv = v - mu;
            const float var = wave_sum((dv[0] * dv[0] + dv[1] * dv[1]) + (dv[2] * dv[2] + dv[3] * dv[3]), F.lane) * (1.0f / 256.0f);
            const float rstd = rsqrtf(var + 1e-6f); f32x4 y = dv * rstd * g4 + b4;
#pragma unroll
            for (int e = 0; e < 4; ++e) y[e] = y[e] * sigmoid_f(y[e]);
            u32x2 wv; wv.x = pk2(y[0], y[1]); wv.y = pk2(y[2], y[3]); *(u32x2*)(Y + (size_t)(r0 + tk) * D + 512 + 4 * F.lane) = wv; }
    }
    __syncthreads();
}

__device__ __forceinline__ void phase_sgu(const Ctx& F, int l, int nrows, int rot) {
    const bf16_t* Z = (const bf16_t*)(F.ws + WS_Z); bf16_t* Y = (bf16_t*)(F.ws + WS_Y);
    const float* lg = F.in[17] + l * 256; const float* lb = F.in[18] + l * 256; const float* sw = F.in[19] + (size_t)l * 4 * 128 * 128; const float* sb = F.in[20] + l * 4 * 128;
    const int lane = F.lane, r32 = lane & 31, hi = lane >> 5;
    const int c8 = (lane & 31) * 8;
    f32x4 g0 = *(const f32x4*)(lg + c8), g1 = *(const f32x4*)(lg + c8 + 4), b0 = *(const f32x4*)(lb + c8), b1 = *(const f32x4*)(lb + c8 + 4);
    const int nunits = nrows / 128;
    for (int un = (F.bx - rot + F.G) % F.G; un < nunits; un += F.G) {
        const int r0 = un * 128;
        __syncthreads();
#pragma unroll
        for (int i = 0; i < 8; ++i) { const int q = F.wave * 16 + 2 * i + hi; const u32x4 raw = *(const u32x4*)(Z + (size_t)(r0 + q) * ZP + 1440 + c8);
            float a[8]; float s = 0.f;
#pragma unroll
            for (int e = 0; e < 4; ++e) { a[2 * e] = gelu_tanh(__uint_as_float(raw[e] << 16)); a[2 * e + 1] = gelu_tanh(__uint_as_float(raw[e] & 0xffff0000u)); s += a[2 * e] + a[2 * e + 1]; }
            s = half_sum(s);
            const float mu = s * (1.0f / 256.0f); float q2 = 0.f;
#pragma unroll
            for (int e = 0; e < 8; ++e) { a[e] -= mu; q2 += a[e] * a[e]; }
            q2 = half_sum(q2);
            const float rstd = rsqrtf(q2 * (1.0f / 256.0f) + 1e-6f);
            u32x4 o4; o4.x = pk2(a[0] * rstd * g0[0] + b0[0], a[1] * rstd * g0[1] + b0[1]); o4.y = pk2(a[2] * rstd * g0[2] + b0[2], a[3] * rstd * g0[3] + b0[3]);
            o4.z = pk2(a[4] * rstd * g1[0] + b1[0], a[5] * rstd * g1[1] + b1[1]); o4.w = pk2(a[6] * rstd * g1[2] + b1[2], a[7] * rstd * g1[3] + b1[3]);
            *(u32x4*)(F.ldsg + (c8 >> 6) * 16384 + (q >> 6) * 8192 + att::v_st(q & 63, c8 & 63)) = o4; }
        __syncthreads();
        const int h = F.wave >> 1, ph = F.wave & 1;
        f32x16 o[2][2] = {};
#pragma unroll
        for (int kt = 0; kt < 2; ++kt) { const int vb = (int)(uintptr_t)F.ldsg + h * 16384 + kt * 8192 + att::v_rd_base(lane);
#pragma unroll
            for (int mt = 0; mt < 2; ++mt) { bf16x8 pa[4]; const float* wr_ = sw + ((size_t)h * 128 + ph * 64 + mt * 32 + r32) * 128 + kt * 64 + hi * 8;
#pragma unroll
                for (int ks = 0; ks < 4; ++ks) { const f32x4 w0 = *(const f32x4*)(wr_ + ks * 16), w1 = *(const f32x4*)(wr_ + ks * 16 + 4); const u32x4 pw = pg8::pack8(w0, w1); pa[ks] = *reinterpret_cast<const bf16x8*>(&pw); }
                att::pv_one<0>(o[mt][0], vb, pa[0], pa[1], pa[2], pa[3]); att::pv_one<1>(o[mt][1], vb, pa[0], pa[1], pa[2], pa[3]); } }
        {
            LAS bf16_t* mx = (LAS bf16_t*)(F.lds + 65536);
#pragma unroll
            for (int mt = 0; mt < 2; ++mt)
#pragma unroll
                for (int r = 0; r < 16; ++r) { const int p = ph * 64 + mt * 32 + att::crow(r, hi); const float bs = sb[h * 128 + p];
#pragma unroll
                    for (int d0 = 0; d0 < 2; ++d0) { const float v = o[mt][d0][r] + bs; mx[p * 256 + h * 64 + d0 * 32 + r32] = (bf16_t)(pk2(v, v) & 0xffffu); } }
            __syncthreads();
#pragma unroll
            for (int it_ = 0; it_ < 8; ++it_) { const int it = F.tid + it_ * NTHREADS; const int p = it >> 5, ch = it & 31;
                const u32x4 mraw = *(const LAS u32x4*)(mx + p * 256 + ch * 8);
                const u32x4 zraw = *(const u32x4*)(Z + (size_t)(r0 + p) * ZP + 1184 + ch * 8);
                float ov[8];
#pragma unroll
                for (int e = 0; e < 4; ++e) { ov[2 * e] = gelu_tanh(__uint_as_float(zraw[e] << 16)) * __uint_as_float(mraw[e] << 16); ov[2 * e + 1] = gelu_tanh(__uint_as_float(zraw[e] & 0xffff0000u)) * __uint_as_float(mraw[e] & 0xffff0000u); }
                u32x4 o4; o4.x = pk2(ov[0], ov[1]); o4.y = pk2(ov[2], ov[3]); o4.z = pk2(ov[4], ov[5]); o4.w = pk2(ov[6], ov[7]);
                *(u32x4*)(Y + (size_t)(r0 + p) * D + 768 + ch * 8) = o4; }
        }
    }
    __syncthreads();
}

__device__ __forceinline__ void phase_attn(const Ctx& F, bool with_ctx) {
    const bf16_t* Q = (const bf16_t*)(F.ws + WS_Q); const bf16_t* KN = (const bf16_t*)(F.ws + WS_KN); const bf16_t* KR = (const bf16_t*)(F.ws + WS_KR); const bf16_t* V = (const bf16_t*)(F.ws + WS_V);
    bf16_t* Y = (bf16_t*)(F.ws + WS_Y);
    const int nlat = BATCH * 8 * 32, ntot = nlat + (with_ctx ? BATCH * 8 : 0);
    __syncthreads();
    for (int U = F.vcu; U < ntot; U += F.G) {
        int bh, row0, nkeys;
        if (U < nlat) { bh = U >> 5; const int qb = U & 31; row0 = (bh >> 3) * SEQ + qb * 256; nkeys = LK; }
        else { bh = U - nlat; row0 = TL + (bh >> 3) * CTXL; nkeys = CTXL; }
        const int b = bh >> 3, h = bh & 7;
        att::attn_unit(Q + (size_t)row0 * 768 + h * 96, KN + (size_t)bh * LK * 64, KR + (size_t)b * LK * 32, V + (size_t)bh * LK * 64, Y + (size_t)row0 * D + h * 64, nkeys, (char*)F.ldsg, F.tid);
    }
}

__global__ void __launch_bounds__(NTHREADS, 2) mega_fwd(Args args) {
    extern __shared__ __attribute__((aligned(16))) unsigned char lds[];
    Ctx F; F.lds = (LAS unsigned char*)lds; F.ldsg = lds; F.in = args.in; F.out = args.out; F.ws = args.ws;
    const int wave_s = __builtin_amdgcn_readfirstlane((int)threadIdx.x >> 6); F.tid = 0; F.lane = 0; F.wave = wave_s; F.G = gridDim.x; F.bx = blockIdx.x;
    F.vcu = (F.G % 8 == 0) ? (F.bx % 8) * (F.G / 8) + F.bx / 8 : F.bx;
    const bool multi = (args.ph_hi - args.ph_lo) > 1;
    volatile LAS unsigned* bst = (volatile LAS unsigned*)(F.lds + LDS_BYTES - 64);
    if (threadIdx.x < 2) bst[threadIdx.x] = 0u;
    __syncthreads();
    XcdBarrier gbar; gbar.bar = (unsigned*)args.ws; gbar.x = 0; gbar.st = nullptr;
    if (multi) gbar = xcd_barrier_post((unsigned*)args.ws, bst);
    const int ph_lo_u = __builtin_amdgcn_readfirstlane(args.ph_lo), ph_hi_u = __builtin_amdgcn_readfirstlane(args.ph_hi);
    for (int ph = ph_lo_u; ph < ph_hi_u; ++ph) {
#define SETLANE() do { int l_; asm volatile("v_mbcnt_lo_u32_b32 %0, -1, 0\n\tv_mbcnt_hi_u32_b32 %0, -1, %0" : "=&v"(l_)); F.lane = l_; F.tid = wave_s * 64 + l_; F.wave = wave_s; } while (0)
        { int z_ = 0; asm volatile("s_mov_b32 %0, 0" : "=s"(z_)); F.ws = args.ws + z_; F.out = args.out + z_; F.in = args.in + z_; }
        float* mods = (float*)(F.ws + WS_MODS); float* ssq = (float*)(F.ws + WS_SSQ); float* cx = (float*)(F.ws + WS_CX); const float* rope = (const float*)(F.ws + WS_ROPE);
        bf16_t* XN = (bf16_t*)(F.ws + WS_XN); bf16_t* Z = (bf16_t*)(F.ws + WS_Z); bf16_t* Qb = (bf16_t*)(F.ws + WS_Q); bf16_t* Y = (bf16_t*)(F.ws + WS_Y); bf16_t* H = (bf16_t*)(F.ws + WS_H);
        float* ssqx = (float*)(F.ws + WS_SSQX); const float* shw = (const float*)(F.ws + WS_SHW); const float* stab = (const float*)(F.ws + WS_STAB);
        if (ph == 0) { if (PHM & 1) REPS(1) { SETLANE(); phase_prologue(F); } }
        else if (ph == 1) { if (PHM & 4) REPS(4) { SETLANE(); phase_norm0(F); } }
        else if (ph == 2 + 6 * DEPTH) { if (PHM & 2) REPS(2) { SETLANE(); phase_final_norm(F); } }
        else {
            const int l = (ph - 2) / 6, sub = (ph - 2) - 6 * l; const bool last = (l == DEPTH - 1); const float* mods_l = mods + (size_t)l * 9 * 6144;
            const int Mx = last ? TL : MALL;
            if (sub == 0) { if (PHM & 8) REPS(8) { SETLANE(); pg8::Gemm g{XN, (const bf16_t*)(F.ws + WS_WIN) + (size_t)l * ZP * D, MALL, ZP, D, D}; pg8::StaticOrder S; S.init(MALL, ZP, F.G, F.bx);
                pg8::EpiZ E{Z, ssq, ssqx, shw + (size_t)l * SHW_L}; pg8::gemm_phase<pg8::EpiZ, pg8::StaticOrder, true, true, 1024, 1024>(F.lds, g, S, E, F.tid); } }
            else if (sub == 1) {
                if (PHM & 16) REPS(16) { SETLANE(); pg8::Gemm g{Z, (const bf16_t*)(F.ws + WS_WUQ) + (size_t)l * 768 * 384, Mx, 768, 384, ZP}; pg8::StaticOrder S; S.init(Mx, 768, F.G, F.bx);
                  pg8::EpiQ E{Qb, ssq, rope}; pg8::gemm_phase<pg8::EpiQ, pg8::StaticOrder, true, true, 384, 1792>(F.lds, g, S, E, F.tid); }
                if (PHM & 32) REPS(32) { SETLANE(); pg8::Gemm g{Z + 384, (const bf16_t*)(F.ws + WS_WUKV) + (size_t)l * 1024 * 256, MALL, 1024, 256, ZP}; pg8::StaticOrder S; S.init(MALL, 1024, F.G, (F.bx - 24 + F.G) % F.G);
                  pg8::EpiKV E{(bf16_t*)(F.ws + WS_KN), (bf16_t*)(F.ws + WS_V), ssq}; pg8::gemm_phase<pg8::EpiKV, pg8::StaticOrder, true, true, 256, 1792>(F.lds, g, S, E, F.tid); }
                if (PHM & 64) REPS(64) { SETLANE(); phase_conv(F, l, Mx, 56); }
                if (PHM & 128) REPS(128) { SETLANE(); phase_sgu(F, l, Mx, 88); }
                if (PHM & 256) REPS(256) { SETLANE(); phase_krope(F); }
            }
            else if (sub == 2) { if (PHM & 512) REPS(512) { SETLANE(); phase_attn(F, !last); } }
            else if (sub == 3) { if (PHM & 1024) REPS(1024) { SETLANE(); pg8::Gemm g{Y, (const bf16_t*)(F.ws + WS_WOUT) + (size_t)l * D * D, Mx, D, D, D}; pg8::StaticOrder S; S.init(Mx, D, F.G, F.bx);
                pg8::EpiRes E{(bf16_t*)(F.ws + WS_XB), mods_l + 2048, XN, ssqx, stab + ((size_t)l * 2 + 1) * 9 * 1024};
                pg8::gemm_phase<pg8::EpiRes, pg8::StaticOrder, true, true, 1024, 1024>(F.lds, g, S, E, F.tid); } }
            else if (sub == 4) { if (PHM & 4096) REPS(4096) { SETLANE();
                unsigned* cnt = (unsigned*)F.ws + 3600 + 64 * l;
                const bf16_t* W1 = (const bf16_t*)(F.ws + WS_W1) + (size_t)l * DFF * D;
                if (!last) {
                    pg8::Gemm g{XN + (size_t)TL * D, W1, TC, DFF, D, D}; pg8::CountingOrder S; S.S.init(TC, DFF, F.G, F.bx); S.cnt = cnt;
                    pg8::EpiFF1 E{H, ssqx, shw + (size_t)l * SHW_L + 9 * SHW_IN, TL}; pg8::gemm_phase<pg8::EpiFF1, pg8::CountingOrder, true, true, 1024, 1024>(F.lds, g, S, E, F.tid); }
                SETLANE();
                {
                    pg8::Gemm g{XN, W1, TL, DFF, D, D}; pg8::StaticOrder S; S.init(TL, DFF, F.G, F.bx);
                    pg8::EpiFF1 E{H, ssqx, shw + (size_t)l * SHW_L + 9 * SHW_IN, 0}; pg8::gemm_phase<pg8::EpiFF1, pg8::StaticOrder, true, true, 1024, 1024>(F.lds, g, S, E, F.tid); }
                SETLANE();
                if (!last) {
                    const int q = F.bx - 128; const bool mine = q >= 0 && q < 128; const int ks = q >> 5, t = q & 31;
                    if (mine) {
                        if (F.tid == 0) { unsigned sp = 0; while (__hip_atomic_load(cnt, __ATOMIC_RELAXED, __HIP_MEMORY_SCOPE_AGENT) < 1024u) { __builtin_amdgcn_s_sleep(2); if (++sp > (1u << 22)) break; } }
                        __syncthreads(); __builtin_amdgcn_fence(__ATOMIC_ACQUIRE, "agent"); asm volatile("s_waitcnt vmcnt(0)" ::: "memory"); }
                    pg8::Gemm g{H + (size_t)TL * DFF + (mine ? ks : 0) * 1024, (const bf16_t*)(F.ws + WS_W2) + (size_t)l * D * DFF + (mine ? ks : 0) * 1024, TC, D, 1024, DFF};
                    pg8::OneUnit S{t >> 2, t & 3, mine};
                    pg8::EpiPart E{(float*)(F.ws + WS_PART) + (size_t)(mine ? ks : 0) * TC * D}; pg8::gemm_phase<pg8::EpiPart, pg8::OneUnit, true, true, 1024, 4096, 4096>(F.lds, g, S, E, F.tid); }
                } }
            else { if (PHM & 8192) REPS(8192) { SETLANE();
                if (!last) phase_ctx_finish(F, mods_l + 5120 + 8 * 6144, stab + ((size_t)(l + 1) * 2 + 0) * 9 * 1024 + 8 * 1024);
                SETLANE();
                pg8::Gemm g{H, (const bf16_t*)(F.ws + WS_W2) + (size_t)l * D * DFF, TL, D, DFF, DFF}; pg8::StaticOrder S; S.init(TL, D, F.G, F.bx);
                pg8::EpiRes E{(bf16_t*)(F.ws + WS_XB), mods_l + 5120, XN, ssqx, last ? (const float*)nullptr : stab + ((size_t)(l + 1) * 2 + 0) * 9 * 1024};
                pg8::gemm_phase<pg8::EpiRes, pg8::StaticOrder, true, true, 4096, 4096>(F.lds, g, S, E, F.tid); } }
        }
        if (ph + 1 < ph_hi_u) { if (ph == ph_lo_u) cg::this_grid().sync(); else xcd_barrier(gbar); }
    }
}

constexpr int NPHASES = 3 + 6 * DEPTH;
extern "C" void kernel_launch(void* const* d_in, const int* in_sizes, int n_in, void* d_out, int out_size, void* d_ws, size_t ws_size, hipStream_t stream) {
    static int grid = 0;
    if (grid == 0) {
        if (n_in != 25 || out_size != TL * D || ws_size < WS_END2) { fprintf(stderr, "kernel_launch: unexpected shapes: n_in %d out %d ws %zu (need %zu)\n", n_in, out_size, ws_size, (size_t)WS_END2); grid = -1; return; }
        int dev = 0, cus = 0, per_cu = 0;
        hipGetDevice(&dev); hipDeviceGetAttribute(&cus, hipDeviceAttributeMultiprocessorCount, dev);
        if (hipFuncSetAttribute((const void*)mega_fwd, hipFuncAttributeMaxDynamicSharedMemorySize, LDS_BYTES) != hipSuccess) { fprintf(stderr, "kernel_launch: hipFuncSetAttribute failed\n"); grid = -1; return; }
        if (hipOccupancyMaxActiveBlocksPerMultiprocessor(&per_cu, (const void*)mega_fwd, NTHREADS, LDS_BYTES) != hipSuccess || per_cu < 1) { fprintf(stderr, "kernel_launch: occupancy query says %d\n", per_cu); per_cu = 1; }
        (void)hipGetLastError();
        grid = cus * 1;
    }
    if (grid < 0) return;
    Args a{};
    for (int i = 0; i < 25; ++i) a.in[i] = (const float*)d_in[i];
    a.out = (float*)d_out; a.ws = (unsigned char*)d_ws;
#if ONE_LAUNCH
    if (hipMemsetAsync(d_ws, 0, 16384, stream) != hipSuccess) { fprintf(stderr, "kernel_launch: memset of barrier words failed\n"); return; }
    a.ph_lo = 0; a.ph_hi = NPHASES;
    void* kargs[] = {&a};
    hipError_t e = hipLaunchCooperativeKernel((const void*)mega_fwd, dim3(grid), dim3(NTHREADS), kargs, LDS_BYTES, stream);
    if (e != hipSuccess) fprintf(stderr, "cooperative launch failed: %s (grid %d)\n", hipGetErrorString(e), grid);
#else
    for (int ph = 0; ph < NPHASES; ++ph) { a.ph_lo = ph; a.ph_hi = ph + 1; hipLaunchKernelGGL(mega_fwd, dim3(grid), dim3(NTHREADS), LDS_BYTES, stream, a); }
#endif
}
```

```cpp
#include <hip/hip_runtime.h>
#include <hip/hip_bf16.h>
#include <hip/hip_cooperative_groups.h>
#include <cstdio>
#include <cstdint>
namespace cg = cooperative_groups;
#ifndef PHM
#define PHM 0xffff
#endif
#ifndef DUPM
#define DUPM 0
#endif
#define REPS(bit) for (int rep_ = 0, nrep_ = nrep_of((DUPM & (bit)) ? 2 : 1); rep_ < nrep_; ++rep_)
#ifndef ONE_LAUNCH
#define ONE_LAUNCH 1
#endif
typedef unsigned short bf16_t;
__device__ __forceinline__ float shx(float v, int o, int lane) { return __int_as_float(__builtin_amdgcn_ds_bpermute((lane ^ o) << 2, __float_as_int(v))); }
constexpr int T_LAT = 65536, ZP = 1792, LK = 8448;
namespace pg8 {
#define PG8_LAS __attribute__((address_space(3)))
typedef unsigned short bf16_t;
typedef short bf16x8 __attribute__((ext_vector_type(8)));
typedef float f32x4 __attribute__((ext_vector_type(4)));
typedef unsigned u32x4 __attribute__((ext_vector_type(4)));
constexpr int BM = 256, BK = 64, HALF = 128, HTB = HALF * BK * 2  , STAGE_BYTES = 8 * HTB, NXCD = 8, WGM = 8;

__host__ __device__ __forceinline__ int lds_byte(int r, int c) { const int st = (r >> 4) * 2 + (c >> 5), rr = r & 15, cc = c & 31, ob = rr * 64 + cc * 2; return st * 1024 + (ob ^ (((ob >> 9) & 1) << 5)); }
__host__ __device__ __forceinline__ void stage_rc(int b, int& R, int& C) { const int st = b / 1024, sb = b % 1024, swz = sb ^ (((sb >> 9) & 1) << 5); R = (st >> 1) * 16 + swz / 64; C = (st & 1) * 32 + (swz % 64) / 2; }
__host__ __device__ __forceinline__ int perm32(int rho) { const int n = rho >> 4, i = rho & 15; return 8 * (i >> 2) + 4 * n + (i & 3); }

struct Unit { int pm, pn; };
struct Gemm { const bf16_t* A; const bf16_t* Bt; int M, N, K, lda; };

struct StaticOrder {
    int nM, nN, nwg, G, c;
    __host__ __device__ void init(int M, int N, int G_, int c_) { nM = M / BM; nN = N / BM; nwg = nM * nN; G = G_; c = c_; }
    __host__ __device__ bool next(int i, Unit& u) const {
        const long L = (long)i * G + c; if (L >= nwg) return false;
        int wgid = (int)L; { const int q = nwg / NXCD, r = nwg % NXCD, xcd = wgid % NXCD, off = wgid / NXCD; wgid = (xcd < r ? xcd * (q + 1) : r * (q + 1) + (xcd - r) * q) + off; }
        const int nig = WGM * nN, gid = wgid / nig, fm = gid * WGM, gsz = (nM - fm) < WGM ? (nM - fm) : WGM;
        u.pm = fm + ((wgid % nig) % gsz); u.pn = (wgid % nig) / gsz; return true;
    }
    __device__ __forceinline__ void a_ready(const Unit&) const {}
    __device__ __forceinline__ void done(const Unit&) const {}
};

struct OneUnit {
    int pm, pn; bool valid;
    __device__ __forceinline__ bool next(int i, Unit& u) const { if (i != 0 || !valid) return false; u.pm = pm; u.pn = pn; return true; }
    __device__ __forceinline__ void a_ready(const Unit&) const {}
    __device__ __forceinline__ void done(const Unit&) const {}
};
struct CountingOrder {
    StaticOrder S; unsigned* cnt;
    __device__ __forceinline__ bool next(int i, Unit& u) const { return S.next(i, u); }
    __device__ __forceinline__ void a_ready(const Unit&) const {}
    __device__ __forceinline__ void done(const Unit&) const {
        __builtin_amdgcn_fence(__ATOMIC_RELEASE, "agent"); asm volatile("s_waitcnt vmcnt(0)" ::: "memory");
        int ln_; asm volatile("v_mbcnt_lo_u32_b32 %0, -1, 0\n\tv_mbcnt_hi_u32_b32 %0, -1, %0" : "=&v"(ln_));
        if (ln_ == 0) __hip_atomic_fetch_add(cnt, 1u, __ATOMIC_RELAXED, __HIP_MEMORY_SCOPE_AGENT);
    }
};
__device__ __forceinline__ unsigned cvt_pk_bf16(float lo, float hi) { unsigned r; asm volatile("v_cvt_pk_bf16_f32 %0, %1, %2" : "=v"(r) : "v"(lo), "v"(hi)); return r; }
__device__ __forceinline__ u32x4 pack8(f32x4 v0, f32x4 v1) { u32x4 w; w.x = cvt_pk_bf16(v0[0], v0[1]); w.y = cvt_pk_bf16(v0[2], v0[3]); w.z = cvt_pk_bf16(v1[0], v1[1]); w.w = cvt_pk_bf16(v1[2], v1[3]); return w; }

__device__ __forceinline__ float sum_fq(float s) {
    { auto r = __builtin_amdgcn_permlane16_swap(__float_as_uint(s), __float_as_uint(s), false, false); s = __uint_as_float(r[0]) + __uint_as_float(r[1]); }
    { auto r = __builtin_amdgcn_permlane32_swap(__float_as_uint(s), __float_as_uint(s), false, false); s = __uint_as_float(r[0]) + __uint_as_float(r[1]); }
    return s;
}
__device__ __forceinline__ float row_rstd16_q(const float* ssqx, int row, int fq) {
    const f32x4 s0 = *(const f32x4*)(ssqx + (size_t)row * 16 + 4 * fq); float s = (s0[0] + s0[1]) + (s0[2] + s0[3]);
    { auto r = __builtin_amdgcn_permlane16_swap(__float_as_uint(s), __float_as_uint(s), false, false); s = __uint_as_float(r[0]) + __uint_as_float(r[1]); }
    { auto r = __builtin_amdgcn_permlane32_swap(__float_as_uint(s), __float_as_uint(s), false, false); s = __uint_as_float(r[0]) + __uint_as_float(r[1]); }
    return rsqrtf(s * (1.0f / 1024.0f) + 1e-6f);
}
__device__ __forceinline__ float row_rstd16(const float* ssqx, int row) {
    const f32x4* sp = (const f32x4*)(ssqx + (size_t)row * 16); const f32x4 s0 = sp[0], s1 = sp[1], s2 = sp[2], s3 = sp[3];
    const float ss = (((s0[0] + s0[1]) + (s0[2] + s0[3])) + ((s1[0] + s1[1]) + (s1[2] + s1[3]))) + (((s2[0] + s2[1]) + (s2[2] + s2[3])) + ((s3[0] + s3[1]) + (s3[2] + s3[3])));
    return rsqrtf(ss * (1.0f / 1024.0f) + 1e-6f);
}
struct EpiZ {
    static constexpr bool PERM = true, AFTER_DRAIN = false;
    bf16_t* Z; float* ssq; const float* ssqx; const float* shw;
    __device__ __forceinline__ void operator()(const f32x4 (&acc)[2][2][4][2], const Unit& u, int wr, int wc, int fr, int fq) const {
        const int row0 = u.pm * BM + wr * 64 + fr, col0 = u.pn * BM + wc * 32 + 8 * fq;
        const int mi = (u.pm * BM >= T_LAT) ? 8 : ((u.pm * BM) >> 13);
        float rs[2][4];
#pragma unroll
        for (int ai = 0; ai < 2; ++ai) {
#pragma unroll
            for (int m = 0; m < 4; ++m) { rs[ai][m] = row_rstd16_q(ssqx, row0 + ai * HALF + m * 16, fq); if (m & 1) asm volatile("" : "+v"(rs[ai][m - 1]), "+v"(rs[ai][m]) :: "memory"); } }
        f32x4 sw[2][2];
#pragma unroll
        for (int bj = 0; bj < 2; ++bj) { sw[bj][0] = *(const f32x4*)(shw + mi * 1792 + col0 + bj * HALF); sw[bj][1] = *(const f32x4*)(shw + mi * 1792 + col0 + bj * HALF + 4); }
#pragma unroll
        for (int ai = 0; ai < 2; ++ai)
#pragma unroll
            for (int m = 0; m < 4; ++m) { const int row = row0 + ai * HALF + m * 16; bf16_t* rowp = Z + (size_t)row * ZP + col0; const float r_ = rs[ai][m];
#pragma unroll
                for (int bj = 0; bj < 2; ++bj) { const f32x4 v0 = acc[ai][bj][m][0] * r_ + sw[bj][0], v1 = acc[ai][bj][m][1] * r_ + sw[bj][1];
                    *(u32x4*)(rowp + bj * HALF) = pack8(v0, v1);
                    const int hh = u.pn * 2 + bj;
                    if (hh < 5) { float s = (v0[0] * v0[0] + v0[1] * v0[1]) + (v0[2] * v0[2] + v0[3] * v0[3]) + (v1[0] * v1[0] + v1[1] * v1[1]) + (v1[2] * v1[2] + v1[3] * v1[3]);
                        s = sum_fq(s);
                        if (fq == 0) ssq[(size_t)row * 20 + hh * 4 + wc] = s; } }
                asm volatile("" ::: "memory"); }
    }
};
struct EpiQ {
    static constexpr bool PERM = true, AFTER_DRAIN = false;
    bf16_t* Q; const float* ssq; const float* rope;
    __device__ __forceinline__ void operator()(const f32x4 (&acc)[2][2][4][2], const Unit& u, int wr, int wc, int fr, int fq) const {
        const int row0 = u.pm * BM + wr * 64 + fr, col0 = u.pn * BM + wc * 32 + 8 * fq;
        float rsq[2][4];
#pragma unroll
        for (int ai = 0; ai < 2; ++ai) {
#pragma unroll
            for (int m = 0; m < 4; ++m) { f32x4 s0 = {0.f, 0.f, 0.f, 0.f}; if (fq < 3) s0 = *(const f32x4*)(ssq + (size_t)(row0 + ai * HALF + m * 16) * 20 + 4 * fq);
                const float ss = sum_fq((s0[0] + s0[1]) + (s0[2] + s0[3]));
                rsq[ai][m] = rsqrtf(ss * (1.0f / 384.0f) + 1e-6f) * 0.14724444653041276f;
                if (m & 1) asm volatile("" : "+v"(rsq[ai][m - 1]), "+v"(rsq[ai][m]) :: "memory"); } }
#pragma unroll
        for (int ai = 0; ai < 2; ++ai)
#pragma unroll
            for (int m = 0; m < 4; ++m) { const int row = row0 + ai * HALF + m * 16;
                const float rstd = rsq[ai][m];
                const bool lat = row < T_LAT; const int t = row & 8191;
#pragma unroll
                for (int bj = 0; bj < 2; ++bj) { const int c = col0 + bj * HALF; const int d = c % 96;
                    f32x4 v0 = acc[ai][bj][m][0] * rstd, v1 = acc[ai][bj][m][1] * rstd;
                    if (lat && d >= 64) { const int p0 = d - 64, g = p0 >> 4, j0 = (p0 & 15) >> 1; const int pos = g ? (t & 63) : (t >> 6);
                        const f32x4* tb = (const f32x4*)(rope + (pos * 8 + j0) * 2); const f32x4 c0 = tb[0], c1 = tb[1];
                        f32x4 r0, r1;
                        r0[0] = v0[0] * c0[0] - v0[1] * c0[1]; r0[1] = v0[1] * c0[0] + v0[0] * c0[1];
                        r0[2] = v0[2] * c0[2] - v0[3] * c0[3]; r0[3] = v0[3] * c0[2] + v0[2] * c0[3];
                        r1[0] = v1[0] * c1[0] - v1[1] * c1[1]; r1[1] = v1[1] * c1[0] + v1[0] * c1[1];
                        r1[2] = v1[2] * c1[2] - v1[3] * c1[3]; r1[3] = v1[3] * c1[2] + v1[2] * c1[3];
                        v0 = r0; v1 = r1; }
                    *(u32x4*)(Q + (size_t)row * 768 + c) = pack8(v0, v1); }
                asm volatile("" ::: "memory"); }
    }
};
struct EpiKV {
    static constexpr bool PERM = true, AFTER_DRAIN = false;
    bf16_t* KN; bf16_t* V; const float* ssq;
    __device__ __forceinline__ void operator()(const f32x4 (&acc)[2][2][4][2], const Unit& u, int wr, int wc, int fr, int fq) const {
        const int row0 = u.pm * BM + wr * 64 + fr; const int d = (wc & 1) * 32 + 8 * fq; bf16_t* dst = (wc < 2) ? KN : V;
        float rsq[2][4];
#pragma unroll
        for (int ai = 0; ai < 2; ++ai)
#pragma unroll
            for (int m = 0; m < 4; ++m) { f32x4 s0 = {0.f, 0.f, 0.f, 0.f}; if (fq < 2) s0 = *(const f32x4*)(ssq + (size_t)(row0 + ai * HALF + m * 16) * 20 + 12 + 4 * fq);
                const float ss = sum_fq((s0[0] + s0[1]) + (s0[2] + s0[3]));
                rsq[ai][m] = rsqrtf(ss * (1.0f / 256.0f) + 1e-6f); if (m == 3) asm volatile("" : "+v"(rsq[ai][0]), "+v"(rsq[ai][1]), "+v"(rsq[ai][2]), "+v"(rsq[ai][3]) :: "memory"); }
#pragma unroll
        for (int ai = 0; ai < 2; ++ai)
#pragma unroll
            for (int m = 0; m < 4; ++m) { const int row = row0 + ai * HALF + m * 16;
                const float rstd = rsq[ai][m];
                int b, kpos; if (row < T_LAT) { b = row >> 13; kpos = 256 + (row & 8191); } else { const int rc = row - T_LAT; b = rc >> 8; kpos = rc & 255; }
#pragma unroll
                for (int bj = 0; bj < 2; ++bj) { const int head = u.pn * 2 + bj;
                    const f32x4 v0 = acc[ai][bj][m][0] * rstd, v1 = acc[ai][bj][m][1] * rstd;
                    *(u32x4*)(dst + ((size_t)(b * 8 + head) * LK + kpos) * 64 + d) = pack8(v0, v1); }
                asm volatile("" ::: "memory"); }
    }
};
struct EpiRes {
    static constexpr bool PERM = true, AFTER_DRAIN = false;
    bf16_t* XB; const float* gate;
    bf16_t* XS; float* ssqx; const float* stab;
    __device__ __forceinline__ void operator()(const f32x4 (&acc)[2][2][4][2], const Unit& u, int wr, int wc, int fr, int fq) const {
        const int trow = u.pm * BM; const int mi = (trow >= T_LAT) ? 8 : (trow >> 13);
        const int row0 = trow + wr * 64 + fr, col0 = u.pn * BM + wc * 32 + 8 * fq;
        f32x4 gv[2][2];
#pragma unroll
        for (int bj = 0; bj < 2; ++bj) { gv[bj][0] = *(const f32x4*)(gate + mi * 6144 + col0 + bj * HALF); gv[bj][1] = *(const f32x4*)(gate + mi * 6144 + col0 + bj * HALF + 4); }
        f32x4 tv[2][2] = {};
        if (stab) {
#pragma unroll
            for (int bj = 0; bj < 2; ++bj) { tv[bj][0] = *(const f32x4*)(stab + mi * 1024 + col0 + bj * HALF); tv[bj][1] = *(const f32x4*)(stab + mi * 1024 + col0 + bj * HALF + 4); } }
#pragma unroll
        for (int ai = 0; ai < 2; ++ai) {
            u32x4 xv[4][2];
#pragma unroll
            for (int m = 0; m < 4; ++m) { const size_t off = (size_t)(row0 + ai * HALF + m * 16) * 1024 + col0;
#pragma unroll
                for (int bj = 0; bj < 2; ++bj) xv[m][bj] = *(const u32x4*)(XB + off + bj * HALF); }
#pragma unroll
            for (int m = 0; m < 4; ++m) { const size_t off = (size_t)(row0 + ai * HALF + m * 16) * 1024 + col0;
                float sq = 0.f;
#pragma unroll
                for (int bj = 0; bj < 2; ++bj) { const u32x4 xr = xv[m][bj];
                    const f32x4 x0 = {__uint_as_float(xr[0] << 16), __uint_as_float(xr[0] & 0xffff0000u), __uint_as_float(xr[1] << 16), __uint_as_float(xr[1] & 0xffff0000u)};
                    const f32x4 x1 = {__uint_as_float(xr[2] << 16), __uint_as_float(xr[2] & 0xffff0000u), __uint_as_float(xr[3] << 16), __uint_as_float(xr[3] & 0xffff0000u)};
                    const f32x4 y0 = x0 + gv[bj][0] * acc[ai][bj][m][0], y1 = x1 + gv[bj][1] * acc[ai][bj][m][1];
                    *(u32x4*)(XB + off + bj * HALF) = pack8(y0, y1);
                    if (stab) { *(u32x4*)(XS + off + bj * HALF) = pack8(y0 * tv[bj][0], y1 * tv[bj][1]);
                        sq += ((y0[0] * y0[0] + y0[1] * y0[1]) + (y0[2] * y0[2] + y0[3] * y0[3])) + ((y1[0] * y1[0] + y1[1] * y1[1]) + (y1[2] * y1[2] + y1[3] * y1[3])); } }
                if (stab) { sq = sum_fq(sq); if (fq == 0) ssqx[(size_t)(row0 + ai * HALF + m * 16) * 16 + u.pn * 4 + wc] = sq; } }
            asm volatile("" ::: "memory"); }
    }
};
struct EpiPart {
    static constexpr bool PERM = true, AFTER_DRAIN = false;
    float* P;
    __device__ __forceinline__ void operator()(const f32x4 (&acc)[2][2][4][2], const Unit& u, int wr, int wc, int fr, int fq) const {
        const int row0 = u.pm * BM + wr * 64 + fr, col0 = u.pn * BM + wc * 32 + 8 * fq;
#pragma unroll
        for (int ai = 0; ai < 2; ++ai)
#pragma unroll
            for (int m = 0; m < 4; ++m) { float* rowp = P + (size_t)(row0 + ai * HALF + m * 16) * 1024 + col0;
#pragma unroll
                for (int bj = 0; bj < 2; ++bj) { *(f32x4*)(rowp + bj * HALF) = acc[ai][bj][m][0]; *(f32x4*)(rowp + bj * HALF + 4) = acc[ai][bj][m][1]; }
                asm volatile("" ::: "memory"); }
    }
};
struct EpiFF1 {
    static constexpr bool PERM = true, AFTER_DRAIN = false;
    bf16_t* H; const float* ssqx; const float* shw; int row_base;
    __device__ __forceinline__ void operator()(const f32x4 (&acc)[2][2][4][2], const Unit& u, int wr, int wc, int fr, int fq) const {
        const int row0 = row_base + u.pm * BM + wr * 64 + fr, col0 = u.pn * BM + wc * 32 + 8 * fq;
        const int mi = (row_base + u.pm * BM >= T_LAT) ? 8 : ((row_base + u.pm * BM) >> 13);
        f32x4 sw[2][2];
#pragma unroll
        for (int bj = 0; bj < 2; ++bj) { sw[bj][0] = *(const f32x4*)(shw + mi * 4096 + col0 + bj * HALF); sw[bj][1] = *(const f32x4*)(shw + mi * 4096 + col0 + bj * HALF + 4); }
        float rsv[2][4];
#pragma unroll
        for (int ai = 0; ai < 2; ++ai) {
#pragma unroll
            for (int m = 0; m < 4; ++m) { rsv[ai][m] = row_rstd16_q(ssqx, row0 + ai * HALF + m * 16, fq); if (m & 1) asm volatile("" : "+v"(rsv[ai][m - 1]), "+v"(rsv[ai][m]) :: "memory"); } }
#pragma unroll
        for (int ai = 0; ai < 2; ++ai)
#pragma unroll
            for (int m = 0; m < 4; ++m) { const int row = row0 + ai * HALF + m * 16; bf16_t* rowp = H + (size_t)row * 4096 + col0; const float rs = rsv[ai][m];
#pragma unroll
                for (int bj = 0; bj < 2; ++bj) { f32x4 v0 = acc[ai][bj][m][0] * rs + sw[bj][0], v1 = acc[ai][bj][m][1] * rs + sw[bj][1];
#pragma unroll
                    for (int e = 0; e < 4; ++e) { const float a = fmaxf(v0[e], 0.f), b = fmaxf(v1[e], 0.f); v0[e] = a * a; v1[e] = b * b; }
                    *(u32x4*)(rowp + bj * HALF) = pack8(v0, v1); }
                asm volatile("" ::: "memory"); }
    }
};
template <class Epi, class Sched, bool ALIGN_EPI, bool SP2, int KC, int LDAC, int LDBC = KC>
__device__ __forceinline__ void gemm_phase(PG8_LAS unsigned char* lds, const Gemm g, const Sched& S, const Epi& E, int tid_in) {
    int tid_l = tid_in; asm volatile("" : "+v"(tid_l));
    const int tid = tid_l, wid = __builtin_amdgcn_readfirstlane(tid >> 6), lane = tid & 63, wr = wid >> 2, wc = wid & 3, fr = lane & 15, fq = lane >> 4;
    constexpr int K = KC, nt = KC / BK;
    unsigned voffA[2], voffB[2];
#pragma unroll
    for (int i = 0; i < 2; ++i) { int R, C; stage_rc(tid * 16 + i * 8192, R, C); const int Rb = Epi::PERM ? ((R & ~31) + perm32(R & 31)) : R;
        voffA[i] = (unsigned)(R * LDAC + C) * 2u; voffB[i] = (unsigned)(Rb * LDBC + C) * 2u; }
    constexpr size_t kstep = (size_t)(BK * 2);
    constexpr size_t hstepA = (size_t)HALF * LDAC * 2, hstepB = (size_t)HALF * LDBC * 2;
    constexpr size_t tstepA = 2 * hstepA, tstepB = 2 * hstepB;
    const unsigned ldsw = (unsigned)wid * 1024u;
    const int aoff = lds_byte(wr * 64 + fr, fq * 8), boff = lds_byte(wc * 32 + fr, fq * 8);
#define PG8_SA(b, h) (((b) * 2 + (h)) * HTB)
#define PG8_SB(b, h) ((4 + (b) * 2 + (h)) * HTB)
#define PG8_STAGE(bufoff, gbase, voff) do { _Pragma("unroll") for (int _i = 0; _i < 2; ++_i) \
        __builtin_amdgcn_global_load_lds((const unsigned*)((const char*)(gbase) + (voff)[_i]), (PG8_LAS unsigned*)(lds + (bufoff) + ldsw + _i * 8192), 16, 0, 0); } while (0)
#define PG8_LDA(dst, b, h) do { _Pragma("unroll") for (int m = 0; m < 4; ++m) _Pragma("unroll") for (int k = 0; k < 2; ++k) dst[m][k] = *(const PG8_LAS bf16x8*)(lds + PG8_SA(b, h) + aoff + m * 2048 + k * 1024); } while (0)
#define PG8_LDB(dst, b, h) do { _Pragma("unroll") for (int n = 0; n < 2; ++n) _Pragma("unroll") for (int k = 0; k < 2; ++k) dst[n][k] = *(const PG8_LAS bf16x8*)(lds + PG8_SB(b, h) + boff + n * 2048 + k * 1024); } while (0)
#define PG8_MMA(ai, bj, At, Bt) do { __builtin_amdgcn_s_setprio(1); _Pragma("unroll") for (int m = 0; m < 4; ++m) _Pragma("unroll") for (int n = 0; n < 2; ++n) _Pragma("unroll") for (int k = 0; k < 2; ++k) \
        acc[ai][bj][m][n] = __builtin_amdgcn_mfma_f32_16x16x32_bf16(Bt[n][k], At[m][k], acc[ai][bj][m][n], 0, 0, 0); __builtin_amdgcn_s_setprio(0); } while (0)
#define PG8_WAIT_V(n) asm volatile("s_waitcnt vmcnt(" #n ")" ::: "memory")
#define PG8_WAIT_L(n) asm volatile("s_waitcnt lgkmcnt(" #n ")" ::: "memory")
#define PG8_BAR __builtin_amdgcn_s_barrier()
#define PG8_SCHED __builtin_amdgcn_sched_barrier(0)
    Unit cur, nxt; int ui = 0;
    if (!S.next(0, cur)) return;
    f32x4 acc[2][2][4][2];
#pragma unroll
    for (int a = 0; a < 2; ++a)
#pragma unroll
        for (int b = 0; b < 2; ++b)
#pragma unroll
            for (int m = 0; m < 4; ++m)
#pragma unroll
                for (int n = 0; n < 2; ++n) acc[a][b][m][n] = (f32x4){0.f, 0.f, 0.f, 0.f};
    bf16x8 At[4][2], B0[2][2], B1[2][2];
    const char* cA = (const char*)g.A + (size_t)cur.pm * tstepA; const char* cB = (const char*)g.Bt + (size_t)cur.pn * tstepB;
    S.a_ready(cur);
    if constexpr (SP2) {
        PG8_STAGE(PG8_SB(0, 0), cB, voffB); PG8_STAGE(PG8_SB(0, 1), cB + hstepB, voffB); PG8_STAGE(PG8_SA(0, 0), cA, voffA); PG8_STAGE(PG8_SA(0, 1), cA + hstepA, voffA);
        if (wr == 1) PG8_BAR;
        PG8_WAIT_V(2); PG8_BAR;
        PG8_STAGE(PG8_SB(1, 0), cB + kstep, voffB); PG8_STAGE(PG8_SA(1, 0), cA + kstep, voffA); PG8_STAGE(PG8_SB(1, 1), cB + hstepB + kstep, voffB);
        PG8_WAIT_V(6); PG8_BAR;
    } else {
        PG8_STAGE(PG8_SB(0, 0), cB, voffB); PG8_STAGE(PG8_SA(0, 0), cA, voffA); PG8_STAGE(PG8_SB(0, 1), cB + hstepB, voffB); PG8_STAGE(PG8_SA(0, 1), cA + hstepA, voffA);
        if (wr == 1) PG8_BAR;
        PG8_WAIT_V(4); PG8_BAR;
        PG8_STAGE(PG8_SB(1, 0), cB + kstep, voffB); PG8_STAGE(PG8_SA(1, 0), cA + kstep, voffA); PG8_STAGE(PG8_SB(1, 1), cB + hstepB + kstep, voffB);
        PG8_WAIT_V(6); PG8_BAR;
    }
    for (;;) {
        const bool has_next = S.next(ui + 1, nxt);
        const char* nA = has_next ? (const char*)g.A + (size_t)nxt.pm * tstepA : cA; const char* nB = has_next ? (const char*)g.Bt + (size_t)nxt.pn * tstepB : cB;
        for (int t = 0; t < nt; t += 2) {
            const bool last = (t == nt - 2);
            const char* a1 = cA + (size_t)(t + 1) * kstep;
            const char* a2 = last ? nA : cA + (size_t)(t + 2) * kstep; const char* b2 = last ? nB : cB + (size_t)(t + 2) * kstep;
            const char* a3 = a2 + kstep; const char* b3 = b2 + kstep;
            if (last && has_next) S.a_ready(nxt);
            if constexpr (SP2) {
            PG8_LDB(B0, 0, 0); PG8_LDB(B1, 0, 1); PG8_SCHED; PG8_LDA(At, 0, 0); PG8_STAGE(PG8_SA(1, 1), a1 + hstepA, voffA);
            PG8_WAIT_V(8); PG8_WAIT_L(0); PG8_BAR; PG8_MMA(0, 0, At, B0); PG8_MMA(0, 1, At, B1); PG8_BAR; PG8_SCHED;
            PG8_LDA(At, 0, 1); PG8_STAGE(PG8_SB(0, 0), b2, voffB); PG8_STAGE(PG8_SB(0, 1), b2 + hstepB, voffB); PG8_STAGE(PG8_SA(0, 0), a2, voffA);
            PG8_WAIT_V(8); PG8_WAIT_L(0); PG8_BAR; PG8_MMA(1, 0, At, B0); PG8_MMA(1, 1, At, B1); PG8_BAR; PG8_SCHED;
            PG8_LDB(B0, 1, 0); PG8_LDB(B1, 1, 1); PG8_SCHED; PG8_LDA(At, 1, 0); PG8_STAGE(PG8_SA(0, 1), a2 + hstepA, voffA);
            PG8_WAIT_V(8); PG8_WAIT_L(0); PG8_BAR; PG8_MMA(0, 0, At, B0); PG8_MMA(0, 1, At, B1); PG8_BAR; PG8_SCHED;
            PG8_LDA(At, 1, 1); PG8_STAGE(PG8_SB(1, 0), b3, voffB); PG8_STAGE(PG8_SB(1, 1), b3 + hstepB, voffB); PG8_STAGE(PG8_SA(1, 0), a3, voffA);
            PG8_WAIT_V(8); PG8_WAIT_L(0); PG8_BAR; PG8_MMA(1, 0, At, B0); PG8_MMA(1, 1, At, B1); PG8_BAR; PG8_SCHED;
            } else {
            PG8_LDB(B0, 0, 0); PG8_SCHED; PG8_LDA(At, 0, 0); PG8_STAGE(PG8_SA(1, 1), a1 + hstepA, voffA);
            PG8_WAIT_L(8); PG8_BAR; PG8_WAIT_L(0); PG8_MMA(0, 0, At, B0); PG8_BAR; PG8_SCHED;
            PG8_LDB(B1, 0, 1); PG8_STAGE(PG8_SB(0, 0), b2, voffB);
            PG8_BAR; PG8_WAIT_L(0); PG8_MMA(0, 1, At, B1); PG8_BAR;
            PG8_LDA(At, 0, 1); PG8_STAGE(PG8_SA(0, 0), a2, voffA);
            PG8_BAR; PG8_WAIT_L(0); PG8_MMA(1, 0, At, B0); PG8_BAR; PG8_SCHED;
            PG8_STAGE(PG8_SB(0, 1), b2 + hstepB, voffB);
            PG8_WAIT_V(6); PG8_BAR; PG8_MMA(1, 1, At, B1); PG8_BAR;
            PG8_LDB(B0, 1, 0); PG8_SCHED; PG8_LDA(At, 1, 0); PG8_STAGE(PG8_SA(0, 1), a2 + hstepA, voffA);
            PG8_WAIT_L(8); PG8_BAR; PG8_WAIT_L(0); PG8_MMA(0, 0, At, B0); PG8_BAR; PG8_SCHED;
            PG8_LDB(B1, 1, 1); PG8_STAGE(PG8_SB(1, 0), b3, voffB);
            PG8_BAR; PG8_WAIT_L(0); PG8_MMA(0, 1, At, B1); PG8_BAR;
            PG8_LDA(At, 1, 1); PG8_STAGE(PG8_SA(1, 0), a3, voffA);
            PG8_BAR; PG8_WAIT_L(0); PG8_MMA(1, 0, At, B0); PG8_BAR; PG8_SCHED;
            PG8_STAGE(PG8_SB(1, 1), b3 + hstepB, voffB);
            PG8_WAIT_V(6); PG8_BAR; PG8_MMA(1, 1, At, B1); PG8_BAR;
            }
        }
        if constexpr (ALIGN_EPI) { if (wr == 0) PG8_BAR; }
        if constexpr (!Epi::AFTER_DRAIN) { Unit ue = cur; int ln_; asm volatile("v_mbcnt_lo_u32_b32 %0, -1, 0\n\tv_mbcnt_hi_u32_b32 %0, -1, %0" : "=&v"(ln_), "+s"(ue.pm), "+s"(ue.pn)); E(acc, ue, wr, wc, ln_ & 15, ln_ >> 4); S.done(cur); }
        if (!has_next) break;
#pragma unroll
        for (int a = 0; a < 2; ++a)
#pragma unroll
            for (int b = 0; b < 2; ++b)
#pragma unroll
                for (int m = 0; m < 4; ++m)
#pragma unroll
                    for (int n = 0; n < 2; ++n) acc[a][b][m][n] = (f32x4){0.f, 0.f, 0.f, 0.f};
        cur = nxt; cA = nA; cB = nB; ++ui;
        if constexpr (ALIGN_EPI) { if (wr == 1) PG8_BAR; }
    }
    PG8_WAIT_V(0);
    if constexpr (!ALIGN_EPI) { if (wr == 0) PG8_BAR; }
    PG8_BAR;
    if constexpr (Epi::AFTER_DRAIN) { E.fused(acc, cur, wr, wc, fr, fq, lds, wid, lane); S.done(cur); }
#undef PG8_SA
#undef PG8_SB
#undef PG8_STAGE
#undef PG8_LDA
#undef PG8_LDB
#undef PG8_MMA
#undef PG8_WAIT_V
#undef PG8_WAIT_L
#undef PG8_BAR
#undef PG8_SCHED
}
}
namespace att {
using bf16x8 = __attribute__((ext_vector_type(8))) short;
using s16x4  = __attribute__((ext_vector_type(4))) short;
using f32x16 = __attribute__((ext_vector_type(16))) float;
using u32x4  = __attribute__((ext_vector_type(4))) unsigned;
constexpr int NW = 8, QBLK = 32, KVBLK = 64;
constexpr float SCALE = 0.10206207261596575f;
constexpr float THR2 = 11.0f;
constexpr int SHM_V = KVBLK * 64 * 2, SHM_K = KVBLK * 208, SHM_ATTN = 3 * SHM_V + 2 * SHM_K + NW * 64 * 4;
#define KSWZ(row, colB) ((row) * 208 + (colB))
#define SBAR() __builtin_amdgcn_sched_barrier(0)
__device__ __forceinline__ int crow(int r, int hi) { return (r & 3) + 8 * (r >> 2) + 4 * hi; }
__device__ __forceinline__ unsigned cvtpk(float lo, float hi) { unsigned r; asm volatile("v_cvt_pk_bf16_f32 %0, %1, %2" : "=v"(r) : "v"(lo), "v"(hi)); return r; }
#define MX3(a, b, c) __builtin_fmaxf(__builtin_fmaxf((a), (b)), (c))
template <bool FIRST>
__device__ __forceinline__ void partialSM(f32x16& p0, f32x16& p1, float& m_reg, f32x16& negm, float& alpha) {
  float a = MX3(p0[0], p0[1], p1[0]), b = MX3(p0[2], p0[3], p1[1]); a = MX3(a, p1[2], p1[3]);
#pragma unroll
  for (int r = 4; r < 16; r += 4) { a = MX3(a, p0[r], p0[r + 1]); b = MX3(b, p0[r + 2], p0[r + 3]); a = MX3(a, p1[r], p1[r + 1]); b = MX3(b, p1[r + 2], p1[r + 3]); }
  float pmax = __builtin_fmaxf(a, b);
  { auto rr = __builtin_amdgcn_permlane32_swap(__float_as_uint(pmax), __float_as_uint(pmax), false, false);
    pmax = __builtin_fmaxf(__uint_as_float(rr[0]), __uint_as_float(rr[1])); }
  alpha = 1.f;
  if (FIRST || __builtin_expect(__any(pmax > THR2), 0)) {
    const float dl = FIRST ? pmax : __builtin_fmaxf(pmax, 0.f); m_reg += dl;
#pragma unroll
    for (int r = 0; r < 16; ++r) { p0[r] -= dl; p1[r] -= dl; }
#pragma unroll
    for (int r = 0; r < 16; ++r) negm[r] = -m_reg;
    if (!FIRST) alpha = __builtin_amdgcn_exp2f(-dl);
  }
#pragma unroll
  for (int r = 0; r < 16; ++r) p0[r] = __builtin_amdgcn_exp2f(p0[r]);
}
__device__ __forceinline__ void finishSM(f32x16& p0, f32x16& p1, float& l_reg, bf16x8& pa0, bf16x8& pa1, bf16x8& pa2, bf16x8& pa3) {
#pragma unroll
  for (int r = 0; r < 16; ++r) { p0[r] = __builtin_amdgcn_exp2f(p0[r]); p1[r] = __builtin_amdgcn_exp2f(p1[r]); }
#pragma unroll
  for (int r = 0; r < 16; ++r) l_reg += p0[r] + p1[r];
#define PK4(P, BASE, OUT) do { u32x4 w = {cvtpk(P[BASE + 0], P[BASE + 1]), cvtpk(P[BASE + 2], P[BASE + 3]), cvtpk(P[BASE + 4], P[BASE + 5]), cvtpk(P[BASE + 6], P[BASE + 7])}; OUT = *reinterpret_cast<bf16x8*>(&w); } while (0)
  PK4(p0, 0, pa0); PK4(p0, 8, pa1); PK4(p1, 0, pa2); PK4(p1, 8, pa3);
#undef PK4
}
__device__ __forceinline__ void qkt(f32x16& p0, f32x16& p1, const char* Ks, const bf16x8* qr, const f32x16& negm, int r32, int hi) {
#pragma unroll
  for (int d0 = 0; d0 < 6; ++d0) { int cb = (d0 * 16 + hi * 8) * 2;
    bf16x8 b0 = *reinterpret_cast<const bf16x8*>(Ks + KSWZ(r32, cb));
    bf16x8 b1 = *reinterpret_cast<const bf16x8*>(Ks + KSWZ(32 + r32, cb));
    if (d0 == 0) { p0 = __builtin_amdgcn_mfma_f32_32x32x16_bf16(b0, qr[0], negm, 0, 0, 0); p1 = __builtin_amdgcn_mfma_f32_32x32x16_bf16(b1, qr[0], negm, 0, 0, 0); }
    else { p0 = __builtin_amdgcn_mfma_f32_32x32x16_bf16(b0, qr[d0], p0, 0, 0, 0); p1 = __builtin_amdgcn_mfma_f32_32x32x16_bf16(b1, qr[d0], p1, 0, 0, 0); } }
}
__device__ __forceinline__ int v_st(int k, int c) { const int kk = (k & ~0xC) | ((k & 4) << 1) | ((k & 8) >> 1); return ((kk >> 3) * 2 + (c >> 5)) * 512 + ((kk & 7) * 32 + (c & 31)) * 2; }
__device__ __forceinline__ int v_st_nat(int k, int c) { return ((k >> 3) * 2 + (c >> 5)) * 512 + ((k & 7) * 32 + (c & 31)) * 2; }
__device__ __forceinline__ int v_rd_base(int lane) { return ((lane & 3) << 3) | (((lane >> 2) & 3) << 6) | (((lane >> 4) & 1) << 5) | (((lane >> 5) & 1) << 8); }
constexpr int v_rd_off(int d0, int ks, int half) { return d0 * 512 + ks * 2048 + half * 1024; }
template <int OFF> __device__ __forceinline__ s16x4 tr_read(int vb) {
  s16x4 r; asm volatile("ds_read_b64_tr_b16 %0, %1 offset:%2" : "=&v"(r) : "v"(vb), "i"(OFF) : "memory"); return r;
}
template <int D0> __device__ __forceinline__ void pv_one(f32x16& od, int vb, bf16x8 pa0, bf16x8 pa1, bf16x8 pa2, bf16x8 pa3) {
  const s16x4 l0 = tr_read<v_rd_off(D0, 0, 0)>(vb), h0 = tr_read<v_rd_off(D0, 0, 1)>(vb), l1 = tr_read<v_rd_off(D0, 1, 0)>(vb), h1 = tr_read<v_rd_off(D0, 1, 1)>(vb);
  const s16x4 l2 = tr_read<v_rd_off(D0, 2, 0)>(vb), h2 = tr_read<v_rd_off(D0, 2, 1)>(vb), l3 = tr_read<v_rd_off(D0, 3, 0)>(vb), h3 = tr_read<v_rd_off(D0, 3, 1)>(vb);
  asm volatile("s_waitcnt lgkmcnt(0)" ::: "memory"); SBAR();
#define PK(L, H) (bf16x8){L[0], L[1], L[2], L[3], H[0], H[1], H[2], H[3]}
  od = __builtin_amdgcn_mfma_f32_32x32x16_bf16(pa0, PK(l0, h0), od, 0, 0, 0);
  od = __builtin_amdgcn_mfma_f32_32x32x16_bf16(pa1, PK(l1, h1), od, 0, 0, 0);
  od = __builtin_amdgcn_mfma_f32_32x32x16_bf16(pa2, PK(l2, h2), od, 0, 0, 0);
  od = __builtin_amdgcn_mfma_f32_32x32x16_bf16(pa3, PK(l3, h3), od, 0, 0, 0);
}
__device__ __forceinline__ void pv_d0(f32x16* o, int vb, bf16x8 ones, bf16x8 pa0, bf16x8 pa1, bf16x8 pa2, bf16x8 pa3) {
  s16x4 a0 = tr_read<v_rd_off(0, 0, 0)>(vb), b0 = tr_read<v_rd_off(0, 0, 1)>(vb), c0 = tr_read<v_rd_off(1, 0, 0)>(vb), d0 = tr_read<v_rd_off(1, 0, 1)>(vb);
  s16x4 a1 = tr_read<v_rd_off(0, 1, 0)>(vb), b1 = tr_read<v_rd_off(0, 1, 1)>(vb), c1 = tr_read<v_rd_off(1, 1, 0)>(vb), d1 = tr_read<v_rd_off(1, 1, 1)>(vb);
  s16x4 a2 = tr_read<v_rd_off(0, 2, 0)>(vb), b2 = tr_read<v_rd_off(0, 2, 1)>(vb), c2 = tr_read<v_rd_off(1, 2, 0)>(vb), d2 = tr_read<v_rd_off(1, 2, 1)>(vb);
  s16x4 a3 = tr_read<v_rd_off(0, 3, 0)>(vb), b3 = tr_read<v_rd_off(0, 3, 1)>(vb), c3 = tr_read<v_rd_off(1, 3, 0)>(vb), d3 = tr_read<v_rd_off(1, 3, 1)>(vb);
  asm volatile("s_waitcnt lgkmcnt(0)" : "+v"(a0), "+v"(b0), "+v"(c0), "+v"(d0), "+v"(a1), "+v"(b1), "+v"(c1), "+v"(d1), "+v"(a2), "+v"(b2), "+v"(c2), "+v"(d2), "+v"(a3), "+v"(b3), "+v"(c3), "+v"(d3) :: "memory");
  o[2] = __builtin_amdgcn_mfma_f32_32x32x16_bf16(pa0, ones, o[2], 0, 0, 0); o[0] = __builtin_amdgcn_mfma_f32_32x32x16_bf16(pa0, PK(a0, b0), o[0], 0, 0, 0); o[1] = __builtin_amdgcn_mfma_f32_32x32x16_bf16(pa0, PK(c0, d0), o[1], 0, 0, 0);
  o[2] = __builtin_amdgcn_mfma_f32_32x32x16_bf16(pa1, ones, o[2], 0, 0, 0); o[0] = __builtin_amdgcn_mfma_f32_32x32x16_bf16(pa1, PK(a1, b1), o[0], 0, 0, 0); o[1] = __builtin_amdgcn_mfma_f32_32x32x16_bf16(pa1, PK(c1, d1), o[1], 0, 0, 0);
  o[2] = __builtin_amdgcn_mfma_f32_32x32x16_bf16(pa2, ones, o[2], 0, 0, 0); o[0] = __builtin_amdgcn_mfma_f32_32x32x16_bf16(pa2, PK(a2, b2), o[0], 0, 0, 0); o[1] = __builtin_amdgcn_mfma_f32_32x32x16_bf16(pa2, PK(c2, d2), o[1], 0, 0, 0);
  o[2] = __builtin_amdgcn_mfma_f32_32x32x16_bf16(pa3, ones, o[2], 0, 0, 0); o[0] = __builtin_amdgcn_mfma_f32_32x32x16_bf16(pa3, PK(a3, b3), o[0], 0, 0, 0); o[1] = __builtin_amdgcn_mfma_f32_32x32x16_bf16(pa3, PK(c3, d3), o[1], 0, 0, 0);
#undef PK
}
template <int OFF> __device__ __forceinline__ bf16x8 rd128(int addr) { bf16x8 r; asm volatile("ds_read_b128 %0, %1 offset:%2" : "=v"(r) : "v"(addr), "i"(OFF) : "memory"); return r; }
#define WAIT4(a, b, c, d) asm volatile("s_waitcnt lgkmcnt(0)" : "+v"(a), "+v"(b), "+v"(c), "+v"(d) :: "memory")
#define EXP4(P, B) do { P[B] = __builtin_amdgcn_exp2f(P[B]); P[B + 1] = __builtin_amdgcn_exp2f(P[B + 1]); P[B + 2] = __builtin_amdgcn_exp2f(P[B + 2]); P[B + 3] = __builtin_amdgcn_exp2f(P[B + 3]); } while (0)
struct VFr { s16x4 a0, b0, c0, d0, a1, b1, c1, d1; };
template <int KS0> __device__ __forceinline__ void vfr_issue(VFr& f, int vb) {
  f.a0 = tr_read<v_rd_off(0, KS0, 0)>(vb); f.b0 = tr_read<v_rd_off(0, KS0, 1)>(vb); f.c0 = tr_read<v_rd_off(1, KS0, 0)>(vb); f.d0 = tr_read<v_rd_off(1, KS0, 1)>(vb);
  f.a1 = tr_read<v_rd_off(0, KS0 + 1, 0)>(vb); f.b1 = tr_read<v_rd_off(0, KS0 + 1, 1)>(vb); f.c1 = tr_read<v_rd_off(1, KS0 + 1, 0)>(vb); f.d1 = tr_read<v_rd_off(1, KS0 + 1, 1)>(vb);
}
#define MF(A, B, C) __builtin_amdgcn_mfma_f32_32x32x16_bf16(A, B, C, 0, 0, 0)
#define KOFF(KB, hb, d0) ((KB) * SHM_K + (hb) * 32 * 208 + (d0) * 32)
#define SUM4(P, B) do { ls += (P[B] + P[B + 1]) + (P[B + 2] + P[B + 3]); } while (0)
#define PACK8(P, B, OUT) do { u32x4 w_ = {cvtpk(P[B + 0], P[B + 1]), cvtpk(P[B + 2], P[B + 3]), cvtpk(P[B + 4], P[B + 5]), cvtpk(P[B + 6], P[B + 7])}; OUT = *reinterpret_cast<bf16x8*>(&w_); } while (0)
template <int KB, bool HASY>
__device__ __forceinline__ void phaseA(f32x16& X0, f32x16& X1, f32x16& Y0, f32x16& Y1, bf16x8& pa0, bf16x8& pa1, bf16x8& pa2, bf16x8& pa3,
                                       const bf16x8* qr, const f32x16& negm, int kaddr, VFr& vf, int vb, float& l_reg) {
  SBAR();
  float ls = 0.f;
  bf16x8 k0 = rd128<KOFF(KB, 0, 0)>(kaddr), k1 = rd128<KOFF(KB, 1, 0)>(kaddr), k2 = rd128<KOFF(KB, 0, 1)>(kaddr), k3 = rd128<KOFF(KB, 1, 1)>(kaddr);
  if (HASY) { EXP4(Y0, 0); EXP4(Y0, 4); }
  SBAR(); WAIT4(k0, k1, k2, k3);
  bf16x8 k4 = rd128<KOFF(KB, 0, 2)>(kaddr), k5 = rd128<KOFF(KB, 1, 2)>(kaddr), k6 = rd128<KOFF(KB, 0, 3)>(kaddr), k7 = rd128<KOFF(KB, 1, 3)>(kaddr);
  SBAR();
  X0 = MF(k0, qr[0], negm); if (HASY) { EXP4(Y0, 8); SUM4(Y0, 0); } SBAR();
  X1 = MF(k1, qr[0], negm); if (HASY) { EXP4(Y0, 12); SUM4(Y0, 4); } SBAR();
  X0 = MF(k2, qr[1], X0); if (HASY) { PACK8(Y0, 0, pa0); } SBAR();
  X1 = MF(k3, qr[1], X1); if (HASY) { EXP4(Y1, 0); SUM4(Y0, 8); } SBAR();
  WAIT4(k4, k5, k6, k7);
  bf16x8 k8 = rd128<KOFF(KB, 0, 4)>(kaddr), k9 = rd128<KOFF(KB, 1, 4)>(kaddr), k10 = rd128<KOFF(KB, 0, 5)>(kaddr), k11 = rd128<KOFF(KB, 1, 5)>(kaddr);
  SBAR();
  X0 = MF(k4, qr[2], X0); if (HASY) { EXP4(Y1, 4); SUM4(Y0, 12); } SBAR();
  X1 = MF(k5, qr[2], X1); if (HASY) { PACK8(Y0, 8, pa1); } SBAR();
  X0 = MF(k6, qr[3], X0); if (HASY) { EXP4(Y1, 8); SUM4(Y1, 0); } SBAR();
  X1 = MF(k7, qr[3], X1); if (HASY) { EXP4(Y1, 12); SUM4(Y1, 4); } SBAR();
  WAIT4(k8, k9, k10, k11);
  SBAR();
  X0 = MF(k8, qr[4], X0); if (HASY) { PACK8(Y1, 0, pa2); } SBAR();
  X1 = MF(k9, qr[4], X1); if (HASY) { SUM4(Y1, 8); SUM4(Y1, 12); } SBAR();
  X0 = MF(k10, qr[5], X0); if (HASY) { PACK8(Y1, 8, pa3); } SBAR();
  X1 = MF(k11, qr[5], X1); if (HASY) vfr_issue<0>(vf, vb);
  l_reg += ls;
  SBAR();
}
#define PKV(L, H) (bf16x8){L[0], L[1], L[2], L[3], H[0], H[1], H[2], H[3]}
#define VWAIT(f) asm volatile("s_waitcnt lgkmcnt(0)" : "+v"(f.a0), "+v"(f.b0), "+v"(f.c0), "+v"(f.d0), "+v"(f.a1), "+v"(f.b1), "+v"(f.c1), "+v"(f.d1) :: "memory")
template <bool HASX>
__device__ __forceinline__ float phaseB(f32x16* o, bf16x8 pa0, bf16x8 pa1, bf16x8 pa2, bf16x8 pa3, VFr& f, int vb, const f32x16& X0, const f32x16& X1) {
  SBAR(); VWAIT(f); VFr g; vfr_issue<2>(g, vb); SBAR();
  float a = 0.f, b = 0.f;
  o[0] = MF(pa0, PKV(f.a0, f.b0), o[0]); SBAR(); o[1] = MF(pa0, PKV(f.c0, f.d0), o[1]);
  if (HASX) { a = MX3(X0[0], X0[1], X1[0]); b = MX3(X0[2], X0[3], X1[1]); a = MX3(a, X1[2], X1[3]); b = MX3(b, X0[4], X0[5]); } SBAR();
  o[0] = MF(pa1, PKV(f.a1, f.b1), o[0]); if (HASX) { a = MX3(a, X0[6], X0[7]); b = MX3(b, X1[4], X1[5]); } SBAR();
  o[1] = MF(pa1, PKV(f.c1, f.d1), o[1]); if (HASX) { a = MX3(a, X1[6], X1[7]); b = MX3(b, X0[8], X0[9]); a = MX3(a, X0[10], X0[11]); } SBAR();
  VWAIT(g); SBAR();
  o[0] = MF(pa2, PKV(g.a0, g.b0), o[0]); if (HASX) { b = MX3(b, X1[8], X1[9]); a = MX3(a, X1[10], X1[11]); } SBAR();
  o[1] = MF(pa2, PKV(g.c0, g.d0), o[1]); if (HASX) { b = MX3(b, X0[12], X0[13]); a = MX3(a, X0[14], X0[15]); } SBAR();
  o[0] = MF(pa3, PKV(g.a1, g.b1), o[0]); if (HASX) { b = MX3(b, X1[12], X1[13]); a = MX3(a, X1[14], X1[15]); } SBAR();
  o[1] = MF(pa3, PKV(g.c1, g.d1), o[1]); SBAR();
  float pmax = __builtin_fmaxf(a, b);
  if (HASX) { auto rr = __builtin_amdgcn_permlane32_swap(__float_as_uint(pmax), __float_as_uint(pmax), false, false); pmax = __builtin_fmaxf(__uint_as_float(rr[0]), __uint_as_float(rr[1])); }
  return pmax;
}
__device__ __forceinline__ float rowmax32(const f32x16& p0, const f32x16& p1) {
  float a = MX3(p0[0], p0[1], p1[0]), b = MX3(p0[2], p0[3], p1[1]); a = MX3(a, p1[2], p1[3]);
#pragma unroll
  for (int r = 4; r < 16; r += 4) { a = MX3(a, p0[r], p0[r + 1]); b = MX3(b, p0[r + 2], p0[r + 3]); a = MX3(a, p1[r], p1[r + 1]); b = MX3(b, p1[r + 2], p1[r + 3]); }
  float pmax = __builtin_fmaxf(a, b);
  auto rr = __builtin_amdgcn_permlane32_swap(__float_as_uint(pmax), __float_as_uint(pmax), false, false);
  return __builtin_fmaxf(__uint_as_float(rr[0]), __uint_as_float(rr[1]));
}
template <bool FIRST>
__device__ __forceinline__ float decide(float pmax, f32x16& p0, f32x16& p1, float& m_reg, f32x16& negm) {
  float alpha = 1.f;
  if (FIRST || __builtin_expect(__any(pmax > THR2), 0)) {
    const float dl = FIRST ? pmax : __builtin_fmaxf(pmax, 0.f); m_reg += dl;
#pragma unroll
    for (int r = 0; r < 16; ++r) { p0[r] -= dl; p1[r] -= dl; }
#pragma unroll
    for (int r = 0; r < 16; ++r) negm[r] = -m_reg;
    if (!FIRST) alpha = __builtin_amdgcn_exp2f(-dl);
  }
  return alpha;
}
__device__ __forceinline__ void attn_unit(const bf16_t* __restrict__ Qb, const bf16_t* __restrict__ KNh, const bf16_t* __restrict__ KRb, const bf16_t* __restrict__ Vh,
                                          bf16_t* __restrict__ Ob, int nkeys, char* lds, int tid_in) {
  int tid_l = tid_in; asm volatile("" : "+v"(tid_l));
  const int tid = tid_l, wid = tid >> 6, lane = tid & 63, r32 = lane & 31, hi = lane >> 5;
  char* V_lds = lds; char* K_lds = lds + 3 * SHM_V;
  float* ws = (float*)(lds + 3 * SHM_V + 2 * SHM_K) + wid * 64; float* li_l = ws; float* al_l = ws + 32;
  float m_reg = 0.f, l_reg = 0.f; f32x16 o[2] = {}; f32x16 negm = {}; bf16x8 qr[6];
  const bf16_t* Qw = Qb + (long)(wid * QBLK + r32) * 768 + hi * 8;
#pragma unroll
  for (int d0 = 0; d0 < 6; ++d0) qr[d0] = *reinterpret_cast<const bf16x8*>(Qw + d0 * 16);
  const int sr = tid >> 3, sc = (tid & 7) * 8, vst0 = v_st_nat(sr, sc), kst0 = KSWZ(sr, sc * 2);
  const bool krt = tid < 256; const int rr_ = (tid >> 2) & 63, rc_ = (tid & 3) * 8, kst1 = KSWZ(rr_, 128 + rc_ * 2);
  const int vb0 = (int)(uintptr_t)V_lds + v_rd_base(lane);
  const int kaddr = (int)(uintptr_t)K_lds + r32 * 208 + hi * 16;
  struct { bf16x8 vs, ks, kr; } sr_[2];
  typedef unsigned v4u_t __attribute__((ext_vector_type(4)));
  const __amdgpu_buffer_rsrc_t rV = __builtin_amdgcn_make_buffer_rsrc((void*)Vh, 0, LK * 64 * 2, 0x00020000);
  const __amdgpu_buffer_rsrc_t rK = __builtin_amdgcn_make_buffer_rsrc((void*)KNh, 0, LK * 64 * 2, 0x00020000);
  const __amdgpu_buffer_rsrc_t rR = __builtin_amdgcn_make_buffer_rsrc((void*)KRb, 0, LK * 32 * 2, 0x00020000);
  const int goff_kv = (sr * 64 + sc) * 2, goff_kr = (rr_ * 32 + rc_) * 2;
#define BLD(R, VO, SO) __builtin_bit_cast(bf16x8, __builtin_amdgcn_raw_buffer_load_b128(R, VO, SO, 0))
#define SLOAD(i, k0) do { sr_[i].vs = BLD(rV, goff_kv, (k0) * 128); sr_[i].ks = BLD(rK, goff_kv, (k0) * 128); if (krt) sr_[i].kr = BLD(rR, goff_kr, (k0) * 64); } while (0)
#define SWRITE(b, voff, i) do { *(bf16x8*)(V_lds + (voff) + vst0) = sr_[i].vs; *(bf16x8*)(K_lds + (b) * SHM_K + kst0) = sr_[i].ks; \
    if (krt) *(bf16x8*)(K_lds + (b) * SHM_K + kst1) = sr_[i].kr; } while (0)
#define SWAIT() do { asm volatile("s_waitcnt vmcnt(3)" ::: "memory"); } while (0)
#define RESC(a) do { if (__any((a) < 1.f)) { if (hi == 0) al_l[r32] = (a); asm volatile("s_waitcnt lgkmcnt(0)" ::: "memory"); l_reg *= (a); \
    _Pragma("unroll") for (int d = 0; d < 2; ++d) _Pragma("unroll") for (int r = 0; r < 16; ++r) o[d][r] *= al_l[crow(r, hi)]; } } while (0)
  f32x16 pA0, pA1, pB0, pB1; float alA, alB; bf16x8 pa0, pa1, pa2, pa3; VFr vf; const int NT = nkeys / KVBLK;
  constexpr int SE = 0, SO = 1;
  int vprev = 0, vcur = SHM_V, vnext = 2 * SHM_V;
#define ROT() do { const int t_ = vprev; vprev = vcur; vcur = vnext; vnext = t_; } while (0)
  SLOAD(SE, 0); asm volatile("s_waitcnt vmcnt(0)" ::: "memory"); SWRITE(0, 0, SE); __syncthreads();
  phaseA<0, false>(pA0, pA1, pB0, pB1, pa0, pa1, pa2, pa3, qr, negm, kaddr, vf, vb0, l_reg);
  alA = decide<true>(rowmax32(pA0, pA1), pA0, pA1, m_reg, negm);
  SLOAD(SO, KVBLK); if (2 < NT) SLOAD(SE, 2 * KVBLK);
  SWAIT(); SWRITE(1, SHM_V, SO); __syncthreads();
  for (int j = 1; j + 1 < NT; j += 2) {
    phaseA<1, true>(pB0, pB1, pA0, pA1, pa0, pa1, pa2, pa3, qr, negm, kaddr, vf, vb0 + vprev, l_reg);
    SLOAD(SO, (j + 2) * KVBLK); SBAR();
    alB = decide<false>(phaseB<true>(o, pa0, pa1, pa2, pa3, vf, vb0 + vprev, pB0, pB1), pB0, pB1, m_reg, negm);
    SWAIT(); SWRITE(0, vnext, SE);
    RESC(alB); __syncthreads(); ROT();
    phaseA<0, true>(pA0, pA1, pB0, pB1, pa0, pa1, pa2, pa3, qr, negm, kaddr, vf, vb0 + vprev, l_reg);
    if (j + 3 < NT) SLOAD(SE, (j + 3) * KVBLK); SBAR();
    alA = decide<false>(phaseB<true>(o, pa0, pa1, pa2, pa3, vf, vb0 + vprev, pA0, pA1), pA0, pA1, m_reg, negm);
    SWAIT(); SWRITE(1, vnext, SO);
    RESC(alA); __syncthreads(); ROT();
  }
  phaseA<1, true>(pB0, pB1, pA0, pA1, pa0, pa1, pa2, pa3, qr, negm, kaddr, vf, vb0 + vprev, l_reg);
  alB = decide<false>(phaseB<true>(o, pa0, pa1, pa2, pa3, vf, vb0 + vprev, pB0, pB1), pB0, pB1, m_reg, negm);
  RESC(alB);
  finishSM(pB0, pB1, l_reg, pa0, pa1, pa2, pa3);
  vfr_issue<0>(vf, vb0 + vcur);
  (void)phaseB<false>(o, pa0, pa1, pa2, pa3, vf, vb0 + vcur, pB0, pB1);
#undef ROT
  { auto rr = __builtin_amdgcn_permlane32_swap(__float_as_uint(l_reg), __float_as_uint(l_reg), false, false); l_reg = __uint_as_float(rr[0]) + __uint_as_float(rr[1]); }
  if (hi == 0) li_l[r32] = l_reg;
  asm volatile("s_waitcnt lgkmcnt(0)" ::: "memory");
  float rli[16];
#pragma unroll
  for (int r = 0; r < 16; ++r) rli[r] = __builtin_amdgcn_rcpf(li_l[crow(r, hi)]);
  bf16_t* Ow = Ob + (long)(wid * QBLK) * 1024;
#pragma unroll
  for (int r = 0; r < 16; ++r) { int orow = crow(r, hi);
#pragma unroll
    for (int d0 = 0; d0 < 2; ++d0) { const float v = o[d0][r] * rli[r]; Ow[(long)orow * 1024 + d0 * 32 + r32] = (bf16_t)(cvtpk(v, v) & 0xffffu); } }
  __syncthreads();
#undef SLOAD
#undef BLD
#undef SWRITE
#undef SWAIT
#undef RESC
}
}
#define LAS __attribute__((address_space(3)))
typedef unsigned short bf16_t;
typedef float f32x4 __attribute__((ext_vector_type(4)));
typedef unsigned u32x4 __attribute__((ext_vector_type(4)));
typedef unsigned u32x2 __attribute__((ext_vector_type(2)));
typedef short bf16x8 __attribute__((ext_vector_type(8)));
using att::f32x16;
#define LDS_WAIT() asm volatile("s_waitcnt lgkmcnt(0)" ::: "memory")

constexpr int NWAVES = 8, NTHREADS = 512;
constexpr int D = 1024, BATCH = 8, SEQ = 8192, DEPTH = 4, CTXL = 256, DFF = 4096, DIN = 1696;
constexpr int TL = BATCH * SEQ, TC = BATCH * CTXL, MALL = TL + TC;
constexpr size_t MiB = 1u << 20;
constexpr size_t WS_ROPE = 64 * 1024, WS_MODS = 1 * MiB, WS_SSQ = 2 * MiB, WS_WIN = 8 * MiB, WS_WUQ = 22 * MiB, WS_WUKV = 25 * MiB, WS_WOUT = 27 * MiB,
                 WS_W1 = 35 * MiB, WS_W2 = 67 * MiB, WS_CX = 99 * MiB, WS_XN = 107 * MiB, WS_Z = 239 * MiB, WS_Q = 470 * MiB, WS_KN = 569 * MiB, WS_KR = 635 * MiB,
                 WS_V = 640 * MiB, WS_Y = 706 * MiB, WS_H = 239 * MiB, WS_END = 838 * MiB,
                 WS_SSQX = 838 * MiB, WS_SHW = 843 * MiB, WS_STAB = 844 * MiB, WS_XB = 845 * MiB, WS_PART = 977 * MiB, WS_END2 = 1009 * MiB;
static_assert(WS_SSQ + (size_t)MALL * 20 * 4 <= WS_WIN && WS_XN + (size_t)MALL * D * 2 <= WS_Z && WS_Z + (size_t)MALL * ZP * 2 <= WS_Q && WS_Q + (size_t)MALL * 768 * 2 <= WS_KN &&
              WS_KN + (size_t)64 * LK * 64 * 2 <= WS_KR && WS_KR + (size_t)8 * LK * 32 * 2 <= WS_V && WS_V + (size_t)64 * LK * 64 * 2 <= WS_Y && WS_Y + (size_t)MALL * D * 2 <= WS_END &&
              WS_H + (size_t)MALL * DFF * 2 <= WS_END && WS_MODS + (size_t)DEPTH * 9 * 6144 * 4 <= WS_SSQ, "ws map");
constexpr int SHW_IN = 1792, SHW_L = 9 * (1792 + 4096);
static_assert(WS_SSQX + (size_t)MALL * 16 * 4 <= WS_SHW && WS_SHW + (size_t)DEPTH * SHW_L * 4 <= WS_STAB && WS_STAB + (size_t)DEPTH * 2 * 9 * 1024 * 4 <= WS_XB && WS_XB + (size_t)MALL * D * 2 <= WS_PART && WS_PART + (size_t)4 * TC * D * 4 <= WS_END2, "ws map 2");
constexpr int LDS_BYTES = 147456;

struct Args { const float* in[25]; float* out; unsigned char* ws; int ph_lo, ph_hi; };

__device__ __forceinline__ float wave_sum(float v, int lane) {
#pragma unroll
    for (int o = 1; o < 64; o <<= 1) v += shx(v, o, lane);
    return v;
}
__device__ __forceinline__ float sigmoid_f(float x) { return __builtin_amdgcn_rcpf(1.f + __expf(-x)); }
__device__ __forceinline__ float gelu_tanh(float x) { const float u = 0.7978845608028654f * (x + 0.044715f * x * x * x); return x * __builtin_amdgcn_rcpf(1.f + __expf(-2.f * u)); }
__device__ __forceinline__ float bf2f(unsigned short h) { return __uint_as_float((unsigned)h << 16); }
__device__ __forceinline__ unsigned pk2(float lo, float hi) { return pg8::cvt_pk_bf16(lo, hi); }
__device__ __forceinline__ int rope_new(int i) { const int g = i >> 4, w = i & 15; return 16 * g + 2 * (w & 7) + (w >> 3); }
__device__ __forceinline__ int rowmap(int mode, int n) {
    if (mode == 1) return (n >= 640 && n < 672) ? 640 + rope_new(n - 640) : n;
    if (mode == 2) { const int h = n / 96, d = n - h * 96; return d >= 64 ? h * 96 + 64 + rope_new(d - 64) : n; }
    return n;
}
__device__ __forceinline__ void transpose_item(const float* W, int K, int N, bf16_t* WT, const float* kscale, int mode, LAS float* scr, int item, int lane) {
    const int nblk = N / 32, kb = item / nblk, nb = item % nblk, k0 = 64 * kb, n0 = 32 * nb;
#pragma unroll 8
    for (int i = 0; i < 32; ++i) { const int kk = 2 * i + (lane >> 5); float w = W[(size_t)(k0 + kk) * N + n0 + (lane & 31)]; if (kscale) w *= kscale[k0 + kk]; scr[kk * 33 + (lane & 31)] = w; }
    LDS_WAIT(); asm volatile("" ::: "memory");
    const int c = lane & 7;
#pragma unroll
    for (int j = 0; j < 4; ++j) { const int n = (lane >> 3) + 8 * j; const LAS float* s = scr + (8 * c) * 33 + n;
        u32x4 o; o.x = pk2(s[0 * 33], s[1 * 33]); o.y = pk2(s[2 * 33], s[3 * 33]); o.z = pk2(s[4 * 33], s[5 * 33]); o.w = pk2(s[6 * 33], s[7 * 33]);
        *(u32x4*)(WT + (size_t)rowmap(mode, n0 + n) * K + k0 + 8 * c) = o; }
    LDS_WAIT(); asm volatile("" ::: "memory");
}

typedef __attribute__((address_space(1))) unsigned gu32;
#define RLX_AGENT __ATOMIC_RELAXED, __HIP_MEMORY_SCOPE_AGENT
#define XB_TMO      128
#define XB_XCNT(j)  (256  + 64 * (j))
#define XB_XSUB(j)  (1280 + 64 * (j))
#define XB_XGEN(j)  (2304 + 64 * (j))
#define XB_TOP      3328
#define XB_TOPGEN   3392
#define XCD_BAR_WORDS 3456
#define XB_SPIN_CAP (1u << 18)

__device__ __forceinline__ unsigned xb_ld(unsigned* p)              { return __hip_atomic_load(p, __ATOMIC_RELAXED, __HIP_MEMORY_SCOPE_AGENT); }
__device__ __forceinline__ unsigned xb_add(unsigned* p, unsigned v) { return __hip_atomic_fetch_add(p, v, __ATOMIC_RELAXED, __HIP_MEMORY_SCOPE_AGENT); }
__device__ __forceinline__ unsigned xb_xcc_id() { return (unsigned)__builtin_amdgcn_s_getreg((3 << 11) | 20) & 0xFu; }
#define XB_SPIN(cond, bar) do { unsigned _sp = 0; while (cond) { __builtin_amdgcn_s_sleep(1); \
    if ((++_sp & 255u) == 0u) { if (xb_ld(&(bar)[XB_TMO])) break; if (_sp > XB_SPIN_CAP) { atomicAdd(&(bar)[XB_TMO], 1u); break; } } } } while (0)

struct XcdBarrier {
    unsigned* bar; unsigned x;
    volatile LAS unsigned* st;
};

__device__ __forceinline__ XcdBarrier xcd_barrier_post(unsigned* bar, volatile LAS unsigned* st) {
    XcdBarrier b; b.bar = bar; b.x = xb_xcc_id(); b.st = st;
    if (threadIdx.x == 0) (void)xb_add(&bar[XB_XCNT(b.x)], 1u);
    return b;
}
__device__ __forceinline__ void xcd_barrier_complete(unsigned* bar, unsigned x, unsigned& nloc, unsigned& nx) {
    const unsigned G = gridDim.x * gridDim.y * gridDim.z;
    unsigned sum, cnt, mine, sp = 0u;
    for (;;) {
        sum = 0u; cnt = 0u; mine = 0u;
#pragma unroll
        for (unsigned j = 0; j < 16; ++j) { const unsigned c = xb_ld(&bar[XB_XCNT(j)]); sum += c; cnt += (c > 0u) ? 1u : 0u; mine = (j == x) ? c : mine; }
        if (sum == G) break;
        __builtin_amdgcn_s_sleep(1);
        if ((++sp & 255u) == 0u) { if (xb_ld(&bar[XB_TMO])) break; if (sp > XB_SPIN_CAP) { atomicAdd(&bar[XB_TMO], 1u); break; } }
    }
    nloc = mine > 0u ? mine : 1u; nx = cnt > 0u ? cnt : 1u;
}

__device__ __forceinline__ void xcd_barrier(const XcdBarrier& b) {
    asm volatile("s_waitcnt vmcnt(0)" ::: "memory");
    __syncthreads();
    if (threadIdx.x == 0) {
        unsigned* bar = b.bar;
        __builtin_amdgcn_s_waitcnt(0);
        unsigned nloc = b.st[0], nx = b.st[1];
        if (nloc == 0u) { xcd_barrier_complete(bar, b.x, nloc, nx); b.st[0] = nloc; b.st[1] = nx; }
        const unsigned old = xb_add(&bar[XB_XSUB(b.x)], 1u);
        const unsigned gen = old / nloc;
        if (old + 1u == (gen + 1u) * nloc) {
            __builtin_amdgcn_fence(__ATOMIC_RELEASE, "agent");
            asm volatile("s_waitcnt vmcnt(0)" ::: "memory");
            const unsigned og = xb_add(&bar[XB_TOP], 1u);
            const unsigned tg = og / nx;
            if (og + 1u == (tg + 1u) * nx) xb_add(&bar[XB_TOPGEN], 1u);
            else XB_SPIN(xb_ld(&bar[XB_TOPGEN]) == tg, bar);
            __builtin_amdgcn_fence(__ATOMIC_ACQUIRE, "agent");
            xb_add(&bar[XB_XGEN(b.x)], 1u);
            asm volatile("s_waitcnt vmcnt(0)" ::: "memory");
        } else {
            XB_SPIN(xb_ld(&bar[XB_XGEN(b.x)]) == gen, bar);
            __builtin_amdgcn_fence(__ATOMIC_ACQUIRE, "agent");
            asm volatile("s_waitcnt vmcnt(0)" ::: "memory");
        }
    }
    __syncthreads();
}
__device__ __forceinline__ int nrep_of(int n) { asm volatile("" : "+s"(n)); return n; }
struct Ctx {
    LAS unsigned char* lds; unsigned char* ldsg; const float* const* in; float* out; unsigned char* ws;
    int tid, lane, wave, G, bx, vcu;
};

__device__ __forceinline__ void phase_prologue(const Ctx& F) {
    LAS float* scr = (LAS float*)(F.lds + F.wave * 16384);
    const int gw = F.bx * NWAVES + F.wave, NGW = F.G * NWAVES;
    constexpr int I_IN = 16 * 53, I_UQ = 6 * 24, I_UKV = 4 * 32, I_OUT = 16 * 32, I_1 = 16 * 128, I_2 = 64 * 32, I_L = I_IN + I_UQ + I_UKV + I_OUT + I_1 + I_2;
    for (int it = gw; it < DEPTH * I_L; it += NGW) {
        const int l = it / I_L; int r = it - l * I_L;
        if (r < I_IN) { transpose_item(F.in[8] + (size_t)l * D * DIN, D, DIN, (bf16_t*)(F.ws + WS_WIN) + (size_t)l * ZP * D, nullptr, 1, scr, r, F.lane); continue; } r -= I_IN;
        if (r < I_UQ) { transpose_item(F.in[10] + (size_t)l * 384 * 768, 384, 768, (bf16_t*)(F.ws + WS_WUQ) + (size_t)l * 768 * 384, F.in[9] + l * 384, 2, scr, r, F.lane); continue; } r -= I_UQ;
        if (r < I_UKV) { transpose_item(F.in[12] + (size_t)l * 256 * 1024, 256, 1024, (bf16_t*)(F.ws + WS_WUKV) + (size_t)l * 1024 * 256, F.in[11] + l * 256, 0, scr, r, F.lane); continue; } r -= I_UKV;
        if (r < I_OUT) { transpose_item(F.in[21] + (size_t)l * D * D, D, D, (bf16_t*)(F.ws + WS_WOUT) + (size_t)l * D * D, nullptr, 0, scr, r, F.lane); continue; } r -= I_OUT;
        if (r < I_1) { transpose_item(F.in[22] + (size_t)l * D * DFF, D, DFF, (bf16_t*)(F.ws + WS_W1) + (size_t)l * DFF * D, nullptr, 0, scr, r, F.lane); continue; } r -= I_1;
        transpose_item(F.in[23] + (size_t)l * DFF * D, DFF, D, (bf16_t*)(F.ws + WS_W2) + (size_t)l * D * DFF, nullptr, 0, scr, r, F.lane);
    }
    for (int i = F.bx * NTHREADS + F.tid; i < DEPTH * 96 * D / 8; i += F.G * NTHREADS) { const int l = i / (96 * D / 8), r = i - l * (96 * D / 8);
        unsigned zz_ = 0u; asm volatile("" : "+v"(zz_)); *(u32x4*)((bf16_t*)(F.ws + WS_WIN) + ((size_t)l * ZP + DIN) * D + (size_t)r * 8) = (u32x4){zz_, zz_, zz_, zz_}; }
    if (F.bx == 0) for (int i = F.tid; i < 128 * 8; i += NTHREADS) { const int pos = i >> 3, j = i & 7; const float inv = 1.0f / powf(10000.0f, (float)j / 8.0f); const float ang = (float)pos * inv;
        float* rp = (float*)(F.ws + WS_ROPE) + i * 2; rp[0] = cosf(ang); rp[1] = sinf(ang); }
    __syncthreads();
    LAS float* sv = (LAS float*)F.lds;
    LAS float* red = (LAS float*)(F.lds + 40960);
    for (int i = F.tid; i < 9 * 1024; i += NTHREADS) { const int j = i >> 10, k = i & 1023; const float cvl = j < 8 ? F.in[1][j * 1024 + k] : F.in[3][k]; sv[i] = cvl * sigmoid_f(cvl); }
    __syncthreads();
    float* mods = (float*)(F.ws + WS_MODS);
    for (int it = F.bx; it < DEPTH * 96; it += F.G) {
        const int l = it / 96, cg_ = it - l * 96, col = F.tid & 63, kg = F.tid >> 6;
        const float* wp = F.in[4] + (size_t)l * D * 6144 + (size_t)(kg * 128) * 6144 + cg_ * 64 + col;
        float acc[9];
#pragma unroll
        for (int j = 0; j < 9; ++j) acc[j] = 0.f;
#pragma unroll 16
        for (int k = 0; k < 128; ++k) { const float w = wp[(size_t)k * 6144];
#pragma unroll
            for (int j = 0; j < 9; ++j) acc[j] += sv[j * 1024 + kg * 128 + k] * w; }
#pragma unroll
        for (int j = 0; j < 9; ++j) red[(kg * 9 + j) * 64 + col] = acc[j];
        __syncthreads();
        for (int i = F.tid; i < 9 * 64; i += NTHREADS) { const int j = i >> 6, c2 = i & 63; float s = F.in[5][l * 6144 + cg_ * 64 + c2];
#pragma unroll
            for (int g = 0; g < 8; ++g) s += red[(g * 9 + j) * 64 + c2];
            mods[((size_t)l * 9 + j) * 6144 + cg_ * 64 + c2] = s;
            const int cidx = cg_ * 64 + c2;
            if (cidx >= 1024 && cidx < 2048) ((float*)(F.ws + WS_STAB))[(((size_t)l * 2 + 0) * 9 + j) * 1024 + cidx - 1024] = F.in[6][l * 1024 + cidx - 1024] * (1.f + s);
            if (cidx >= 4096 && cidx < 5120) ((float*)(F.ws + WS_STAB))[(((size_t)l * 2 + 1) * 9 + j) * 1024 + cidx - 4096] = F.in[7][l * 1024 + cidx - 4096] * (1.f + s); }
        __syncthreads();
    }
}

__device__ __forceinline__ void phase_norm0(const Ctx& F) {
    const int gw = F.bx * NWAVES + F.wave, NGW = F.G * NWAVES; bf16_t* XS = (bf16_t*)(F.ws + WS_XN); float* ssqx = (float*)(F.ws + WS_SSQX);
    const float* stab = (const float*)(F.ws + WS_STAB);
    for (int wu = gw; wu < MALL / 16; wu += NGW) {
        const int r0 = wu * 16; const bool isctx = r0 >= TL; const int mi = isctx ? 8 : (r0 >> 13);
        const float* base = isctx ? F.in[2] + (size_t)(r0 - TL) * D : F.in[0] + (size_t)r0 * D;
        f32x4 S[4];
#pragma unroll
        for (int j = 0; j < 4; ++j) S[j] = *(const f32x4*)(stab + (size_t)mi * 1024 + 4 * F.lane + 256 * j);
        for (int i = 0; i < 16; ++i) {
            const f32x4* xr = (const f32x4*)(base + (size_t)i * D) + F.lane;
            f32x4 v[4]; float s = 0.f;
#pragma unroll
            for (int j = 0; j < 4; ++j) { v[j] = xr[64 * j]; s += (v[j][0] * v[j][0] + v[j][1] * v[j][1]) + (v[j][2] * v[j][2] + v[j][3] * v[j][3]); }
            bf16_t* orow = XS + (size_t)(r0 + i) * D + 4 * F.lane;
#pragma unroll
            for (int j = 0; j < 4; ++j) { const f32x4 o = v[j] * S[j]; u32x2 w; w.x = pk2(o[0], o[1]); w.y = pk2(o[2], o[3]); *(u32x2*)(orow + 256 * j) = w;
                u32x2 wb; wb.x = pk2(v[j][0], v[j][1]); wb.y = pk2(v[j][2], v[j][3]); *(u32x2*)((bf16_t*)(F.ws + WS_XB) + (size_t)(r0 + i) * D + 4 * F.lane + 256 * j) = wb; }
            const float tot = wave_sum(s, F.lane);
            if (F.lane < 4) { f32x4 q = {0.f, 0.f, 0.f, 0.f}; if (F.lane == 0) q[0] = tot; *(f32x4*)(ssqx + (size_t)(r0 + i) * 16 + 4 * F.lane) = q; }
        }
    }
    __syncthreads();
    LAS float* sv = (LAS float*)F.lds;
    LAS float* red = (LAS float*)(F.lds + 40960);
    const float* mods = (const float*)(F.ws + WS_MODS); float* shw = (float*)(F.ws + WS_SHW);
    constexpr int G_IN = 28, G_FF = 64, G_L = G_IN + G_FF;
    for (int it = F.bx; it < DEPTH * G_L; it += F.G) {
        const int l = it / G_L, gi = it - l * G_L; const bool isin = gi < G_IN; const int cg_ = isin ? gi : gi - G_IN;
        const int shoff = isin ? 0 : 3072, N = isin ? DIN : DFF; const float* W = isin ? F.in[8] + (size_t)l * D * DIN : F.in[22] + (size_t)l * D * DFF;
        __syncthreads();
        for (int i = F.tid; i < 9 * 1024; i += NTHREADS) { const int j = i >> 10, k = i & 1023; sv[i] = mods[((size_t)l * 9 + j) * 6144 + shoff + k]; }
        __syncthreads();
        const int col = F.tid & 63, kg = F.tid >> 6, n = cg_ * 64 + col; const bool valid = n < N;
        float acc[9];
#pragma unroll
        for (int j = 0; j < 9; ++j) acc[j] = 0.f;
        if (valid) { const float* wp = W + (size_t)(kg * 128) * N + n;
#pragma unroll 16
            for (int k = 0; k < 128; ++k) { const float w = wp[(size_t)k * N];
#pragma unroll
                for (int j = 0; j < 9; ++j) acc[j] += sv[j * 1024 + kg * 128 + k] * w; } }
#pragma unroll
        for (int j = 0; j < 9; ++j) red[(kg * 9 + j) * 64 + col] = acc[j];
        __syncthreads();
        for (int i = F.tid; i < 9 * 64; i += NTHREADS) { const int j = i >> 6, c2 = i & 63, n2 = cg_ * 64 + c2; float sm = 0.f;
#pragma unroll
            for (int g = 0; g < 8; ++g) sm += red[(g * 9 + j) * 64 + c2];
            if (isin) { if (n2 < DIN) shw[(size_t)l * SHW_L + j * SHW_IN + rowmap(1, n2)] = sm; else shw[(size_t)l * SHW_L + j * SHW_IN + n2] = 0.f; }
            else shw[(size_t)l * SHW_L + 9 * SHW_IN + j * DFF + n2] = sm; }
    }
    __syncthreads();
}
__device__ __forceinline__ void phase_final_norm(const Ctx& F) {
    const int gw = F.bx * NWAVES + F.wave, NGW = F.G * NWAVES; const float* g = F.in[24]; const bf16_t* XB = (const bf16_t*)(F.ws + WS_XB);
    f32x4 S[4];
#pragma unroll
    for (int j = 0; j < 4; ++j) S[j] = *(const f32x4*)(g + 4 * F.lane + 256 * j);
    for (int r = gw; r < TL; r += NGW) {
        f32x4* orow = (f32x4*)(F.out + (size_t)r * D) + F.lane;
        f32x4 v[4]; float s = 0.f;
#pragma unroll
        for (int j = 0; j < 4; ++j) { const u32x2 w = *(const u32x2*)(XB + (size_t)r * D + 4 * F.lane + 256 * j);
            v[j] = (f32x4){__uint_as_float(w.x << 16), __uint_as_float(w.x & 0xffff0000u), __uint_as_float(w.y << 16), __uint_as_float(w.y & 0xffff0000u)};
            s += (v[j][0] * v[j][0] + v[j][1] * v[j][1]) + (v[j][2] * v[j][2] + v[j][3] * v[j][3]); }
        const float rstd = rsqrtf(wave_sum(s, F.lane) * (1.0f / D) + 1e-6f);
#pragma unroll
        for (int j = 0; j < 4; ++j) orow[64 * j] = v[j] * rstd * S[j];
    }
}

__device__ __forceinline__ void phase_ctx_finish(const Ctx& F, const float* gate  , const float* stab  ) {
    const int gw = F.bx * NWAVES + F.wave, NGW = F.G * NWAVES; bf16_t* XB = (bf16_t*)(F.ws + WS_XB); bf16_t* XS = (bf16_t*)(F.ws + WS_XN); float* ssqx = (float*)(F.ws + WS_SSQX);
    const float* P = (const float*)(F.ws + WS_PART);
    for (int rc = gw; rc < TC; rc += NGW) {
        const int row = TL + rc; float s = 0.f;
#pragma unroll
        for (int j = 0; j < 4; ++j) { const int c = 4 * F.lane + 256 * j; const size_t po = (size_t)rc * D + c;
            const f32x4 p = (*(const f32x4*)(P + po) + *(const f32x4*)(P + (size_t)TC * D + po)) + (*(const f32x4*)(P + (size_t)2 * TC * D + po) + *(const f32x4*)(P + (size_t)3 * TC * D + po));
            const u32x2 xr = *(const u32x2*)(XB + (size_t)row * D + c);
            const f32x4 x = {__uint_as_float(xr.x << 16), __uint_as_float(xr.x & 0xffff0000u), __uint_as_float(xr.y << 16), __uint_as_float(xr.y & 0xffff0000u)};
            const f32x4 y = x + *(const f32x4*)(gate + c) * p, t = y * *(const f32x4*)(stab + c);
            u32x2 w; w.x = pk2(y[0], y[1]); w.y = pk2(y[2], y[3]); *(u32x2*)(XB + (size_t)row * D + c) = w;
            u32x2 w2; w2.x = pk2(t[0], t[1]); w2.y = pk2(t[2], t[3]); *(u32x2*)(XS + (size_t)row * D + c) = w2;
            s += (y[0] * y[0] + y[1] * y[1]) + (y[2] * y[2] + y[3] * y[3]); }
        const float tot = wave_sum(s, F.lane);
        if (F.lane < 4) { f32x4 q = {0.f, 0.f, 0.f, 0.f}; if (F.lane == 0) q[0] = tot; *(f32x4*)(ssqx + (size_t)row * 16 + 4 * F.lane) = q; }
    }
}

__device__ __forceinline__ void phase_krope(const Ctx& F) {
    const bf16_t* Z = (const bf16_t*)(F.ws + WS_Z); bf16_t* KR = (bf16_t*)(F.ws + WS_KR); const float* rope = (const float*)(F.ws + WS_ROPE);
    for (int i = F.bx * NTHREADS + F.tid; i < MALL * 4; i += F.G * NTHREADS) {
        const int row = i >> 2, ch = i & 3;
        const u32x4 raw = *(const u32x4*)(Z + (size_t)row * ZP + 640 + ch * 8);
        float a[8];
#pragma unroll
        for (int e = 0; e < 4; ++e) { a[2 * e] = __uint_as_float(raw[e] << 16); a[2 * e + 1] = __uint_as_float(raw[e] & 0xffff0000u); }
        int b, kpos;
        if (row < TL) { b = row >> 13; const int t = row & 8191; kpos = 256 + t; const int g = ch >> 1, j0 = (ch & 1) * 4; const int pos = g ? (t & 63) : (t >> 6);
            const f32x4* tb = (const f32x4*)(rope + (pos * 8 + j0) * 2); const f32x4 c0 = tb[0], c1 = tb[1];
            const float cs[8] = {c0[0], c0[1], c0[2], c0[3], c1[0], c1[1], c1[2], c1[3]};
#pragma unroll
            for (int p = 0; p < 4; ++p) { const float x1 = a[2 * p], x2 = a[2 * p + 1], c = cs[2 * p], s = cs[2 * p + 1]; a[2 * p] = x1 * c - x2 * s; a[2 * p + 1] = x2 * c + x1 * s; } }
        else { const int rc = row - TL; b = rc >> 8; kpos = rc & 255; }
        u32x4 o; o.x = pk2(a[0], a[1]); o.y = pk2(a[2], a[3]); o.z = pk2(a[4], a[5]); o.w = pk2(a[6], a[7]);
        *(u32x4*)(KR + ((size_t)b * LK + kpos) * 32 + ch * 8) = o;
    }
}

__device__ __forceinline__ void phase_conv(const Ctx& F, int l, int nrows, int rot) {
    const bf16_t* Z = (const bf16_t*)(F.ws + WS_Z); bf16_t* Y = (bf16_t*)(F.ws + WS_Y);
    LAS float* yin = (LAS float*)F.lds;
    LAS float* yout = (LAS float*)(F.lds + 65536);
    const float* cw = F.in[13] + (size_t)l * 31 * 256; const float* cb = F.in[14] + l * 256; const float* lg = F.in[15] + l * 256; const float* lb = F.in[16] + l * 256;
    const int c = F.tid & 255, th = F.tid >> 8;
    float w[31];
#pragma unroll
    for (int j = 0; j < 31; ++j) w[j] = cw[j * 256 + c];
    const float bias = cb[c];
    const f32x4 g4 = *(const f32x4*)(lg + 4 * F.lane), b4 = *(const f32x4*)(lb + 4 * F.lane);
    const int nunits = nrows / 32;
    for (int un = (F.bx - rot + F.G) % F.G; un < nunits; un += F.G) {
        const int r0 = un * 32; int s0, s1;
        if (r0 < TL) { s0 = r0 & ~8191; s1 = s0 + 8192; } else { s0 = TL + ((r0 - TL) & ~255); s1 = s0 + 256; }
        __syncthreads();
#pragma unroll
        for (int it_ = 0; it_ < 4; ++it_) { const int it = F.tid + it_ * NTHREADS; if (it >= 62 * 32) break; const int i = it >> 5, ch = it & 31; const int row = r0 - 15 + i;
            f32x4 o0 = {0.f, 0.f, 0.f, 0.f}, o1 = o0;
            if (row >= s0 && row < s1) { const u32x4 ra = *(const u32x4*)(Z + (size_t)row * ZP + 672 + ch * 8), rg = *(const u32x4*)(Z + (size_t)row * ZP + 928 + ch * 8);
#pragma unroll
                for (int e = 0; e < 4; ++e) { const float a0 = __uint_as_float(ra[e] << 16), a1 = __uint_as_float(ra[e] & 0xffff0000u), g0 = __uint_as_float(rg[e] << 16), g1 = __uint_as_float(rg[e] & 0xffff0000u);
                    const float y0 = a0 * sigmoid_f(g0), y1 = a1 * sigmoid_f(g1);
                    if (e < 2) { o0[2 * e] = y0; o0[2 * e + 1] = y1; } else { o1[2 * e - 4] = y0; o1[2 * e - 3] = y1; } } }
            *(LAS f32x4*)(yin + i * 256 + ch * 8) = o0; *(LAS f32x4*)(yin + i * 256 + ch * 8 + 4) = o1; }
        __syncthreads();
        for (int ob = 0; ob < 2; ++ob) {
            const LAS float* xp = yin + (16 * th + 8 * ob) * 256 + c;
            float x[38];
#pragma unroll
            for (int k = 0; k < 38; ++k) x[k] = xp[k * 256];
#pragma unroll
            for (int oo = 0; oo < 8; ++oo) { float a = bias;
#pragma unroll
                for (int j = 0; j < 31; ++j) a += x[oo + j] * w[j];
                yout[(16 * th + 8 * ob + oo) * 256 + c] = a; }
        }
        __syncthreads();
#pragma unroll
        for (int i = 0; i < 4; ++i) { const int tk = F.wave * 4 + i; const f32x4 v = *(LAS f32x4*)(yout + tk * 256 + 4 * F.lane);
            const float mu = wave_sum((v[0] + v[1]) + (v[2] + v[3]), F.lane) * (1.0f / 256.0f); const f32x4 dv = v - mu;
            const float var = wave_sum((dv[0] * dv[0] + dv[1] * dv[1]) + (dv[2] * dv[2] + dv[3] * dv[3]), F.lane) * (1.0f / 256.0f);
            const float rstd = rsqrtf(var + 1e-6f); f32x4 y = dv * rstd * g4 + b4;
#pragma unroll
            for (int e = 0; e < 4; ++e) y[e] = y[e] * sigmoid_f(y[e]);
            u32x2 wv; wv.x = pk2(y[0], y[1]); wv.y = pk2(y[2], y[3]); *(u32x2*)(Y + (size_t)(r0 + tk) * D + 512 + 4 * F.lane) = wv; }
    }
    __syncthreads();
}

__device__ __forceinline__ void phase_sgu(const Ctx& F, int l, int nrows, int rot) {
    const bf16_t* Z = (const bf16_t*)(F.ws + WS_Z); bf16_t* Y = (bf16_t*)(F.ws + WS_Y);
    const float* lg = F.in[17] + l * 256; const float* lb = F.in[18] + l * 256; const float* sw = F.in[19] + (size_t)l * 4 * 128 * 128; const float* sb = F.in[20] + l * 4 * 128;
    const int lane = F.lane, r32 = lane & 31, hi = lane >> 5;
    const int c8 = (lane & 31) * 8;
    f32x4 g0 = *(const f32x4*)(lg + c8), g1 = *(const f32x4*)(lg + c8 + 4), b0 = *(const f32x4*)(lb + c8), b1 = *(const f32x4*)(lb + c8 + 4);
    const int nunits = nrows / 128;
    for (int un = (F.bx - rot + F.G) % F.G; un < nunits; un += F.G) {
        const int r0 = un * 128;
        __syncthreads();
#pragma unroll
        for (int i = 0; i < 8; ++i) { const int q = F.wave * 16 + 2 * i + hi; const u32x4 raw = *(const u32x4*)(Z + (size_t)(r0 + q) * ZP + 1440 + c8);
            float a[8]; float s = 0.f;
#pragma unroll
            for (int e = 0; e < 4; ++e) { a[2 * e] = gelu_tanh(__uint_as_float(raw[e] << 16)); a[2 * e + 1] = gelu_tanh(__uint_as_float(raw[e] & 0xffff0000u)); s += a[2 * e] + a[2 * e + 1]; }
#pragma unroll
            for (int o = 1; o < 32; o <<= 1) s += shx(s, o, lane);
            const float mu = s * (1.0f / 256.0f); float q2 = 0.f;
#pragma unroll
            for (int e = 0; e < 8; ++e) { a[e] -= mu; q2 += a[e] * a[e]; }
#pragma unroll
            for (int o = 1; o < 32; o <<= 1) q2 += shx(q2, o, lane);
            const float rstd = rsqrtf(q2 * (1.0f / 256.0f) + 1e-6f);
            u32x4 o4; o4.x = pk2(a[0] * rstd * g0[0] + b0[0], a[1] * rstd * g0[1] + b0[1]); o4.y = pk2(a[2] * rstd * g0[2] + b0[2], a[3] * rstd * g0[3] + b0[3]);
            o4.z = pk2(a[4] * rstd * g1[0] + b1[0], a[5] * rstd * g1[1] + b1[1]); o4.w = pk2(a[6] * rstd * g1[2] + b1[2], a[7] * rstd * g1[3] + b1[3]);
            *(u32x4*)(F.ldsg + (c8 >> 6) * 16384 + (q >> 6) * 8192 + att::v_st(q & 63, c8 & 63)) = o4; }
        __syncthreads();
        const int h = F.wave >> 1, ph = F.wave & 1;
        f32x16 o[2][2] = {};
#pragma unroll
        for (int kt = 0; kt < 2; ++kt) { const int vb = (int)(uintptr_t)F.ldsg + h * 16384 + kt * 8192 + att::v_rd_base(lane);
#pragma unroll
            for (int mt = 0; mt < 2; ++mt) { bf16x8 pa[4]; const float* wr_ = sw + ((size_t)h * 128 + ph * 64 + mt * 32 + r32) * 128 + kt * 64 + hi * 8;
#pragma unroll
                for (int ks = 0; ks < 4; ++ks) { const f32x4 w0 = *(const f32x4*)(wr_ + ks * 16), w1 = *(const f32x4*)(wr_ + ks * 16 + 4); const u32x4 pw = pg8::pack8(w0, w1); pa[ks] = *reinterpret_cast<const bf16x8*>(&pw); }
                att::pv_one<0>(o[mt][0], vb, pa[0], pa[1], pa[2], pa[3]); att::pv_one<1>(o[mt][1], vb, pa[0], pa[1], pa[2], pa[3]); } }
        {
            LAS bf16_t* mx = (LAS bf16_t*)(F.lds + 65536);
#pragma unroll
            for (int mt = 0; mt < 2; ++mt)
#pragma unroll
                for (int r = 0; r < 16; ++r) { const int p = ph * 64 + mt * 32 + att::crow(r, hi); const float bs = sb[h * 128 + p];
#pragma unroll
                    for (int d0 = 0; d0 < 2; ++d0) { const float v = o[mt][d0][r] + bs; mx[p * 256 + h * 64 + d0 * 32 + r32] = (bf16_t)(pk2(v, v) & 0xffffu); } }
            __syncthreads();
#pragma unroll
            for (int it_ = 0; it_ < 8; ++it_) { const int it = F.tid + it_ * NTHREADS; const int p = it >> 5, ch = it & 31;
                const u32x4 mraw = *(const LAS u32x4*)(mx + p * 256 + ch * 8);
                const u32x4 zraw = *(const u32x4*)(Z + (size_t)(r0 + p) * ZP + 1184 + ch * 8);
                float ov[8];
#pragma unroll
                for (int e = 0; e < 4; ++e) { ov[2 * e] = gelu_tanh(__uint_as_float(zraw[e] << 16)) * __uint_as_float(mraw[e] << 16); ov[2 * e + 1] = gelu_tanh(__uint_as_float(zraw[e] & 0xffff0000u)) * __uint_as_float(mraw[e] & 0xffff0000u); }
                u32x4 o4; o4.x = pk2(ov[0], ov[1]); o4.y = pk2(ov[2], ov[3]); o4.z = pk2(ov[4], ov[5]); o4.w = pk2(ov[6], ov[7]);
                *(u32x4*)(Y + (size_t)(r0 + p) * D + 768 + ch * 8) = o4; }
        }
    }
    __syncthreads();
}

__device__ __forceinline__ void phase_attn(const Ctx& F, bool with_ctx) {
    const bf16_t* Q = (const bf16_t*)(F.ws + WS_Q); const bf16_t* KN = (const bf16_t*)(F.ws + WS_KN); const bf16_t* KR = (const bf16_t*)(F.ws + WS_KR); const bf16_t* V = (const bf16_t*)(F.ws + WS_V);
    bf16_t* Y = (bf16_t*)(F.ws + WS_Y);
    const int nlat = BATCH * 8 * 32, ntot = nlat + (with_ctx ? BATCH * 8 : 0);
    __syncthreads();
    for (int U = F.vcu; U < ntot; U += F.G) {
        int bh, row0, nkeys;
        if (U < nlat) { bh = U >> 5; const int qb = U & 31; row0 = (bh >> 3) * SEQ + qb * 256; nkeys = LK; }
        else { bh = U - nlat; row0 = TL + (bh >> 3) * CTXL; nkeys = CTXL; }
        const int b = bh >> 3, h = bh & 7;
        att::attn_unit(Q + (size_t)row0 * 768 + h * 96, KN + (size_t)bh * LK * 64, KR + (size_t)b * LK * 32, V + (size_t)bh * LK * 64, Y + (size_t)row0 * D + h * 64, nkeys, (char*)F.ldsg, F.tid);
    }
}

__global__ void __launch_bounds__(NTHREADS, 2) mega_fwd(Args args) {
    extern __shared__ __attribute__((aligned(16))) unsigned char lds[];
    Ctx F; F.lds = (LAS unsigned char*)lds; F.ldsg = lds; F.in = args.in; F.out = args.out; F.ws = args.ws;
    const int wave_s = __builtin_amdgcn_readfirstlane((int)threadIdx.x >> 6); F.tid = 0; F.lane = 0; F.wave = wave_s; F.G = gridDim.x; F.bx = blockIdx.x;
    F.vcu = (F.G % 8 == 0) ? (F.bx % 8) * (F.G / 8) + F.bx / 8 : F.bx;
    const bool multi = (args.ph_hi - args.ph_lo) > 1;
    volatile LAS unsigned* bst = (volatile LAS unsigned*)(F.lds + LDS_BYTES - 64);
    if (threadIdx.x < 2) bst[threadIdx.x] = 0u;
    __syncthreads();
    XcdBarrier gbar; gbar.bar = (unsigned*)args.ws; gbar.x = 0; gbar.st = nullptr;
    if (multi) gbar = xcd_barrier_post((unsigned*)args.ws, bst);
    const int ph_lo_u = __builtin_amdgcn_readfirstlane(args.ph_lo), ph_hi_u = __builtin_amdgcn_readfirstlane(args.ph_hi);
    for (int ph = ph_lo_u; ph < ph_hi_u; ++ph) {
#define SETLANE() do { int l_; asm volatile("v_mbcnt_lo_u32_b32 %0, -1, 0\n\tv_mbcnt_hi_u32_b32 %0, -1, %0" : "=&v"(l_)); F.lane = l_; F.tid = wave_s * 64 + l_; F.wave = wave_s; } while (0)
        { int z_ = 0; asm volatile("s_mov_b32 %0, 0" : "=s"(z_)); F.ws = args.ws + z_; F.out = args.out + z_; F.in = args.in + z_; }
        float* mods = (float*)(F.ws + WS_MODS); float* ssq = (float*)(F.ws + WS_SSQ); float* cx = (float*)(F.ws + WS_CX); const float* rope = (const float*)(F.ws + WS_ROPE);
        bf16_t* XN = (bf16_t*)(F.ws + WS_XN); bf16_t* Z = (bf16_t*)(F.ws + WS_Z); bf16_t* Qb = (bf16_t*)(F.ws + WS_Q); bf16_t* Y = (bf16_t*)(F.ws + WS_Y); bf16_t* H = (bf16_t*)(F.ws + WS_H);
        float* ssqx = (float*)(F.ws + WS_SSQX); const float* shw = (const float*)(F.ws + WS_SHW); const float* stab = (const float*)(F.ws + WS_STAB);
        if (ph == 0) { if (PHM & 1) REPS(1) { SETLANE(); phase_prologue(F); } }
        else if (ph == 1) { if (PHM & 4) REPS(4) { SETLANE(); phase_norm0(F); } }
        else if (ph == 2 + 6 * DEPTH) { if (PHM & 2) REPS(2) { SETLANE(); phase_final_norm(F); } }
        else {
            const int l = (ph - 2) / 6, sub = (ph - 2) - 6 * l; const bool last = (l == DEPTH - 1); const float* mods_l = mods + (size_t)l * 9 * 6144;
            const int Mx = last ? TL : MALL;
            if (sub == 0) { if (PHM & 8) REPS(8) { SETLANE(); pg8::Gemm g{XN, (const bf16_t*)(F.ws + WS_WIN) + (size_t)l * ZP * D, MALL, ZP, D, D}; pg8::StaticOrder S; S.init(MALL, ZP, F.G, F.bx);
                pg8::EpiZ E{Z, ssq, ssqx, shw + (size_t)l * SHW_L}; pg8::gemm_phase<pg8::EpiZ, pg8::StaticOrder, true, true, 1024, 1024>(F.lds, g, S, E, F.tid); } }
            else if (sub == 1) {
                if (PHM & 16) REPS(16) { SETLANE(); pg8::Gemm g{Z, (const bf16_t*)(F.ws + WS_WUQ) + (size_t)l * 768 * 384, Mx, 768, 384, ZP}; pg8::StaticOrder S; S.init(Mx, 768, F.G, F.bx);
                  pg8::EpiQ E{Qb, ssq, rope}; pg8::gemm_phase<pg8::EpiQ, pg8::StaticOrder, true, true, 384, 1792>(F.lds, g, S, E, F.tid); }
                if (PHM & 32) REPS(32) { SETLANE(); pg8::Gemm g{Z + 384, (const bf16_t*)(F.ws + WS_WUKV) + (size_t)l * 1024 * 256, MALL, 1024, 256, ZP}; pg8::StaticOrder S; S.init(MALL, 1024, F.G, (F.bx - 24 + F.G) % F.G);
                  pg8::EpiKV E{(bf16_t*)(F.ws + WS_KN), (bf16_t*)(F.ws + WS_V), ssq}; pg8::gemm_phase<pg8::EpiKV, pg8::StaticOrder, true, true, 256, 1792>(F.lds, g, S, E, F.tid); }
                if (PHM & 64) REPS(64) { SETLANE(); phase_conv(F, l, Mx, 56); }
                if (PHM & 128) REPS(128) { SETLANE(); phase_sgu(F, l, Mx, 88); }
                if (PHM & 256) REPS(256) { SETLANE(); phase_krope(F); }
            }
            else if (sub == 2) { if (PHM & 512) REPS(512) { SETLANE(); phase_attn(F, !last); } }
            else if (sub == 3) { if (PHM & 1024) REPS(1024) { SETLANE(); pg8::Gemm g{Y, (const bf16_t*)(F.ws + WS_WOUT) + (size_t)l * D * D, Mx, D, D, D}; pg8::StaticOrder S; S.init(Mx, D, F.G, F.bx);
                pg8::EpiRes E{(bf16_t*)(F.ws + WS_XB), mods_l + 2048, XN, ssqx, stab + ((size_t)l * 2 + 1) * 9 * 1024};
                pg8::gemm_phase<pg8::EpiRes, pg8::StaticOrder, true, true, 1024, 1024>(F.lds, g, S, E, F.tid); } }
            else if (sub == 4) { if (PHM & 4096) REPS(4096) { SETLANE();
                unsigned* cnt = (unsigned*)F.ws + 3600 + 64 * l;
                const bf16_t* W1 = (const bf16_t*)(F.ws + WS_W1) + (size_t)l * DFF * D;
                if (!last) {
                    pg8::Gemm g{XN + (size_t)TL * D, W1, TC, DFF, D, D}; pg8::CountingOrder S; S.S.init(TC, DFF, F.G, F.bx); S.cnt = cnt;
                    pg8::EpiFF1 E{H, ssqx, shw + (size_t)l * SHW_L + 9 * SHW_IN, TL}; pg8::gemm_phase<pg8::EpiFF1, pg8::CountingOrder, true, true, 1024, 1024>(F.lds, g, S, E, F.tid); }
                {
                    pg8::Gemm g{XN, W1, TL, DFF, D, D}; pg8::StaticOrder S; S.init(TL, DFF, F.G, F.bx);
                    pg8::EpiFF1 E{H, ssqx, shw + (size_t)l * SHW_L + 9 * SHW_IN, 0}; pg8::gemm_phase<pg8::EpiFF1, pg8::StaticOrder, true, true, 1024, 1024>(F.lds, g, S, E, F.tid); }
                if (!last) {
                    const int q = F.bx - 128; const bool mine = q >= 0 && q < 128; const int ks = q >> 5, t = q & 31;
                    if (mine) {
                        if (F.tid == 0) { unsigned sp = 0; while (__hip_atomic_load(cnt, __ATOMIC_RELAXED, __HIP_MEMORY_SCOPE_AGENT) < 1024u) { __builtin_amdgcn_s_sleep(2); if (++sp > (1u << 22)) break; } }
                        __syncthreads(); __builtin_amdgcn_fence(__ATOMIC_ACQUIRE, "agent"); asm volatile("s_waitcnt vmcnt(0)" ::: "memory"); }
                    pg8::Gemm g{H + (size_t)TL * DFF + (mine ? ks : 0) * 1024, (const bf16_t*)(F.ws + WS_W2) + (size_t)l * D * DFF + (mine ? ks : 0) * 1024, TC, D, 1024, DFF};
                    pg8::OneUnit S{t >> 2, t & 3, mine};
                    pg8::EpiPart E{(float*)(F.ws + WS_PART) + (size_t)(mine ? ks : 0) * TC * D}; pg8::gemm_phase<pg8::EpiPart, pg8::OneUnit, true, true, 1024, 4096, 4096>(F.lds, g, S, E, F.tid); }
                } }
            else { if (PHM & 8192) REPS(8192) { SETLANE();
                if (!last) phase_ctx_finish(F, mods_l + 5120 + 8 * 6144, stab + ((size_t)(l + 1) * 2 + 0) * 9 * 1024 + 8 * 1024);
                pg8::Gemm g{H, (const bf16_t*)(F.ws + WS_W2) + (size_t)l * D * DFF, TL, D, DFF, DFF}; pg8::StaticOrder S; S.init(TL, D, F.G, F.bx);
                pg8::EpiRes E{(bf16_t*)(F.ws + WS_XB), mods_l + 5120, XN, ssqx, last ? (const float*)nullptr : stab + ((size_t)(l + 1) * 2 + 0) * 9 * 1024};
                pg8::gemm_phase<pg8::EpiRes, pg8::StaticOrder, true, true, 4096, 4096>(F.lds, g, S, E, F.tid); } }
        }
        if (ph + 1 < ph_hi_u) { if (ph == ph_lo_u) cg::this_grid().sync(); else xcd_barrier(gbar); }
    }
}

constexpr int NPHASES = 3 + 6 * DEPTH;
extern "C" void kernel_launch(void* const* d_in, const int* in_sizes, int n_in, void* d_out, int out_size, void* d_ws, size_t ws_size, hipStream_t stream) {
    static int grid = 0;
    if (grid == 0) {
        if (n_in != 25 || out_size != TL * D || ws_size < WS_END2) { fprintf(stderr, "kernel_launch: unexpected shapes: n_in %d out %d ws %zu (need %zu)\n", n_in, out_size, ws_size, (size_t)WS_END2); grid = -1; return; }
        int dev = 0, cus = 0, per_cu = 0;
        hipGetDevice(&dev); hipDeviceGetAttribute(&cus, hipDeviceAttributeMultiprocessorCount, dev);
        if (hipFuncSetAttribute((const void*)mega_fwd, hipFuncAttributeMaxDynamicSharedMemorySize, LDS_BYTES) != hipSuccess) { fprintf(stderr, "kernel_launch: hipFuncSetAttribute failed\n"); grid = -1; return; }
        if (hipOccupancyMaxActiveBlocksPerMultiprocessor(&per_cu, (const void*)mega_fwd, NTHREADS, LDS_BYTES) != hipSuccess || per_cu < 1) { fprintf(stderr, "kernel_launch: occupancy query says %d\n", per_cu); per_cu = 1; }
        (void)hipGetLastError();
        grid = cus * 1;
    }
    if (grid < 0) return;
    Args a{};
    for (int i = 0; i < 25; ++i) a.in[i] = (const float*)d_in[i];
    a.out = (float*)d_out; a.ws = (unsigned char*)d_ws;
#if ONE_LAUNCH
    if (hipMemsetAsync(d_ws, 0, 16384, stream) != hipSuccess) { fprintf(stderr, "kernel_launch: memset of barrier words failed\n"); return; }
    a.ph_lo = 0; a.ph_hi = NPHASES;
    void* kargs[] = {&a};
    hipError_t e = hipLaunchCooperativeKernel((const void*)mega_fwd, dim3(grid), dim3(NTHREADS), kargs, LDS_BYTES, stream);
    if (e != hipSuccess) fprintf(stderr, "cooperative launch failed: %s (grid %d)\n", hipGetErrorString(e), grid);
#else
    for (int ph = 0; ph < NPHASES; ++ph) { a.ph_lo = ph; a.ph_hi = ph + 1; hipLaunchKernelGGL(mega_fwd, dim3(grid), dim3(NTHREADS), LDS_BYTES, stream, a); }
#endif
}
```

```cpp
#include <hip/hip_runtime.h>
#include <hip/hip_bf16.h>
#include <hip/hip_cooperative_groups.h>
#include <cstdio>
#include <cstdint>
namespace cg = cooperative_groups;
#ifndef PHM
#define PHM 0xffff
#endif
#ifndef DUPM
#define DUPM 0
#endif
#define REPS(bit) for (int rep_ = 0, nrep_ = nrep_of((DUPM & (bit)) ? 2 : 1); rep_ < nrep_; ++rep_)
#ifndef ONE_LAUNCH
#define ONE_LAUNCH 1
#endif
typedef unsigned short bf16_t;
__device__ __forceinline__ float shx(float v, int o, int lane) { return __int_as_float(__builtin_amdgcn_ds_bpermute((lane ^ o) << 2, __float_as_int(v))); }
constexpr int T_LAT = 65536, ZP = 1792, LK = 8448;
namespace pg8 {
#define PG8_LAS __attribute__((address_space(3)))
typedef unsigned short bf16_t;
typedef short bf16x8 __attribute__((ext_vector_type(8)));
typedef float f32x4 __attribute__((ext_vector_type(4)));
typedef unsigned u32x4 __attribute__((ext_vector_type(4)));
constexpr int BM = 256, BK = 64, HALF = 128, HTB = HALF * BK * 2  , STAGE_BYTES = 8 * HTB, NXCD = 8, WGM = 8;

__host__ __device__ __forceinline__ int lds_byte(int r, int c) { const int st = (r >> 4) * 2 + (c >> 5), rr = r & 15, cc = c & 31, ob = rr * 64 + cc * 2; return st * 1024 + (ob ^ (((ob >> 9) & 1) << 5)); }
__host__ __device__ __forceinline__ void stage_rc(int b, int& R, int& C) { const int st = b / 1024, sb = b % 1024, swz = sb ^ (((sb >> 9) & 1) << 5); R = (st >> 1) * 16 + swz / 64; C = (st & 1) * 32 + (swz % 64) / 2; }
__host__ __device__ __forceinline__ int perm32(int rho) { const int n = rho >> 4, i = rho & 15; return 8 * (i >> 2) + 4 * n + (i & 3); }

struct Unit { int pm, pn; };
struct Gemm { const bf16_t* A; const bf16_t* Bt; int M, N, K, lda; };

struct StaticOrder {
    int nM, nN, nwg, G, c; bool rev;
    __host__ __device__ void init(int M, int N, int G_, int c_, bool rev_ = false) { nM = M / BM; nN = N / BM; nwg = nM * nN; G = G_; c = c_; rev = rev_; }
    __host__ __device__ bool next(int i, Unit& u) const {
        const long L = (long)i * G + c; if (L >= nwg) return false;
        int wgid = (int)L; { const int q = nwg / NXCD, r = nwg % NXCD, xcd = wgid % NXCD, off = wgid / NXCD; wgid = (xcd < r ? xcd * (q + 1) : r * (q + 1) + (xcd - r) * q) + off; }
        const int nig = WGM * nN, gid = wgid / nig, fm = gid * WGM, gsz = (nM - fm) < WGM ? (nM - fm) : WGM;
        u.pm = fm + ((wgid % nig) % gsz); u.pn = (wgid % nig) / gsz; if (rev) u.pm = nM - 1 - u.pm; return true;
    }
    __device__ __forceinline__ void a_ready(const Unit&) const {}
    __device__ __forceinline__ void done(const Unit&) const {}
};

struct OneUnit {
    int pm, pn; bool valid;
    __device__ __forceinline__ bool next(int i, Unit& u) const { if (i != 0 || !valid) return false; u.pm = pm; u.pn = pn; return true; }
    __device__ __forceinline__ void a_ready(const Unit&) const {}
    __device__ __forceinline__ void done(const Unit&) const {}
};
struct CountingOrder {
    StaticOrder S; unsigned* cnt;
    __device__ __forceinline__ bool next(int i, Unit& u) const { return S.next(i, u); }
    __device__ __forceinline__ void a_ready(const Unit&) const {}
    __device__ __forceinline__ void done(const Unit&) const {
        __builtin_amdgcn_fence(__ATOMIC_RELEASE, "agent"); asm volatile("s_waitcnt vmcnt(0)" ::: "memory");
        int ln_; asm volatile("v_mbcnt_lo_u32_b32 %0, -1, 0\n\tv_mbcnt_hi_u32_b32 %0, -1, %0" : "=&v"(ln_));
        if (ln_ == 0) __hip_atomic_fetch_add(cnt, 1u, __ATOMIC_RELAXED, __HIP_MEMORY_SCOPE_AGENT);
    }
};
__device__ __forceinline__ unsigned cvt_pk_bf16(float lo, float hi) { unsigned r; asm volatile("v_cvt_pk_bf16_f32 %0, %1, %2" : "=v"(r) : "v"(lo), "v"(hi)); return r; }
__device__ __forceinline__ u32x4 pack8(f32x4 v0, f32x4 v1) { u32x4 w; w.x = cvt_pk_bf16(v0[0], v0[1]); w.y = cvt_pk_bf16(v0[2], v0[3]); w.z = cvt_pk_bf16(v1[0], v1[1]); w.w = cvt_pk_bf16(v1[2], v1[3]); return w; }

__device__ __forceinline__ float sum_fq(float s) {
    { auto r = __builtin_amdgcn_permlane16_swap(__float_as_uint(s), __float_as_uint(s), false, false); s = __uint_as_float(r[0]) + __uint_as_float(r[1]); }
    { auto r = __builtin_amdgcn_permlane32_swap(__float_as_uint(s), __float_as_uint(s), false, false); s = __uint_as_float(r[0]) + __uint_as_float(r[1]); }
    return s;
}
__device__ __forceinline__ float row_rstd16_q(const float* ssqx, int row, int fq) {
    const f32x4 s0 = *(const f32x4*)(ssqx + (size_t)row * 16 + 4 * fq); float s = (s0[0] + s0[1]) + (s0[2] + s0[3]);
    { auto r = __builtin_amdgcn_permlane16_swap(__float_as_uint(s), __float_as_uint(s), false, false); s = __uint_as_float(r[0]) + __uint_as_float(r[1]); }
    { auto r = __builtin_amdgcn_permlane32_swap(__float_as_uint(s), __float_as_uint(s), false, false); s = __uint_as_float(r[0]) + __uint_as_float(r[1]); }
    return rsqrtf(s * (1.0f / 1024.0f) + 1e-6f);
}
__device__ __forceinline__ float row_rstd16(const float* ssqx, int row) {
    const f32x4* sp = (const f32x4*)(ssqx + (size_t)row * 16); const f32x4 s0 = sp[0], s1 = sp[1], s2 = sp[2], s3 = sp[3];
    const float ss = (((s0[0] + s0[1]) + (s0[2] + s0[3])) + ((s1[0] + s1[1]) + (s1[2] + s1[3]))) + (((s2[0] + s2[1]) + (s2[2] + s2[3])) + ((s3[0] + s3[1]) + (s3[2] + s3[3])));
    return rsqrtf(ss * (1.0f / 1024.0f) + 1e-6f);
}
struct EpiZ {
    static constexpr bool PERM = true, AFTER_DRAIN = false;
    bf16_t* Z; float* ssq; const float* ssqx; const float* shw;
    __device__ __forceinline__ void operator()(const f32x4 (&acc)[2][2][4][2], const Unit& u, int wr, int wc, int fr, int fq) const {
        const int row0 = u.pm * BM + wr * 64 + fr, col0 = u.pn * BM + wc * 32 + 8 * fq;
        const int mi = (u.pm * BM >= T_LAT) ? 8 : ((u.pm * BM) >> 13);
        float rs[2][4];
#pragma unroll
        for (int ai = 0; ai < 2; ++ai) {
#pragma unroll
            for (int m = 0; m < 4; ++m) { rs[ai][m] = row_rstd16_q(ssqx, row0 + ai * HALF + m * 16, fq); if (m & 1) asm volatile("" : "+v"(rs[ai][m - 1]), "+v"(rs[ai][m]) :: "memory"); } }
        f32x4 sw[2][2];
#pragma unroll
        for (int bj = 0; bj < 2; ++bj) { sw[bj][0] = *(const f32x4*)(shw + mi * 1792 + col0 + bj * HALF); sw[bj][1] = *(const f32x4*)(shw + mi * 1792 + col0 + bj * HALF + 4); }
#pragma unroll
        for (int ai = 0; ai < 2; ++ai)
#pragma unroll
            for (int m = 0; m < 4; ++m) { const int row = row0 + ai * HALF + m * 16; bf16_t* rowp = Z + (size_t)row * ZP + col0; const float r_ = rs[ai][m];
#pragma unroll
                for (int bj = 0; bj < 2; ++bj) { const f32x4 v0 = acc[ai][bj][m][0] * r_ + sw[bj][0], v1 = acc[ai][bj][m][1] * r_ + sw[bj][1];
                    *(u32x4*)(rowp + bj * HALF) = pack8(v0, v1);
                    const int hh = u.pn * 2 + bj;
                    if (hh < 5) { float s = (v0[0] * v0[0] + v0[1] * v0[1]) + (v0[2] * v0[2] + v0[3] * v0[3]) + (v1[0] * v1[0] + v1[1] * v1[1]) + (v1[2] * v1[2] + v1[3] * v1[3]);
                        s = sum_fq(s);
                        if (fq == 0) ssq[(size_t)row * 20 + hh * 4 + wc] = s; } }
                asm volatile("" ::: "memory"); }
    }
};
struct EpiQ {
    static constexpr bool PERM = true, AFTER_DRAIN = false;
    bf16_t* Q; const float* ssq; const float* rope;
    __device__ __forceinline__ void operator()(const f32x4 (&acc)[2][2][4][2], const Unit& u, int wr, int wc, int fr, int fq) const {
        const int row0 = u.pm * BM + wr * 64 + fr, col0 = u.pn * BM + wc * 32 + 8 * fq;
        float rsq[2][4];
#pragma unroll
        for (int ai = 0; ai < 2; ++ai) {
#pragma unroll
            for (int m = 0; m < 4; ++m) { f32x4 s0 = {0.f, 0.f, 0.f, 0.f}; if (fq < 3) s0 = *(const f32x4*)(ssq + (size_t)(row0 + ai * HALF + m * 16) * 20 + 4 * fq);
                const float ss = sum_fq((s0[0] + s0[1]) + (s0[2] + s0[3]));
                rsq[ai][m] = rsqrtf(ss * (1.0f / 384.0f) + 1e-6f) * 0.14724444653041276f;
                if (m & 1) asm volatile("" : "+v"(rsq[ai][m - 1]), "+v"(rsq[ai][m]) :: "memory"); } }
#pragma unroll
        for (int ai = 0; ai < 2; ++ai)
#pragma unroll
            for (int m = 0; m < 4; ++m) { const int row = row0 + ai * HALF + m * 16;
                const float rstd = rsq[ai][m];
                const bool lat = row < T_LAT; const int t = row & 8191;
#pragma unroll
                for (int bj = 0; bj < 2; ++bj) { const int c = col0 + bj * HALF; const int d = c % 96;
                    f32x4 v0 = acc[ai][bj][m][0] * rstd, v1 = acc[ai][bj][m][1] * rstd;
                    if (lat && d >= 64) { const int p0 = d - 64, g = p0 >> 4, j0 = (p0 & 15) >> 1; const int pos = g ? (t & 63) : (t >> 6);
                        const f32x4* tb = (const f32x4*)(rope + (pos * 8 + j0) * 2); const f32x4 c0 = tb[0], c1 = tb[1];
                        f32x4 r0, r1;
                        r0[0] = v0[0] * c0[0] - v0[1] * c0[1]; r0[1] = v0[1] * c0[0] + v0[0] * c0[1];
                        r0[2] = v0[2] * c0[2] - v0[3] * c0[3]; r0[3] = v0[3] * c0[2] + v0[2] * c0[3];
                        r1[0] = v1[0] * c1[0] - v1[1] * c1[1]; r1[1] = v1[1] * c1[0] + v1[0] * c1[1];
                        r1[2] = v1[2] * c1[2] - v1[3] * c1[3]; r1[3] = v1[3] * c1[2] + v1[2] * c1[3];
                        v0 = r0; v1 = r1; }
                    *(u32x4*)(Q + (size_t)row * 768 + c) = pack8(v0, v1); }
                asm volatile("" ::: "memory"); }
    }
};
struct EpiKV {
    static constexpr bool PERM = true, AFTER_DRAIN = false;
    bf16_t* KN; bf16_t* V; const float* ssq;
    __device__ __forceinline__ void operator()(const f32x4 (&acc)[2][2][4][2], const Unit& u, int wr, int wc, int fr, int fq) const {
        const int row0 = u.pm * BM + wr * 64 + fr; const int d = (wc & 1) * 32 + 8 * fq; bf16_t* dst = (wc < 2) ? KN : V;
        float rsq[2][4];
#pragma unroll
        for (int ai = 0; ai < 2; ++ai)
#pragma unroll
            for (int m = 0; m < 4; ++m) { f32x4 s0 = {0.f, 0.f, 0.f, 0.f}; if (fq < 2) s0 = *(const f32x4*)(ssq + (size_t)(row0 + ai * HALF + m * 16) * 20 + 12 + 4 * fq);
                const float ss = sum_fq((s0[0] + s0[1]) + (s0[2] + s0[3]));
                rsq[ai][m] = rsqrtf(ss * (1.0f / 256.0f) + 1e-6f); if (m == 3) asm volatile("" : "+v"(rsq[ai][0]), "+v"(rsq[ai][1]), "+v"(rsq[ai][2]), "+v"(rsq[ai][3]) :: "memory"); }
#pragma unroll
        for (int ai = 0; ai < 2; ++ai)
#pragma unroll
            for (int m = 0; m < 4; ++m) { const int row = row0 + ai * HALF + m * 16;
                const float rstd = rsq[ai][m];
                int b, kpos; if (row < T_LAT) { b = row >> 13; kpos = 256 + (row & 8191); } else { const int rc = row - T_LAT; b = rc >> 8; kpos = rc & 255; }
#pragma unroll
                for (int bj = 0; bj < 2; ++bj) { const int head = u.pn * 2 + bj;
                    const f32x4 v0 = acc[ai][bj][m][0] * rstd, v1 = acc[ai][bj][m][1] * rstd;
                    *(u32x4*)(dst + ((size_t)(b * 8 + head) * LK + kpos) * 64 + d) = pack8(v0, v1); }
                asm volatile("" ::: "memory"); }
    }
};
struct EpiRes {
    static constexpr bool PERM = true, AFTER_DRAIN = false;
    bf16_t* XB; const float* gate;
    bf16_t* XS; float* ssqx; const float* stab;
    __device__ __forceinline__ void operator()(const f32x4 (&acc)[2][2][4][2], const Unit& u, int wr, int wc, int fr, int fq) const {
        const int trow = u.pm * BM; const int mi = (trow >= T_LAT) ? 8 : (trow >> 13);
        const int row0 = trow + wr * 64 + fr, col0 = u.pn * BM + wc * 32 + 8 * fq;
        f32x4 gv[2][2];
#pragma unroll
        for (int bj = 0; bj < 2; ++bj) { gv[bj][0] = *(const f32x4*)(gate + mi * 6144 + col0 + bj * HALF); gv[bj][1] = *(const f32x4*)(gate + mi * 6144 + col0 + bj * HALF + 4); }
        f32x4 tv[2][2] = {};
        if (stab) {
#pragma unroll
            for (int bj = 0; bj < 2; ++bj) { tv[bj][0] = *(const f32x4*)(stab + mi * 1024 + col0 + bj * HALF); tv[bj][1] = *(const f32x4*)(stab + mi * 1024 + col0 + bj * HALF + 4); } }
#pragma unroll
        for (int ai = 0; ai < 2; ++ai) {
            u32x4 xv[4][2];
#pragma unroll
            for (int m = 0; m < 4; ++m) { const size_t off = (size_t)(row0 + ai * HALF + m * 16) * 1024 + col0;
#pragma unroll
                for (int bj = 0; bj < 2; ++bj) xv[m][bj] = *(const u32x4*)(XB + off + bj * HALF); }
#pragma unroll
            for (int m = 0; m < 4; ++m) { const size_t off = (size_t)(row0 + ai * HALF + m * 16) * 1024 + col0;
                float sq = 0.f;
#pragma unroll
                for (int bj = 0; bj < 2; ++bj) { const u32x4 xr = xv[m][bj];
                    const f32x4 x0 = {__uint_as_float(xr[0] << 16), __uint_as_float(xr[0] & 0xffff0000u), __uint_as_float(xr[1] << 16), __uint_as_float(xr[1] & 0xffff0000u)};
                    const f32x4 x1 = {__uint_as_float(xr[2] << 16), __uint_as_float(xr[2] & 0xffff0000u), __uint_as_float(xr[3] << 16), __uint_as_float(xr[3] & 0xffff0000u)};
                    const f32x4 y0 = x0 + gv[bj][0] * acc[ai][bj][m][0], y1 = x1 + gv[bj][1] * acc[ai][bj][m][1];
                    *(u32x4*)(XB + off + bj * HALF) = pack8(y0, y1);
                    if (stab) { *(u32x4*)(XS + off + bj * HALF) = pack8(y0 * tv[bj][0], y1 * tv[bj][1]);
                        sq += ((y0[0] * y0[0] + y0[1] * y0[1]) + (y0[2] * y0[2] + y0[3] * y0[3])) + ((y1[0] * y1[0] + y1[1] * y1[1]) + (y1[2] * y1[2] + y1[3] * y1[3])); } }
                if (stab) { sq = sum_fq(sq); if (fq == 0) ssqx[(size_t)(row0 + ai * HALF + m * 16) * 16 + u.pn * 4 + wc] = sq; } }
            asm volatile("" ::: "memory"); }
    }
};
struct EpiPart {
    static constexpr bool PERM = true, AFTER_DRAIN = false;
    float* P;
    __device__ __forceinline__ void operator()(const f32x4 (&acc)[2][2][4][2], const Unit& u, int wr, int wc, int fr, int fq) const {
        const int row0 = u.pm * BM + wr * 64 + fr, col0 = u.pn * BM + wc * 32 + 8 * fq;
#pragma unroll
        for (int ai = 0; ai < 2; ++ai)
#pragma unroll
            for (int m = 0; m < 4; ++m) { float* rowp = P + (size_t)(row0 + ai * HALF + m * 16) * 1024 + col0;
#pragma unroll
                for (int bj = 0; bj < 2; ++bj) { *(f32x4*)(rowp + bj * HALF) = acc[ai][bj][m][0]; *(f32x4*)(rowp + bj * HALF + 4) = acc[ai][bj][m][1]; }
                asm volatile("" ::: "memory"); }
    }
};
struct EpiFF1 {
    static constexpr bool PERM = true, AFTER_DRAIN = false;
    bf16_t* H; const float* ssqx; const float* shw; int row_base;
    __device__ __forceinline__ void operator()(const f32x4 (&acc)[2][2][4][2], const Unit& u, int wr, int wc, int fr, int fq) const {
        const int row0 = row_base + u.pm * BM + wr * 64 + fr, col0 = u.pn * BM + wc * 32 + 8 * fq;
        const int mi = (row_base + u.pm * BM >= T_LAT) ? 8 : ((row_base + u.pm * BM) >> 13);
        f32x4 sw[2][2];
#pragma unroll
        for (int bj = 0; bj < 2; ++bj) { sw[bj][0] = *(const f32x4*)(shw + mi * 4096 + col0 + bj * HALF); sw[bj][1] = *(const f32x4*)(shw + mi * 4096 + col0 + bj * HALF + 4); }
        float rsv[2][4];
#pragma unroll
        for (int ai = 0; ai < 2; ++ai) {
#pragma unroll
            for (int m = 0; m < 4; ++m) { rsv[ai][m] = row_rstd16_q(ssqx, row0 + ai * HALF + m * 16, fq); if (m & 1) asm volatile("" : "+v"(rsv[ai][m - 1]), "+v"(rsv[ai][m]) :: "memory"); } }
#pragma unroll
        for (int ai = 0; ai < 2; ++ai)
#pragma unroll
            for (int m = 0; m < 4; ++m) { const int row = row0 + ai * HALF + m * 16; bf16_t* rowp = H + (size_t)row * 4096 + col0; const float rs = rsv[ai][m];
#pragma unroll
                for (int bj = 0; bj < 2; ++bj) { f32x4 v0 = acc[ai][bj][m][0] * rs + sw[bj][0], v1 = acc[ai][bj][m][1] * rs + sw[bj][1];
#pragma unroll
                    for (int e = 0; e < 4; ++e) { const float a = fmaxf(v0[e], 0.f), b = fmaxf(v1[e], 0.f); v0[e] = a * a; v1[e] = b * b; }
                    *(u32x4*)(rowp + bj * HALF) = pack8(v0, v1); }
                asm volatile("" ::: "memory"); }
    }
};
template <class Epi, class Sched, bool ALIGN_EPI, bool SP2, int KC, int LDAC, int LDBC = KC>
__device__ __forceinline__ void gemm_phase(PG8_LAS unsigned char* lds, const Gemm g, const Sched& S, const Epi& E, int tid_in) {
    int tid_l = tid_in; asm volatile("" : "+v"(tid_l));
    const int tid = tid_l, wid = __builtin_amdgcn_readfirstlane(tid >> 6), lane = tid & 63, wr = wid >> 2, wc = wid & 3, fr = lane & 15, fq = lane >> 4;
    constexpr int K = KC, nt = KC / BK;
    unsigned voffA[2], voffB[2];
#pragma unroll
    for (int i = 0; i < 2; ++i) { int R, C; stage_rc(tid * 16 + i * 8192, R, C); const int Rb = Epi::PERM ? ((R & ~31) + perm32(R & 31)) : R;
        voffA[i] = (unsigned)(R * LDAC + C) * 2u; voffB[i] = (unsigned)(Rb * LDBC + C) * 2u; }
    constexpr size_t kstep = (size_t)(BK * 2);
    constexpr size_t hstepA = (size_t)HALF * LDAC * 2, hstepB = (size_t)HALF * LDBC * 2;
    constexpr size_t tstepA = 2 * hstepA, tstepB = 2 * hstepB;
    const unsigned ldsw = (unsigned)wid * 1024u;
    const int aoff = lds_byte(wr * 64 + fr, fq * 8), boff = lds_byte(wc * 32 + fr, fq * 8);
#define PG8_SA(b, h) (((b) * 2 + (h)) * HTB)
#define PG8_SB(b, h) ((4 + (b) * 2 + (h)) * HTB)
#define PG8_STAGE(bufoff, gbase, voff) do { _Pragma("unroll") for (int _i = 0; _i < 2; ++_i) \
        __builtin_amdgcn_global_load_lds((const unsigned*)((const char*)(gbase) + (voff)[_i]), (PG8_LAS unsigned*)(lds + (bufoff) + ldsw + _i * 8192), 16, 0, 0); } while (0)
#define PG8_LDA(dst, b, h) do { _Pragma("unroll") for (int m = 0; m < 4; ++m) _Pragma("unroll") for (int k = 0; k < 2; ++k) dst[m][k] = *(const PG8_LAS bf16x8*)(lds + PG8_SA(b, h) + aoff + m * 2048 + k * 1024); } while (0)
#define PG8_LDB(dst, b, h) do { _Pragma("unroll") for (int n = 0; n < 2; ++n) _Pragma("unroll") for (int k = 0; k < 2; ++k) dst[n][k] = *(const PG8_LAS bf16x8*)(lds + PG8_SB(b, h) + boff + n * 2048 + k * 1024); } while (0)
#define PG8_MMA(ai, bj, At, Bt) do { __builtin_amdgcn_s_setprio(1); _Pragma("unroll") for (int m = 0; m < 4; ++m) _Pragma("unroll") for (int n = 0; n < 2; ++n) _Pragma("unroll") for (int k = 0; k < 2; ++k) \
        acc[ai][bj][m][n] = __builtin_amdgcn_mfma_f32_16x16x32_bf16(Bt[n][k], At[m][k], acc[ai][bj][m][n], 0, 0, 0); __builtin_amdgcn_s_setprio(0); } while (0)
#define PG8_WAIT_V(n) asm volatile("s_waitcnt vmcnt(" #n ")" ::: "memory")
#define PG8_WAIT_L(n) asm volatile("s_waitcnt lgkmcnt(" #n ")" ::: "memory")
#define PG8_BAR __builtin_amdgcn_s_barrier()
#define PG8_SCHED __builtin_amdgcn_sched_barrier(0)
    Unit cur, nxt; int ui = 0;
    if (!S.next(0, cur)) return;
    f32x4 acc[2][2][4][2];
#pragma unroll
    for (int a = 0; a < 2; ++a)
#pragma unroll
        for (int b = 0; b < 2; ++b)
#pragma unroll
            for (int m = 0; m < 4; ++m)
#pragma unroll
                for (int n = 0; n < 2; ++n) acc[a][b][m][n] = (f32x4){0.f, 0.f, 0.f, 0.f};
    bf16x8 At[4][2], B0[2][2], B1[2][2];
    const char* cA = (const char*)g.A + (size_t)cur.pm * tstepA; const char* cB = (const char*)g.Bt + (size_t)cur.pn * tstepB;
    S.a_ready(cur);
    if constexpr (SP2) {
        PG8_STAGE(PG8_SB(0, 0), cB, voffB); PG8_STAGE(PG8_SB(0, 1), cB + hstepB, voffB); PG8_STAGE(PG8_SA(0, 0), cA, voffA); PG8_STAGE(PG8_SA(0, 1), cA + hstepA, voffA);
        if (wr == 1) PG8_BAR;
        PG8_WAIT_V(2); PG8_BAR;
        PG8_STAGE(PG8_SB(1, 0), cB + kstep, voffB); PG8_STAGE(PG8_SA(1, 0), cA + kstep, voffA); PG8_STAGE(PG8_SB(1, 1), cB + hstepB + kstep, voffB);
        PG8_WAIT_V(6); PG8_BAR;
    } else {
        PG8_STAGE(PG8_SB(0, 0), cB, voffB); PG8_STAGE(PG8_SA(0, 0), cA, voffA); PG8_STAGE(PG8_SB(0, 1), cB + hstepB, voffB); PG8_STAGE(PG8_SA(0, 1), cA + hstepA, voffA);
        if (wr == 1) PG8_BAR;
        PG8_WAIT_V(4); PG8_BAR;
        PG8_STAGE(PG8_SB(1, 0), cB + kstep, voffB); PG8_STAGE(PG8_SA(1, 0), cA + kstep, voffA); PG8_STAGE(PG8_SB(1, 1), cB + hstepB + kstep, voffB);
        PG8_WAIT_V(6); PG8_BAR;
    }
    for (;;) {
        const bool has_next = S.next(ui + 1, nxt);
        const char* nA = has_next ? (const char*)g.A + (size_t)nxt.pm * tstepA : cA; const char* nB = has_next ? (const char*)g.Bt + (size_t)nxt.pn * tstepB : cB;
        for (int t = 0; t < nt; t += 2) {
            const bool last = (t == nt - 2);
            const char* a1 = cA + (size_t)(t + 1) * kstep;
            const char* a2 = last ? nA : cA + (size_t)(t + 2) * kstep; const char* b2 = last ? nB : cB + (size_t)(t + 2) * kstep;
            const char* a3 = a2 + kstep; const char* b3 = b2 + kstep;
            if (last && has_next) S.a_ready(nxt);
            if constexpr (SP2) {
            PG8_LDB(B0, 0, 0); PG8_LDB(B1, 0, 1); PG8_SCHED; PG8_LDA(At, 0, 0); PG8_STAGE(PG8_SA(1, 1), a1 + hstepA, voffA);
            PG8_WAIT_V(8); PG8_WAIT_L(0); PG8_BAR; PG8_MMA(0, 0, At, B0); PG8_MMA(0, 1, At, B1); PG8_BAR; PG8_SCHED;
            PG8_LDA(At, 0, 1); PG8_STAGE(PG8_SB(0, 0), b2, voffB); PG8_STAGE(PG8_SB(0, 1), b2 + hstepB, voffB); PG8_STAGE(PG8_SA(0, 0), a2, voffA);
            PG8_WAIT_V(8); PG8_WAIT_L(0); PG8_BAR; PG8_MMA(1, 0, At, B0); PG8_MMA(1, 1, At, B1); PG8_BAR; PG8_SCHED;
            PG8_LDB(B0, 1, 0); PG8_LDB(B1, 1, 1); PG8_SCHED; PG8_LDA(At, 1, 0); PG8_STAGE(PG8_SA(0, 1), a2 + hstepA, voffA);
            PG8_WAIT_V(8); PG8_WAIT_L(0); PG8_BAR; PG8_MMA(0, 0, At, B0); PG8_MMA(0, 1, At, B1); PG8_BAR; PG8_SCHED;
            PG8_LDA(At, 1, 1); PG8_STAGE(PG8_SB(1, 0), b3, voffB); PG8_STAGE(PG8_SB(1, 1), b3 + hstepB, voffB); PG8_STAGE(PG8_SA(1, 0), a3, voffA);
            PG8_WAIT_V(8); PG8_WAIT_L(0); PG8_BAR; PG8_MMA(1, 0, At, B0); PG8_MMA(1, 1, At, B1); PG8_BAR; PG8_SCHED;
            } else {
            PG8_LDB(B0, 0, 0); PG8_SCHED; PG8_LDA(At, 0, 0); PG8_STAGE(PG8_SA(1, 1), a1 + hstepA, voffA);
            PG8_WAIT_L(8); PG8_BAR; PG8_WAIT_L(0); PG8_MMA(0, 0, At, B0); PG8_BAR; PG8_SCHED;
            PG8_LDB(B1, 0, 1); PG8_STAGE(PG8_SB(0, 0), b2, voffB);
            PG8_BAR; PG8_WAIT_L(0); PG8_MMA(0, 1, At, B1); PG8_BAR;
            PG8_LDA(At, 0, 1); PG8_STAGE(PG8_SA(0, 0), a2, voffA);
            PG8_BAR; PG8_WAIT_L(0); PG8_MMA(1, 0, At, B0); PG8_BAR; PG8_SCHED;
            PG8_STAGE(PG8_SB(0, 1), b2 + hstepB, voffB);
            PG8_WAIT_V(6); PG8_BAR; PG8_MMA(1, 1, At, B1); PG8_BAR;
            PG8_LDB(B0, 1, 0); PG8_SCHED; PG8_LDA(At, 1, 0); PG8_STAGE(PG8_SA(0, 1), a2 + hstepA, voffA);
            PG8_WAIT_L(8); PG8_BAR; PG8_WAIT_L(0); PG8_MMA(0, 0, At, B0); PG8_BAR; PG8_SCHED;
            PG8_LDB(B1, 1, 1); PG8_STAGE(PG8_SB(1, 0), b3, voffB);
            PG8_BAR; PG8_WAIT_L(0); PG8_MMA(0, 1, At, B1); PG8_BAR;
            PG8_LDA(At, 1, 1); PG8_STAGE(PG8_SA(1, 0), a3, voffA);
            PG8_BAR; PG8_WAIT_L(0); PG8_MMA(1, 0, At, B0); PG8_BAR; PG8_SCHED;
            PG8_STAGE(PG8_SB(1, 1), b3 + hstepB, voffB);
            PG8_WAIT_V(6); PG8_BAR; PG8_MMA(1, 1, At, B1); PG8_BAR;
            }
        }
        if constexpr (ALIGN_EPI) { if (wr == 0) PG8_BAR; }
        if constexpr (!Epi::AFTER_DRAIN) { Unit ue = cur; int ln_; asm volatile("v_mbcnt_lo_u32_b32 %0, -1, 0\n\tv_mbcnt_hi_u32_b32 %0, -1, %0" : "=&v"(ln_), "+s"(ue.pm), "+s"(ue.pn)); E(acc, ue, wr, wc, ln_ & 15, ln_ >> 4); S.done(cur); }
        if (!has_next) break;
#pragma unroll
        for (int a = 0; a < 2; ++a)
#pragma unroll
            for (int b = 0; b < 2; ++b)
#pragma unroll
                for (int m = 0; m < 4; ++m)
#pragma unroll
                    for (int n = 0; n < 2; ++n) acc[a][b][m][n] = (f32x4){0.f, 0.f, 0.f, 0.f};
        cur = nxt; cA = nA; cB = nB; ++ui;
        if constexpr (ALIGN_EPI) { if (wr == 1) PG8_BAR; }
    }
    PG8_WAIT_V(0);
    if constexpr (!ALIGN_EPI) { if (wr == 0) PG8_BAR; }
    PG8_BAR;
    if constexpr (Epi::AFTER_DRAIN) { E.fused(acc, cur, wr, wc, fr, fq, lds, wid, lane); S.done(cur); }
#undef PG8_SA
#undef PG8_SB
#undef PG8_STAGE
#undef PG8_LDA
#undef PG8_LDB
#undef PG8_MMA
#undef PG8_WAIT_V
#undef PG8_WAIT_L
#undef PG8_BAR
#undef PG8_SCHED
}
}
namespace att {
using bf16x8 = __attribute__((ext_vector_type(8))) short;
using s16x4  = __attribute__((ext_vector_type(4))) short;
using f32x16 = __attribute__((ext_vector_type(16))) float;
using u32x4  = __attribute__((ext_vector_type(4))) unsigned;
constexpr int NW = 8, QBLK = 32, KVBLK = 64;
constexpr float SCALE = 0.10206207261596575f;
constexpr float THR2 = 11.0f;
constexpr int SHM_V = KVBLK * 64 * 2, SHM_K = KVBLK * 208, SHM_ATTN = 3 * SHM_V + 2 * SHM_K + NW * 64 * 4;
#define KSWZ(row, colB) ((row) * 208 + (colB))
#define SBAR() __builtin_amdgcn_sched_barrier(0)
__device__ __forceinline__ int crow(int r, int hi) { return (r & 3) + 8 * (r >> 2) + 4 * hi; }
__device__ __forceinline__ unsigned cvtpk(float lo, float hi) { unsigned r; asm volatile("v_cvt_pk_bf16_f32 %0, %1, %2" : "=v"(r) : "v"(lo), "v"(hi)); return r; }
#define MX3(a, b, c) __builtin_fmaxf(__builtin_fmaxf((a), (b)), (c))
template <bool FIRST>
__device__ __forceinline__ void partialSM(f32x16& p0, f32x16& p1, float& m_reg, f32x16& negm, float& alpha) {
  float a = MX3(p0[0], p0[1], p1[0]), b = MX3(p0[2], p0[3], p1[1]); a = MX3(a, p1[2], p1[3]);
#pragma unroll
  for (int r = 4; r < 16; r += 4) { a = MX3(a, p0[r], p0[r + 1]); b = MX3(b, p0[r + 2], p0[r + 3]); a = MX3(a, p1[r], p1[r + 1]); b = MX3(b, p1[r + 2], p1[r + 3]); }
  float pmax = __builtin_fmaxf(a, b);
  { auto rr = __builtin_amdgcn_permlane32_swap(__float_as_uint(pmax), __float_as_uint(pmax), false, false);
    pmax = __builtin_fmaxf(__uint_as_float(rr[0]), __uint_as_float(rr[1])); }
  alpha = 1.f;
  if (FIRST || __builtin_expect(__any(pmax > THR2), 0)) {
    const float dl = FIRST ? pmax : __builtin_fmaxf(pmax, 0.f); m_reg += dl;
#pragma unroll
    for (int r = 0; r < 16; ++r) { p0[r] -= dl; p1[r] -= dl; }
#pragma unroll
    for (int r = 0; r < 16; ++r) negm[r] = -m_reg;
    if (!FIRST) alpha = __builtin_amdgcn_exp2f(-dl);
  }
#pragma unroll
  for (int r = 0; r < 16; ++r) p0[r] = __builtin_amdgcn_exp2f(p0[r]);
}
__device__ __forceinline__ void finishSM(f32x16& p0, f32x16& p1, float& l_reg, bf16x8& pa0, bf16x8& pa1, bf16x8& pa2, bf16x8& pa3) {
#pragma unroll
  for (int r = 0; r < 16; ++r) { p0[r] = __builtin_amdgcn_exp2f(p0[r]); p1[r] = __builtin_amdgcn_exp2f(p1[r]); }
#pragma unroll
  for (int r = 0; r < 16; ++r) l_reg += p0[r] + p1[r];
#define PK4(P, BASE, OUT) do { u32x4 w = {cvtpk(P[BASE + 0], P[BASE + 1]), cvtpk(P[BASE + 2], P[BASE + 3]), cvtpk(P[BASE + 4], P[BASE + 5]), cvtpk(P[BASE + 6], P[BASE + 7])}; OUT = *reinterpret_cast<bf16x8*>(&w); } while (0)
  PK4(p0, 0, pa0); PK4(p0, 8, pa1); PK4(p1, 0, pa2); PK4(p1, 8, pa3);
#undef PK4
}
__device__ __forceinline__ void qkt(f32x16& p0, f32x16& p1, const char* Ks, const bf16x8* qr, const f32x16& negm, int r32, int hi) {
#pragma unroll
  for (int d0 = 0; d0 < 6; ++d0) { int cb = (d0 * 16 + hi * 8) * 2;
    bf16x8 b0 = *reinterpret_cast<const bf16x8*>(Ks + KSWZ(r32, cb));
    bf16x8 b1 = *reinterpret_cast<const bf16x8*>(Ks + KSWZ(32 + r32, cb));
    if (d0 == 0) { p0 = __builtin_amdgcn_mfma_f32_32x32x16_bf16(b0, qr[0], negm, 0, 0, 0); p1 = __builtin_amdgcn_mfma_f32_32x32x16_bf16(b1, qr[0], negm, 0, 0, 0); }
    else { p0 = __builtin_amdgcn_mfma_f32_32x32x16_bf16(b0, qr[d0], p0, 0, 0, 0); p1 = __builtin_amdgcn_mfma_f32_32x32x16_bf16(b1, qr[d0], p1, 0, 0, 0); } }
}
__device__ __forceinline__ int v_st(int k, int c) { const int kk = (k & ~0xC) | ((k & 4) << 1) | ((k & 8) >> 1); return ((kk >> 3) * 2 + (c >> 5)) * 512 + ((kk & 7) * 32 + (c & 31)) * 2; }
__device__ __forceinline__ int v_st_nat(int k, int c) { return ((k >> 3) * 2 + (c >> 5)) * 512 + ((k & 7) * 32 + (c & 31)) * 2; }
__device__ __forceinline__ int v_rd_base(int lane) { return ((lane & 3) << 3) | (((lane >> 2) & 3) << 6) | (((lane >> 4) & 1) << 5) | (((lane >> 5) & 1) << 8); }
constexpr int v_rd_off(int d0, int ks, int half) { return d0 * 512 + ks * 2048 + half * 1024; }
template <int OFF> __device__ __forceinline__ s16x4 tr_read(int vb) {
  s16x4 r; asm volatile("ds_read_b64_tr_b16 %0, %1 offset:%2" : "=&v"(r) : "v"(vb), "i"(OFF) : "memory"); return r;
}
template <int D0> __device__ __forceinline__ void pv_one(f32x16& od, int vb, bf16x8 pa0, bf16x8 pa1, bf16x8 pa2, bf16x8 pa3) {
  const s16x4 l0 = tr_read<v_rd_off(D0, 0, 0)>(vb), h0 = tr_read<v_rd_off(D0, 0, 1)>(vb), l1 = tr_read<v_rd_off(D0, 1, 0)>(vb), h1 = tr_read<v_rd_off(D0, 1, 1)>(vb);
  const s16x4 l2 = tr_read<v_rd_off(D0, 2, 0)>(vb), h2 = tr_read<v_rd_off(D0, 2, 1)>(vb), l3 = tr_read<v_rd_off(D0, 3, 0)>(vb), h3 = tr_read<v_rd_off(D0, 3, 1)>(vb);
  asm volatile("s_waitcnt lgkmcnt(0)" ::: "memory"); SBAR();
#define PK(L, H) (bf16x8){L[0], L[1], L[2], L[3], H[0], H[1], H[2], H[3]}
  od = __builtin_amdgcn_mfma_f32_32x32x16_bf16(pa0, PK(l0, h0), od, 0, 0, 0);
  od = __builtin_amdgcn_mfma_f32_32x32x16_bf16(pa1, PK(l1, h1), od, 0, 0, 0);
  od = __builtin_amdgcn_mfma_f32_32x32x16_bf16(pa2, PK(l2, h2), od, 0, 0, 0);
  od = __builtin_amdgcn_mfma_f32_32x32x16_bf16(pa3, PK(l3, h3), od, 0, 0, 0);
}
__device__ __forceinline__ void pv_d0(f32x16* o, int vb, bf16x8 ones, bf16x8 pa0, bf16x8 pa1, bf16x8 pa2, bf16x8 pa3) {
  s16x4 a0 = tr_read<v_rd_off(0, 0, 0)>(vb), b0 = tr_read<v_rd_off(0, 0, 1)>(vb), c0 = tr_read<v_rd_off(1, 0, 0)>(vb), d0 = tr_read<v_rd_off(1, 0, 1)>(vb);
  s16x4 a1 = tr_read<v_rd_off(0, 1, 0)>(vb), b1 = tr_read<v_rd_off(0, 1, 1)>(vb), c1 = tr_read<v_rd_off(1, 1, 0)>(vb), d1 = tr_read<v_rd_off(1, 1, 1)>(vb);
  s16x4 a2 = tr_read<v_rd_off(0, 2, 0)>(vb), b2 = tr_read<v_rd_off(0, 2, 1)>(vb), c2 = tr_read<v_rd_off(1, 2, 0)>(vb), d2 = tr_read<v_rd_off(1, 2, 1)>(vb);
  s16x4 a3 = tr_read<v_rd_off(0, 3, 0)>(vb), b3 = tr_read<v_rd_off(0, 3, 1)>(vb), c3 = tr_read<v_rd_off(1, 3, 0)>(vb), d3 = tr_read<v_rd_off(1, 3, 1)>(vb);
  asm volatile("s_waitcnt lgkmcnt(0)" : "+v"(a0), "+v"(b0), "+v"(c0), "+v"(d0), "+v"(a1), "+v"(b1), "+v"(c1), "+v"(d1), "+v"(a2), "+v"(b2), "+v"(c2), "+v"(d2), "+v"(a3), "+v"(b3), "+v"(c3), "+v"(d3) :: "memory");
  o[2] = __builtin_amdgcn_mfma_f32_32x32x16_bf16(pa0, ones, o[2], 0, 0, 0); o[0] = __builtin_amdgcn_mfma_f32_32x32x16_bf16(pa0, PK(a0, b0), o[0], 0, 0, 0); o[1] = __builtin_amdgcn_mfma_f32_32x32x16_bf16(pa0, PK(c0, d0), o[1], 0, 0, 0);
  o[2] = __builtin_amdgcn_mfma_f32_32x32x16_bf16(pa1, ones, o[2], 0, 0, 0); o[0] = __builtin_amdgcn_mfma_f32_32x32x16_bf16(pa1, PK(a1, b1), o[0], 0, 0, 0); o[1] = __builtin_amdgcn_mfma_f32_32x32x16_bf16(pa1, PK(c1, d1), o[1], 0, 0, 0);
  o[2] = __builtin_amdgcn_mfma_f32_32x32x16_bf16(pa2, ones, o[2], 0, 0, 0); o[0] = __builtin_amdgcn_mfma_f32_32x32x16_bf16(pa2, PK(a2, b2), o[0], 0, 0, 0); o[1] = __builtin_amdgcn_mfma_f32_32x32x16_bf16(pa2, PK(c2, d2), o[1], 0, 0, 0);
  o[2] = __builtin_amdgcn_mfma_f32_32x32x16_bf16(pa3, ones, o[2], 0, 0, 0); o[0] = __builtin_amdgcn_mfma_f32_32x32x16_bf16(pa3, PK(a3, b3), o[0], 0, 0, 0); o[1] = __builtin_amdgcn_mfma_f32_32x32x16_bf16(pa3, PK(c3, d3), o[1], 0, 0, 0);
#undef PK
}
template <int OFF> __device__ __forceinline__ bf16x8 rd128(int addr) { bf16x8 r; asm volatile("ds_read_b128 %0, %1 offset:%2" : "=v"(r) : "v"(addr), "i"(OFF) : "memory"); return r; }
#define WAIT4(a, b, c, d) asm volatile("s_waitcnt lgkmcnt(0)" : "+v"(a), "+v"(b), "+v"(c), "+v"(d) :: "memory")
#define EXP4(P, B) do { P[B] = __builtin_amdgcn_exp2f(P[B]); P[B + 1] = __builtin_amdgcn_exp2f(P[B + 1]); P[B + 2] = __builtin_amdgcn_exp2f(P[B + 2]); P[B + 3] = __builtin_amdgcn_exp2f(P[B + 3]); } while (0)
struct VFr { s16x4 a0, b0, c0, d0, a1, b1, c1, d1; };
template <int KS0> __device__ __forceinline__ void vfr_issue(VFr& f, int vb) {
  f.a0 = tr_read<v_rd_off(0, KS0, 0)>(vb); f.b0 = tr_read<v_rd_off(0, KS0, 1)>(vb); f.c0 = tr_read<v_rd_off(1, KS0, 0)>(vb); f.d0 = tr_read<v_rd_off(1, KS0, 1)>(vb);
  f.a1 = tr_read<v_rd_off(0, KS0 + 1, 0)>(vb); f.b1 = tr_read<v_rd_off(0, KS0 + 1, 1)>(vb); f.c1 = tr_read<v_rd_off(1, KS0 + 1, 0)>(vb); f.d1 = tr_read<v_rd_off(1, KS0 + 1, 1)>(vb);
}
#define MF(A, B, C) __builtin_amdgcn_mfma_f32_32x32x16_bf16(A, B, C, 0, 0, 0)
#define KOFF(KB, hb, d0) ((KB) * SHM_K + (hb) * 32 * 208 + (d0) * 32)
#define SUM4(P, B) do { ls += (P[B] + P[B + 1]) + (P[B + 2] + P[B + 3]); } while (0)
#define PACK8(P, B, OUT) do { u32x4 w_ = {cvtpk(P[B + 0], P[B + 1]), cvtpk(P[B + 2], P[B + 3]), cvtpk(P[B + 4], P[B + 5]), cvtpk(P[B + 6], P[B + 7])}; OUT = *reinterpret_cast<bf16x8*>(&w_); } while (0)
template <int KB, bool HASY>
__device__ __forceinline__ void phaseA(f32x16& X0, f32x16& X1, f32x16& Y0, f32x16& Y1, bf16x8& pa0, bf16x8& pa1, bf16x8& pa2, bf16x8& pa3,
                                       const bf16x8* qr, const f32x16& negm, int kaddr, VFr& vf, int vb, float& l_reg) {
  SBAR();
  float ls = 0.f;
  bf16x8 k0 = rd128<KOFF(KB, 0, 0)>(kaddr), k1 = rd128<KOFF(KB, 1, 0)>(kaddr), k2 = rd128<KOFF(KB, 0, 1)>(kaddr), k3 = rd128<KOFF(KB, 1, 1)>(kaddr);
  if (HASY) { EXP4(Y0, 0); EXP4(Y0, 4); }
  SBAR(); WAIT4(k0, k1, k2, k3);
  bf16x8 k4 = rd128<KOFF(KB, 0, 2)>(kaddr), k5 = rd128<KOFF(KB, 1, 2)>(kaddr), k6 = rd128<KOFF(KB, 0, 3)>(kaddr), k7 = rd128<KOFF(KB, 1, 3)>(kaddr);
  SBAR();
  X0 = MF(k0, qr[0], negm); if (HASY) { EXP4(Y0, 8); SUM4(Y0, 0); } SBAR();
  X1 = MF(k1, qr[0], negm); if (HASY) { EXP4(Y0, 12); SUM4(Y0, 4); } SBAR();
  X0 = MF(k2, qr[1], X0); if (HASY) { PACK8(Y0, 0, pa0); } SBAR();
  X1 = MF(k3, qr[1], X1); if (HASY) { EXP4(Y1, 0); SUM4(Y0, 8); } SBAR();
  WAIT4(k4, k5, k6, k7);
  bf16x8 k8 = rd128<KOFF(KB, 0, 4)>(kaddr), k9 = rd128<KOFF(KB, 1, 4)>(kaddr), k10 = rd128<KOFF(KB, 0, 5)>(kaddr), k11 = rd128<KOFF(KB, 1, 5)>(kaddr);
  SBAR();
  X0 = MF(k4, qr[2], X0); if (HASY) { EXP4(Y1, 4); SUM4(Y0, 12); } SBAR();
  X1 = MF(k5, qr[2], X1); if (HASY) { PACK8(Y0, 8, pa1); } SBAR();
  X0 = MF(k6, qr[3], X0); if (HASY) { EXP4(Y1, 8); SUM4(Y1, 0); } SBAR();
  X1 = MF(k7, qr[3], X1); if (HASY) { EXP4(Y1, 12); SUM4(Y1, 4); } SBAR();
  WAIT4(k8, k9, k10, k11);
  SBAR();
  X0 = MF(k8, qr[4], X0); if (HASY) { PACK8(Y1, 0, pa2); } SBAR();
  X1 = MF(k9, qr[4], X1); if (HASY) { SUM4(Y1, 8); SUM4(Y1, 12); } SBAR();
  X0 = MF(k10, qr[5], X0); if (HASY) { PACK8(Y1, 8, pa3); } SBAR();
  X1 = MF(k11, qr[5], X1); if (HASY) vfr_issue<0>(vf, vb);
  l_reg += ls;
  SBAR();
}
#define PKV(L, H) (bf16x8){L[0], L[1], L[2], L[3], H[0], H[1], H[2], H[3]}
#define VWAIT(f) asm volatile("s_waitcnt lgkmcnt(0)" : "+v"(f.a0), "+v"(f.b0), "+v"(f.c0), "+v"(f.d0), "+v"(f.a1), "+v"(f.b1), "+v"(f.c1), "+v"(f.d1) :: "memory")
template <bool HASX>
__device__ __forceinline__ float phaseB(f32x16* o, bf16x8 pa0, bf16x8 pa1, bf16x8 pa2, bf16x8 pa3, VFr& f, int vb, const f32x16& X0, const f32x16& X1) {
  SBAR(); VWAIT(f); VFr g; vfr_issue<2>(g, vb); SBAR();
  float a = 0.f, b = 0.f;
  o[0] = MF(pa0, PKV(f.a0, f.b0), o[0]); SBAR(); o[1] = MF(pa0, PKV(f.c0, f.d0), o[1]);
  if (HASX) { a = MX3(X0[0], X0[1], X1[0]); b = MX3(X0[2], X0[3], X1[1]); a = MX3(a, X1[2], X1[3]); b = MX3(b, X0[4], X0[5]); } SBAR();
  o[0] = MF(pa1, PKV(f.a1, f.b1), o[0]); if (HASX) { a = MX3(a, X0[6], X0[7]); b = MX3(b, X1[4], X1[5]); } SBAR();
  o[1] = MF(pa1, PKV(f.c1, f.d1), o[1]); if (HASX) { a = MX3(a, X1[6], X1[7]); b = MX3(b, X0[8], X0[9]); a = MX3(a, X0[10], X0[11]); } SBAR();
  VWAIT(g); SBAR();
  o[0] = MF(pa2, PKV(g.a0, g.b0), o[0]); if (HASX) { b = MX3(b, X1[8], X1[9]); a = MX3(a, X1[10], X1[11]); } SBAR();
  o[1] = MF(pa2, PKV(g.c0, g.d0), o[1]); if (HASX) { b = MX3(b, X0[12], X0[13]); a = MX3(a, X0[14], X0[15]); } SBAR();
  o[0] = MF(pa3, PKV(g.a1, g.b1), o[0]); if (HASX) { b = MX3(b, X1[12], X1[13]); a = MX3(a, X1[14], X1[15]); } SBAR();
  o[1] = MF(pa3, PKV(g.c1, g.d1), o[1]); SBAR();
  float pmax = __builtin_fmaxf(a, b);
  if (HASX) { auto rr = __builtin_amdgcn_permlane32_swap(__float_as_uint(pmax), __float_as_uint(pmax), false, false); pmax = __builtin_fmaxf(__uint_as_float(rr[0]), __uint_as_float(rr[1])); }
  return pmax;
}
__device__ __forceinline__ float rowmax32(const f32x16& p0, const f32x16& p1) {
  float a = MX3(p0[0], p0[1], p1[0]), b = MX3(p0[2], p0[3], p1[1]); a = MX3(a, p1[2], p1[3]);
#pragma unroll
  for (int r = 4; r < 16; r += 4) { a = MX3(a, p0[r], p0[r + 1]); b = MX3(b, p0[r + 2], p0[r + 3]); a = MX3(a, p1[r], p1[r + 1]); b = MX3(b, p1[r + 2], p1[r + 3]); }
  float pmax = __builtin_fmaxf(a, b);
  auto rr = __builtin_amdgcn_permlane32_swap(__float_as_uint(pmax), __float_as_uint(pmax), false, false);
  return __builtin_fmaxf(__uint_as_float(rr[0]), __uint_as_float(rr[1]));
}
template <bool FIRST>
__device__ __forceinline__ float decide(float pmax, f32x16& p0, f32x16& p1, float& m_reg, f32x16& negm) {
  float alpha = 1.f;
  if (FIRST || __builtin_expect(__any(pmax > THR2), 0)) {
    const float dl = FIRST ? pmax : __builtin_fmaxf(pmax, 0.f); m_reg += dl;
#pragma unroll
    for (int r = 0; r < 16; ++r) { p0[r] -= dl; p1[r] -= dl; }
#pragma unroll
    for (int r = 0; r < 16; ++r) negm[r] = -m_reg;
    if (!FIRST) alpha = __builtin_amdgcn_exp2f(-dl);
  }
  return alpha;
}
__device__ __forceinline__ void attn_unit(const bf16_t* __restrict__ Qb, const bf16_t* __restrict__ KNh, const bf16_t* __restrict__ KRb, const bf16_t* __restrict__ Vh,
                                          bf16_t* __restrict__ Ob, int nkeys, char* lds, int tid_in) {
  int tid_l = tid_in; asm volatile("" : "+v"(tid_l));
  const int tid = tid_l, wid = tid >> 6, lane = tid & 63, r32 = lane & 31, hi = lane >> 5;
  char* V_lds = lds; char* K_lds = lds + 3 * SHM_V;
  float* ws = (float*)(lds + 3 * SHM_V + 2 * SHM_K) + wid * 64; float* li_l = ws; float* al_l = ws + 32;
  float m_reg = 0.f, l_reg = 0.f; f32x16 o[2] = {}; f32x16 negm = {}; bf16x8 qr[6];
  const bf16_t* Qw = Qb + (long)(wid * QBLK + r32) * 768 + hi * 8;
#pragma unroll
  for (int d0 = 0; d0 < 6; ++d0) qr[d0] = *reinterpret_cast<const bf16x8*>(Qw + d0 * 16);
  const int sr = tid >> 3, sc = (tid & 7) * 8, vst0 = v_st_nat(sr, sc), kst0 = KSWZ(sr, sc * 2);
  const bool krt = tid < 256; const int rr_ = (tid >> 2) & 63, rc_ = (tid & 3) * 8, kst1 = KSWZ(rr_, 128 + rc_ * 2);
  const int vb0 = (int)(uintptr_t)V_lds + v_rd_base(lane);
  const int kaddr = (int)(uintptr_t)K_lds + r32 * 208 + hi * 16;
  struct { bf16x8 vs, ks, kr; } sr_[2];
  typedef unsigned v4u_t __attribute__((ext_vector_type(4)));
  const __amdgpu_buffer_rsrc_t rV = __builtin_amdgcn_make_buffer_rsrc((void*)Vh, 0, LK * 64 * 2, 0x00020000);
  const __amdgpu_buffer_rsrc_t rK = __builtin_amdgcn_make_buffer_rsrc((void*)KNh, 0, LK * 64 * 2, 0x00020000);
  const __amdgpu_buffer_rsrc_t rR = __builtin_amdgcn_make_buffer_rsrc((void*)KRb, 0, LK * 32 * 2, 0x00020000);
  const int goff_kv = (sr * 64 + sc) * 2, goff_kr = (rr_ * 32 + rc_) * 2;
#define BLD(R, VO, SO) __builtin_bit_cast(bf16x8, __builtin_amdgcn_raw_buffer_load_b128(R, VO, SO, 0))
#define SLOAD(i, k0) do { sr_[i].vs = BLD(rV, goff_kv, (k0) * 128); sr_[i].ks = BLD(rK, goff_kv, (k0) * 128); if (krt) sr_[i].kr = BLD(rR, goff_kr, (k0) * 64); } while (0)
#define SWRITE(b, voff, i) do { *(bf16x8*)(V_lds + (voff) + vst0) = sr_[i].vs; *(bf16x8*)(K_lds + (b) * SHM_K + kst0) = sr_[i].ks; \
    if (krt) *(bf16x8*)(K_lds + (b) * SHM_K + kst1) = sr_[i].kr; } while (0)
#define SWAIT() do { asm volatile("s_waitcnt vmcnt(3)" ::: "memory"); } while (0)
#define RESC(a) do { if (__any((a) < 1.f)) { if (hi == 0) al_l[r32] = (a); asm volatile("s_waitcnt lgkmcnt(0)" ::: "memory"); l_reg *= (a); \
    _Pragma("unroll") for (int d = 0; d < 2; ++d) _Pragma("unroll") for (int r = 0; r < 16; ++r) o[d][r] *= al_l[crow(r, hi)]; } } while (0)
  f32x16 pA0, pA1, pB0, pB1; float alA, alB; bf16x8 pa0, pa1, pa2, pa3; VFr vf; const int NT = nkeys / KVBLK;
  constexpr int SE = 0, SO = 1;
  int vprev = 0, vcur = SHM_V, vnext = 2 * SHM_V;
#define ROT() do { const int t_ = vprev; vprev = vcur; vcur = vnext; vnext = t_; } while (0)
  SLOAD(SE, 0); asm volatile("s_waitcnt vmcnt(0)" ::: "memory"); SWRITE(0, 0, SE); __syncthreads();
  phaseA<0, false>(pA0, pA1, pB0, pB1, pa0, pa1, pa2, pa3, qr, negm, kaddr, vf, vb0, l_reg);
  alA = decide<true>(rowmax32(pA0, pA1), pA0, pA1, m_reg, negm);
  SLOAD(SO, KVBLK); if (2 < NT) SLOAD(SE, 2 * KVBLK);
  SWAIT(); SWRITE(1, SHM_V, SO); __syncthreads();
  for (int j = 1; j + 1 < NT; j += 2) {
    phaseA<1, true>(pB0, pB1, pA0, pA1, pa0, pa1, pa2, pa3, qr, negm, kaddr, vf, vb0 + vprev, l_reg);
    SLOAD(SO, (j + 2) * KVBLK); SBAR();
    alB = decide<false>(phaseB<true>(o, pa0, pa1, pa2, pa3, vf, vb0 + vprev, pB0, pB1), pB0, pB1, m_reg, negm);
    SWAIT(); SWRITE(0, vnext, SE);
    RESC(alB); __syncthreads(); ROT();
    phaseA<0, true>(pA0, pA1, pB0, pB1, pa0, pa1, pa2, pa3, qr, negm, kaddr, vf, vb0 + vprev, l_reg);
    if (j + 3 < NT) SLOAD(SE, (j + 3) * KVBLK); SBAR();
    alA = decide<false>(phaseB<true>(o, pa0, pa1, pa2, pa3, vf, vb0 + vprev, pA0, pA1), pA0, pA1, m_reg, negm);
    SWAIT(); SWRITE(1, vnext, SO);
    RESC(alA); __syncthreads(); ROT();
  }
  phaseA<1, true>(pB0, pB1, pA0, pA1, pa0, pa1, pa2, pa3, qr, negm, kaddr, vf, vb0 + vprev, l_reg);
  alB = decide<false>(phaseB<true>(o, pa0, pa1, pa2, pa3, vf, vb0 + vprev, pB0, pB1), pB0, pB1, m_reg, negm);
  RESC(alB);
  finishSM(pB0, pB1, l_reg, pa0, pa1, pa2, pa3);
  vfr_issue<0>(vf, vb0 + vcur);
  (void)phaseB<false>(o, pa0, pa1, pa2, pa3, vf, vb0 + vcur, pB0, pB1);
#undef ROT
  { auto rr = __builtin_amdgcn_permlane32_swap(__float_as_uint(l_reg), __float_as_uint(l_reg), false, false); l_reg = __uint_as_float(rr[0]) + __uint_as_float(rr[1]); }
  if (hi == 0) li_l[r32] = l_reg;
  asm volatile("s_waitcnt lgkmcnt(0)" ::: "memory");
  float rli[16];
#pragma unroll
  for (int r = 0; r < 16; ++r) rli[r] = __builtin_amdgcn_rcpf(li_l[crow(r, hi)]);
  bf16_t* Ow = Ob + (long)(wid * QBLK) * 1024;
#pragma unroll
  for (int r = 0; r < 16; ++r) { int orow = crow(r, hi);
#pragma unroll
    for (int d0 = 0; d0 < 2; ++d0) { const float v = o[d0][r] * rli[r]; Ow[(long)orow * 1024 + d0 * 32 + r32] = (bf16_t)(cvtpk(v, v) & 0xffffu); } }
  __syncthreads();
#undef SLOAD
#undef BLD
#undef SWRITE
#undef SWAIT
#undef RESC
}
}
#define LAS __attribute__((address_space(3)))
typedef unsigned short bf16_t;
typedef float f32x4 __attribute__((ext_vector_type(4)));
typedef unsigned u32x4 __attribute__((ext_vector_type(4)));
typedef unsigned u32x2 __attribute__((ext_vector_type(2)));
typedef short bf16x8 __attribute__((ext_vector_type(8)));
using att::f32x16;
#define LDS_WAIT() asm volatile("s_waitcnt lgkmcnt(0)" ::: "memory")

constexpr int NWAVES = 8, NTHREADS = 512;
constexpr int D = 1024, BATCH = 8, SEQ = 8192, DEPTH = 4, CTXL = 256, DFF = 4096, DIN = 1696;
constexpr int TL = BATCH * SEQ, TC = BATCH * CTXL, MALL = TL + TC;
constexpr size_t MiB = 1u << 20;
constexpr size_t WS_ROPE = 64 * 1024, WS_MODS = 1 * MiB, WS_SSQ = 2 * MiB, WS_WIN = 8 * MiB, WS_WUQ = 22 * MiB, WS_WUKV = 25 * MiB, WS_WOUT = 27 * MiB,
                 WS_W1 = 35 * MiB, WS_W2 = 67 * MiB, WS_CX = 99 * MiB, WS_XN = 107 * MiB, WS_Z = 239 * MiB, WS_Q = 470 * MiB, WS_KN = 569 * MiB, WS_KR = 635 * MiB,
                 WS_V = 640 * MiB, WS_Y = 706 * MiB, WS_H = 239 * MiB, WS_END = 838 * MiB,
                 WS_SSQX = 838 * MiB, WS_SHW = 843 * MiB, WS_STAB = 844 * MiB, WS_XB = 845 * MiB, WS_PART = 977 * MiB, WS_END2 = 1009 * MiB;
static_assert(WS_SSQ + (size_t)MALL * 20 * 4 <= WS_WIN && WS_XN + (size_t)MALL * D * 2 <= WS_Z && WS_Z + (size_t)MALL * ZP * 2 <= WS_Q && WS_Q + (size_t)MALL * 768 * 2 <= WS_KN &&
              WS_KN + (size_t)64 * LK * 64 * 2 <= WS_KR && WS_KR + (size_t)8 * LK * 32 * 2 <= WS_V && WS_V + (size_t)64 * LK * 64 * 2 <= WS_Y && WS_Y + (size_t)MALL * D * 2 <= WS_END &&
              WS_H + (size_t)MALL * DFF * 2 <= WS_END && WS_MODS + (size_t)DEPTH * 9 * 6144 * 4 <= WS_SSQ, "ws map");
constexpr int SHW_IN = 1792, SHW_L = 9 * (1792 + 4096);
static_assert(WS_SSQX + (size_t)MALL * 16 * 4 <= WS_SHW && WS_SHW + (size_t)DEPTH * SHW_L * 4 <= WS_STAB && WS_STAB + (size_t)DEPTH * 2 * 9 * 1024 * 4 <= WS_XB && WS_XB + (size_t)MALL * D * 2 <= WS_PART && WS_PART + (size_t)4 * TC * D * 4 <= WS_END2, "ws map 2");
constexpr int LDS_BYTES = 147456;

struct Args { const float* in[25]; float* out; unsigned char* ws; int ph_lo, ph_hi; };

__device__ __forceinline__ float wave_sum(float v, int lane) {
#pragma unroll
    for (int o = 1; o < 64; o <<= 1) v += shx(v, o, lane);
    return v;
}
__device__ __forceinline__ float sigmoid_f(float x) { return __builtin_amdgcn_rcpf(1.f + __expf(-x)); }
__device__ __forceinline__ float gelu_tanh(float x) { const float u = 0.7978845608028654f * (x + 0.044715f * x * x * x); return x * __builtin_amdgcn_rcpf(1.f + __expf(-2.f * u)); }
__device__ __forceinline__ float bf2f(unsigned short h) { return __uint_as_float((unsigned)h << 16); }
__device__ __forceinline__ unsigned pk2(float lo, float hi) { return pg8::cvt_pk_bf16(lo, hi); }
__device__ __forceinline__ int rope_new(int i) { const int g = i >> 4, w = i & 15; return 16 * g + 2 * (w & 7) + (w >> 3); }
__device__ __forceinline__ int rowmap(int mode, int n) {
    if (mode == 1) return (n >= 640 && n < 672) ? 640 + rope_new(n - 640) : n;
    if (mode == 2) { const int h = n / 96, d = n - h * 96; return d >= 64 ? h * 96 + 64 + rope_new(d - 64) : n; }
    return n;
}
__device__ __forceinline__ void transpose_item(const float* W, int K, int N, bf16_t* WT, const float* kscale, int mode, LAS float* scr, int item, int lane) {
    const int nblk = N / 32, kb = item / nblk, nb = item % nblk, k0 = 64 * kb, n0 = 32 * nb;
#pragma unroll 8
    for (int i = 0; i < 32; ++i) { const int kk = 2 * i + (lane >> 5); float w = W[(size_t)(k0 + kk) * N + n0 + (lane & 31)]; if (kscale) w *= kscale[k0 + kk]; scr[kk * 33 + (lane & 31)] = w; }
    LDS_WAIT(); asm volatile("" ::: "memory");
    const int c = lane & 7;
#pragma unroll
    for (int j = 0; j < 4; ++j) { const int n = (lane >> 3) + 8 * j; const LAS float* s = scr + (8 * c) * 33 + n;
        u32x4 o; o.x = pk2(s[0 * 33], s[1 * 33]); o.y = pk2(s[2 * 33], s[3 * 33]); o.z = pk2(s[4 * 33], s[5 * 33]); o.w = pk2(s[6 * 33], s[7 * 33]);
        *(u32x4*)(WT + (size_t)rowmap(mode, n0 + n) * K + k0 + 8 * c) = o; }
    LDS_WAIT(); asm volatile("" ::: "memory");
}

typedef __attribute__((address_space(1))) unsigned gu32;
#define RLX_AGENT __ATOMIC_RELAXED, __HIP_MEMORY_SCOPE_AGENT
#define XB_TMO      128
#define XB_XCNT(j)  (256  + 64 * (j))
#define XB_XSUB(j)  (1280 + 64 * (j))
#define XB_XGEN(j)  (2304 + 64 * (j))
#define XB_TOP      3328
#define XB_TOPGEN   3392
#define XCD_BAR_WORDS 3456
#define XB_SPIN_CAP (1u << 18)

__device__ __forceinline__ unsigned xb_ld(unsigned* p)              { return __hip_atomic_load(p, __ATOMIC_RELAXED, __HIP_MEMORY_SCOPE_AGENT); }
__device__ __forceinline__ unsigned xb_add(unsigned* p, unsigned v) { return __hip_atomic_fetch_add(p, v, __ATOMIC_RELAXED, __HIP_MEMORY_SCOPE_AGENT); }
__device__ __forceinline__ unsigned xb_xcc_id() { return (unsigned)__builtin_amdgcn_s_getreg((3 << 11) | 20) & 0xFu; }
#define XB_SPIN(cond, bar) do { unsigned _sp = 0; while (cond) { __builtin_amdgcn_s_sleep(1); \
    if ((++_sp & 255u) == 0u) { if (xb_ld(&(bar)[XB_TMO])) break; if (_sp > XB_SPIN_CAP) { atomicAdd(&(bar)[XB_TMO], 1u); break; } } } } while (0)

struct XcdBarrier {
    unsigned* bar; unsigned x;
    volatile LAS unsigned* st;
};

__device__ __forceinline__ XcdBarrier xcd_barrier_post(unsigned* bar, volatile LAS unsigned* st) {
    XcdBarrier b; b.bar = bar; b.x = xb_xcc_id(); b.st = st;
    if (threadIdx.x == 0) (void)xb_add(&bar[XB_XCNT(b.x)], 1u);
    return b;
}
__device__ __forceinline__ void xcd_barrier_complete(unsigned* bar, unsigned x, unsigned& nloc, unsigned& nx) {
    const unsigned G = gridDim.x * gridDim.y * gridDim.z;
    unsigned sum, cnt, mine, sp = 0u;
    for (;;) {
        sum = 0u; cnt = 0u; mine = 0u;
#pragma unroll
        for (unsigned j = 0; j < 16; ++j) { const unsigned c = xb_ld(&bar[XB_XCNT(j)]); sum += c; cnt += (c > 0u) ? 1u : 0u; mine = (j == x) ? c : mine; }
        if (sum == G) break;
        __builtin_amdgcn_s_sleep(1);
        if ((++sp & 255u) == 0u) { if (xb_ld(&bar[XB_TMO])) break; if (sp > XB_SPIN_CAP) { atomicAdd(&bar[XB_TMO], 1u); break; } }
    }
    nloc = mine > 0u ? mine : 1u; nx = cnt > 0u ? cnt : 1u;
}

__device__ __forceinline__ void xcd_barrier(const XcdBarrier& b) {
    asm volatile("s_waitcnt vmcnt(0)" ::: "memory");
    __syncthreads();
    if (threadIdx.x == 0) {
        unsigned* bar = b.bar;
        __builtin_amdgcn_s_waitcnt(0);
        unsigned nloc = b.st[0], nx = b.st[1];
        if (nloc == 0u) { xcd_barrier_complete(bar, b.x, nloc, nx); b.st[0] = nloc; b.st[1] = nx; }
        const unsigned old = xb_add(&bar[XB_XSUB(b.x)], 1u);
        const unsigned gen = old / nloc;
        if (old + 1u == (gen + 1u) * nloc) {
            __builtin_amdgcn_fence(__ATOMIC_RELEASE, "agent");
            asm volatile("s_waitcnt vmcnt(0)" ::: "memory");
            const unsigned og = xb_add(&bar[XB_TOP], 1u);
            const unsigned tg = og / nx;
            if (og + 1u == (tg + 1u) * nx) xb_add(&bar[XB_TOPGEN], 1u);
            else XB_SPIN(xb_ld(&bar[XB_TOPGEN]) == tg, bar);
            __builtin_amdgcn_fence(__ATOMIC_ACQUIRE, "agent");
            xb_add(&bar[XB_XGEN(b.x)], 1u);
            asm volatile("s_waitcnt vmcnt(0)" ::: "memory");
        } else {
            XB_SPIN(xb_ld(&bar[XB_XGEN(b.x)]) == gen, bar);
            __builtin_amdgcn_fence(__ATOMIC_ACQUIRE, "agent");
            asm volatile("s_waitcnt vmcnt(0)" ::: "memory");
        }
    }
    __syncthreads();
}
__device__ __forceinline__ int nrep_of(int n) { asm volatile("" : "+s"(n)); return n; }
struct Ctx {
    LAS unsigned char* lds; unsigned char* ldsg; const float* const* in; float* out; unsigned char* ws;
    int tid, lane, wave, G, bx, vcu;
};

__device__ __forceinline__ void phase_prologue(const Ctx& F) {
    LAS float* scr = (LAS float*)(F.lds + F.wave * 16384);
    const int gw = F.bx * NWAVES + F.wave, NGW = F.G * NWAVES;
    constexpr int I_IN = 16 * 53, I_UQ = 6 * 24, I_UKV = 4 * 32, I_OUT = 16 * 32, I_1 = 16 * 128, I_2 = 64 * 32, I_L = I_IN + I_UQ + I_UKV + I_OUT + I_1 + I_2;
    for (int it = gw; it < DEPTH * I_L; it += NGW) {
        const int l = it / I_L; int r = it - l * I_L;
        if (r < I_IN) { transpose_item(F.in[8] + (size_t)l * D * DIN, D, DIN, (bf16_t*)(F.ws + WS_WIN) + (size_t)l * ZP * D, nullptr, 1, scr, r, F.lane); continue; } r -= I_IN;
        if (r < I_UQ) { transpose_item(F.in[10] + (size_t)l * 384 * 768, 384, 768, (bf16_t*)(F.ws + WS_WUQ) + (size_t)l * 768 * 384, F.in[9] + l * 384, 2, scr, r, F.lane); continue; } r -= I_UQ;
        if (r < I_UKV) { transpose_item(F.in[12] + (size_t)l * 256 * 1024, 256, 1024, (bf16_t*)(F.ws + WS_WUKV) + (size_t)l * 1024 * 256, F.in[11] + l * 256, 0, scr, r, F.lane); continue; } r -= I_UKV;
        if (r < I_OUT) { transpose_item(F.in[21] + (size_t)l * D * D, D, D, (bf16_t*)(F.ws + WS_WOUT) + (size_t)l * D * D, nullptr, 0, scr, r, F.lane); continue; } r -= I_OUT;
        if (r < I_1) { transpose_item(F.in[22] + (size_t)l * D * DFF, D, DFF, (bf16_t*)(F.ws + WS_W1) + (size_t)l * DFF * D, nullptr, 0, scr, r, F.lane); continue; } r -= I_1;
        transpose_item(F.in[23] + (size_t)l * DFF * D, DFF, D, (bf16_t*)(F.ws + WS_W2) + (size_t)l * D * DFF, nullptr, 0, scr, r, F.lane);
    }
    for (int i = F.bx * NTHREADS + F.tid; i < DEPTH * 96 * D / 8; i += F.G * NTHREADS) { const int l = i / (96 * D / 8), r = i - l * (96 * D / 8);
        unsigned zz_ = 0u; asm volatile("" : "+v"(zz_)); *(u32x4*)((bf16_t*)(F.ws + WS_WIN) + ((size_t)l * ZP + DIN) * D + (size_t)r * 8) = (u32x4){zz_, zz_, zz_, zz_}; }
    if (F.bx == 0) for (int i = F.tid; i < 128 * 8; i += NTHREADS) { const int pos = i >> 3, j = i & 7; const float inv = 1.0f / powf(10000.0f, (float)j / 8.0f); const float ang = (float)pos * inv;
        float* rp = (float*)(F.ws + WS_ROPE) + i * 2; rp[0] = cosf(ang); rp[1] = sinf(ang); }
    __syncthreads();
    LAS float* sv = (LAS float*)F.lds;
    LAS float* red = (LAS float*)(F.lds + 40960);
    for (int i = F.tid; i < 9 * 1024; i += NTHREADS) { const int j = i >> 10, k = i & 1023; const float cvl = j < 8 ? F.in[1][j * 1024 + k] : F.in[3][k]; sv[i] = cvl * sigmoid_f(cvl); }
    __syncthreads();
    float* mods = (float*)(F.ws + WS_MODS);
    for (int it = F.bx; it < DEPTH * 96; it += F.G) {
        const int l = it / 96, cg_ = it - l * 96, col = F.tid & 63, kg = F.tid >> 6;
        const float* wp = F.in[4] + (size_t)l * D * 6144 + (size_t)(kg * 128) * 6144 + cg_ * 64 + col;
        float acc[9];
#pragma unroll
        for (int j = 0; j < 9; ++j) acc[j] = 0.f;
#pragma unroll 16
        for (int k = 0; k < 128; ++k) { const float w = wp[(size_t)k * 6144];
#pragma unroll
            for (int j = 0; j < 9; ++j) acc[j] += sv[j * 1024 + kg * 128 + k] * w; }
#pragma unroll
        for (int j = 0; j < 9; ++j) red[(kg * 9 + j) * 64 + col] = acc[j];
        __syncthreads();
        for (int i = F.tid; i < 9 * 64; i += NTHREADS) { const int j = i >> 6, c2 = i & 63; float s = F.in[5][l * 6144 + cg_ * 64 + c2];
#pragma unroll
            for (int g = 0; g < 8; ++g) s += red[(g * 9 + j) * 64 + c2];
            mods[((size_t)l * 9 + j) * 6144 + cg_ * 64 + c2] = s;
            const int cidx = cg_ * 64 + c2;
            if (cidx >= 1024 && cidx < 2048) ((float*)(F.ws + WS_STAB))[(((size_t)l * 2 + 0) * 9 + j) * 1024 + cidx - 1024] = F.in[6][l * 1024 + cidx - 1024] * (1.f + s);
            if (cidx >= 4096 && cidx < 5120) ((float*)(F.ws + WS_STAB))[(((size_t)l * 2 + 1) * 9 + j) * 1024 + cidx - 4096] = F.in[7][l * 1024 + cidx - 4096] * (1.f + s); }
        __syncthreads();
    }
}

__device__ __forceinline__ void phase_norm0(const Ctx& F) {
    const int gw = F.bx * NWAVES + F.wave, NGW = F.G * NWAVES; bf16_t* XS = (bf16_t*)(F.ws + WS_XN); float* ssqx = (float*)(F.ws + WS_SSQX);
    const float* stab = (const float*)(F.ws + WS_STAB);
    for (int wu = gw; wu < MALL / 16; wu += NGW) {
        const int r0 = wu * 16; const bool isctx = r0 >= TL; const int mi = isctx ? 8 : (r0 >> 13);
        const float* base = isctx ? F.in[2] + (size_t)(r0 - TL) * D : F.in[0] + (size_t)r0 * D;
        f32x4 S[4];
#pragma unroll
        for (int j = 0; j < 4; ++j) S[j] = *(const f32x4*)(stab + (size_t)mi * 1024 + 4 * F.lane + 256 * j);
        for (int i = 0; i < 16; ++i) {
            const f32x4* xr = (const f32x4*)(base + (size_t)i * D) + F.lane;
            f32x4 v[4]; float s = 0.f;
#pragma unroll
            for (int j = 0; j < 4; ++j) { v[j] = xr[64 * j]; s += (v[j][0] * v[j][0] + v[j][1] * v[j][1]) + (v[j][2] * v[j][2] + v[j][3] * v[j][3]); }
            bf16_t* orow = XS + (size_t)(r0 + i) * D + 4 * F.lane;
#pragma unroll
            for (int j = 0; j < 4; ++j) { const f32x4 o = v[j] * S[j]; u32x2 w; w.x = pk2(o[0], o[1]); w.y = pk2(o[2], o[3]); *(u32x2*)(orow + 256 * j) = w;
                u32x2 wb; wb.x = pk2(v[j][0], v[j][1]); wb.y = pk2(v[j][2], v[j][3]); *(u32x2*)((bf16_t*)(F.ws + WS_XB) + (size_t)(r0 + i) * D + 4 * F.lane + 256 * j) = wb; }
            const float tot = wave_sum(s, F.lane);
            if (F.lane < 4) { f32x4 q = {0.f, 0.f, 0.f, 0.f}; if (F.lane == 0) q[0] = tot; *(f32x4*)(ssqx + (size_t)(r0 + i) * 16 + 4 * F.lane) = q; }
        }
    }
    __syncthreads();
    LAS float* sv = (LAS float*)F.lds;
    LAS float* red = (LAS float*)(F.lds + 40960);
    const float* mods = (const float*)(F.ws + WS_MODS); float* shw = (float*)(F.ws + WS_SHW);
    constexpr int G_IN = 28, G_FF = 64, G_L = G_IN + G_FF;
    for (int it = F.bx; it < DEPTH * G_L; it += F.G) {
        const int l = it / G_L, gi = it - l * G_L; const bool isin = gi < G_IN; const int cg_ = isin ? gi : gi - G_IN;
        const int shoff = isin ? 0 : 3072, N = isin ? DIN : DFF; const float* W = isin ? F.in[8] + (size_t)l * D * DIN : F.in[22] + (size_t)l * D * DFF;
        __syncthreads();
        for (int i = F.tid; i < 9 * 1024; i += NTHREADS) { const int j = i >> 10, k = i & 1023; sv[i] = mods[((size_t)l * 9 + j) * 6144 + shoff + k]; }
        __syncthreads();
        const int col = F.tid & 63, kg = F.tid >> 6, n = cg_ * 64 + col; const bool valid = n < N;
        float acc[9];
#pragma unroll
        for (int j = 0; j < 9; ++j) acc[j] = 0.f;
        if (valid) { const float* wp = W + (size_t)(kg * 128) * N + n;
#pragma unroll 16
            for (int k = 0; k < 128; ++k) { const float w = wp[(size_t)k * N];
#pragma unroll
                for (int j = 0; j < 9; ++j) acc[j] += sv[j * 1024 + kg * 128 + k] * w; } }
#pragma unroll
        for (int j = 0; j < 9; ++j) red[(kg * 9 + j) * 64 + col] = acc[j];
        __syncthreads();
        for (int i = F.tid; i < 9 * 64; i += NTHREADS) { const int j = i >> 6, c2 = i & 63, n2 = cg_ * 64 + c2; float sm = 0.f;
#pragma unroll
            for (int g = 0; g < 8; ++g) sm += red[(g * 9 + j) * 64 + c2];
            if (isin) { if (n2 < DIN) shw[(size_t)l * SHW_L + j * SHW_IN + rowmap(1, n2)] = sm; else shw[(size_t)l * SHW_L + j * SHW_IN + n2] = 0.f; }
            else shw[(size_t)l * SHW_L + 9 * SHW_IN + j * DFF + n2] = sm; }
    }
    __syncthreads();
}
__device__ __forceinline__ void phase_final_norm(const Ctx& F) {
    const int gw = F.bx * NWAVES + F.wave, NGW = F.G * NWAVES; const float* g = F.in[24]; const bf16_t* XB = (const bf16_t*)(F.ws + WS_XB);
    f32x4 S[4];
#pragma unroll
    for (int j = 0; j < 4; ++j) S[j] = *(const f32x4*)(g + 4 * F.lane + 256 * j);
    for (int r = gw; r < TL; r += NGW) {
        f32x4* orow = (f32x4*)(F.out + (size_t)r * D) + F.lane;
        f32x4 v[4]; float s = 0.f;
#pragma unroll
        for (int j = 0; j < 4; ++j) { const u32x2 w = *(const u32x2*)(XB + (size_t)r * D + 4 * F.lane + 256 * j);
            v[j] = (f32x4){__uint_as_float(w.x << 16), __uint_as_float(w.x & 0xffff0000u), __uint_as_float(w.y << 16), __uint_as_float(w.y & 0xffff0000u)};
            s += (v[j][0] * v[j][0] + v[j][1] * v[j][1]) + (v[j][2] * v[j][2] + v[j][3] * v[j][3]); }
        const float rstd = rsqrtf(wave_sum(s, F.lane) * (1.0f / D) + 1e-6f);
#pragma unroll
        for (int j = 0; j < 4; ++j) orow[64 * j] = v[j] * rstd * S[j];
    }
}

__device__ __forceinline__ void phase_ctx_finish(const Ctx& F, const float* gate  , const float* stab  ) {
    const int gw = F.bx * NWAVES + F.wave, NGW = F.G * NWAVES; bf16_t* XB = (bf16_t*)(F.ws + WS_XB); bf16_t* XS = (bf16_t*)(F.ws + WS_XN); float* ssqx = (float*)(F.ws + WS_SSQX);
    const float* P = (const float*)(F.ws + WS_PART);
    for (int rc = gw; rc < TC; rc += NGW) {
        const int row = TL + rc; float s = 0.f;
#pragma unroll
        for (int j = 0; j < 4; ++j) { const int c = 4 * F.lane + 256 * j; const size_t po = (size_t)rc * D + c;
            const f32x4 p = (*(const f32x4*)(P + po) + *(const f32x4*)(P + (size_t)TC * D + po)) + (*(const f32x4*)(P + (size_t)2 * TC * D + po) + *(const f32x4*)(P + (size_t)3 * TC * D + po));
            const u32x2 xr = *(const u32x2*)(XB + (size_t)row * D + c);
            const f32x4 x = {__uint_as_float(xr.x << 16), __uint_as_float(xr.x & 0xffff0000u), __uint_as_float(xr.y << 16), __uint_as_float(xr.y & 0xffff0000u)};
            const f32x4 y = x + *(const f32x4*)(gate + c) * p, t = y * *(const f32x4*)(stab + c);
            u32x2 w; w.x = pk2(y[0], y[1]); w.y = pk2(y[2], y[3]); *(u32x2*)(XB + (size_t)row * D + c) = w;
            u32x2 w2; w2.x = pk2(t[0], t[1]); w2.y = pk2(t[2], t[3]); *(u32x2*)(XS + (size_t)row * D + c) = w2;
            s += (y[0] * y[0] + y[1] * y[1]) + (y[2] * y[2] + y[3] * y[3]); }
        const float tot = wave_sum(s, F.lane);
        if (F.lane < 4) { f32x4 q = {0.f, 0.f, 0.f, 0.f}; if (F.lane == 0) q[0] = tot; *(f32x4*)(ssqx + (size_t)row * 16 + 4 * F.lane) = q; }
    }
}

__device__ __forceinline__ void phase_krope(const Ctx& F) {
    const bf16_t* Z = (const bf16_t*)(F.ws + WS_Z); bf16_t* KR = (bf16_t*)(F.ws + WS_KR); const float* rope = (const float*)(F.ws + WS_ROPE);
    for (int i = F.bx * NTHREADS + F.tid; i < MALL * 4; i += F.G * NTHREADS) {
        const int row = i >> 2, ch = i & 3;
        const u32x4 raw = *(const u32x4*)(Z + (size_t)row * ZP + 640 + ch * 8);
        float a[8];
#pragma unroll
        for (int e = 0; e < 4; ++e) { a[2 * e] = __uint_as_float(raw[e] << 16); a[2 * e + 1] = __uint_as_float(raw[e] & 0xffff0000u); }
        int b, kpos;
        if (row < TL) { b = row >> 13; const int t = row & 8191; kpos = 256 + t; const int g = ch >> 1, j0 = (ch & 1) * 4; const int pos = g ? (t & 63) : (t >> 6);
            const f32x4* tb = (const f32x4*)(rope + (pos * 8 + j0) * 2); const f32x4 c0 = tb[0], c1 = tb[1];
            const float cs[8] = {c0[0], c0[1], c0[2], c0[3], c1[0], c1[1], c1[2], c1[3]};
#pragma unroll
            for (int p = 0; p < 4; ++p) { const float x1 = a[2 * p], x2 = a[2 * p + 1], c = cs[2 * p], s = cs[2 * p + 1]; a[2 * p] = x1 * c - x2 * s; a[2 * p + 1] = x2 * c + x1 * s; } }
        else { const int rc = row - TL; b = rc >> 8; kpos = rc & 255; }
        u32x4 o; o.x = pk2(a[0], a[1]); o.y = pk2(a[2], a[3]); o.z = pk2(a[4], a[5]); o.w = pk2(a[6], a[7]);
        *(u32x4*)(KR + ((size_t)b * LK + kpos) * 32 + ch * 8) = o;
    }
}

__device__ __forceinline__ void phase_conv(const Ctx& F, int l, int nrows, int rot) {
    const bf16_t* Z = (const bf16_t*)(F.ws + WS_Z); bf16_t* Y = (bf16_t*)(F.ws + WS_Y);
    LAS float* yin = (LAS float*)F.lds;
    LAS float* yout = (LAS float*)(F.lds + 65536);
    const float* cw = F.in[13] + (size_t)l * 31 * 256; const float* cb = F.in[14] + l * 256; const float* lg = F.in[15] + l * 256; const float* lb = F.in[16] + l * 256;
    const int c = F.tid & 255, th = F.tid >> 8;
    float w[31];
#pragma unroll
    for (int j = 0; j < 31; ++j) w[j] = cw[j * 256 + c];
    const float bias = cb[c];
    const f32x4 g4 = *(const f32x4*)(lg + 4 * F.lane), b4 = *(const f32x4*)(lb + 4 * F.lane);
    const int nunits = nrows / 32;
    for (int un = (F.bx - rot + F.G) % F.G; un < nunits; un += F.G) {
        const int r0 = un * 32; int s0, s1;
        if (r0 < TL) { s0 = r0 & ~8191; s1 = s0 + 8192; } else { s0 = TL + ((r0 - TL) & ~255); s1 = s0 + 256; }
        __syncthreads();
#pragma unroll
        for (int it_ = 0; it_ < 4; ++it_) { const int it = F.tid + it_ * NTHREADS; if (it >= 62 * 32) break; const int i = it >> 5, ch = it & 31; const int row = r0 - 15 + i;
            f32x4 o0 = {0.f, 0.f, 0.f, 0.f}, o1 = o0;
            if (row >= s0 && row < s1) { const u32x4 ra = *(const u32x4*)(Z + (size_t)row * ZP + 672 + ch * 8), rg = *(const u32x4*)(Z + (size_t)row * ZP + 928 + ch * 8);
#pragma unroll
                for (int e = 0; e < 4; ++e) { const float a0 = __uint_as_float(ra[e] << 16), a1 = __uint_as_float(ra[e] & 0xffff0000u), g0 = __uint_as_float(rg[e] << 16), g1 = __uint_as_float(rg[e] & 0xffff0000u);
                    const float y0 = a0 * sigmoid_f(g0), y1 = a1 * sigmoid_f(g1);
                    if (e < 2) { o0[2 * e] = y0; o0[2 * e + 1] = y1; } else { o1[2 * e - 4] = y0; o1[2 * e - 3] = y1; } } }
            *(LAS f32x4*)(yin + i * 256 + ch * 8) = o0; *(LAS f32x4*)(yin + i * 256 + ch * 8 + 4) = o1; }
        __syncthreads();
        for (int ob = 0; ob < 2; ++ob) {
            const LAS float* xp = yin + (16 * th + 8 * ob) * 256 + c;
            float x[38];
#pragma unroll
            for (int k = 0; k < 38; ++k) x[k] = xp[k * 256];
#pragma unroll
            for (int oo = 0; oo < 8; ++oo) { float a = bias;
#pragma unroll
                for (int j = 0; j < 31; ++j) a += x[oo + j] * w[j];
                yout[(16 * th + 8 * ob + oo) * 256 + c] = a; }
        }
        __syncthreads();
#pragma unroll
        for (int i = 0; i < 4; ++i) { const int tk = F.wave * 4 + i; const f32x4 v = *(LAS f32x4*)(yout + tk * 256 + 4 * F.lane);
            const float mu = wave_sum((v[0] + v[1]) + (v[2] + v[3]), F.lane) * (1.0f / 256.0f); const f32x4 dv = v - mu;
            const float var = wave_sum((dv[0] * dv[0] + dv[1] * dv[1]) + (dv[2] * dv[2] + dv[3] * dv[3]), F.lane) * (1.0f / 256.0f);
            const float rstd = rsqrtf(var + 1e-6f); f32x4 y = dv * rstd * g4 + b4;
#pragma unroll
            for (int e = 0; e < 4; ++e) y[e] = y[e] * sigmoid_f(y[e]);
            u32x2 wv; wv.x = pk2(y[0], y[1]); wv.y = pk2(y[2], y[3]); *(u32x2*)(Y + (size_t)(r0 + tk) * D + 512 + 4 * F.lane) = wv; }
    }
    __syncthreads();
}

__device__ __forceinline__ void phase_sgu(const Ctx& F, int l, int nrows, int rot) {
    const bf16_t* Z = (const bf16_t*)(F.ws + WS_Z); bf16_t* Y = (bf16_t*)(F.ws + WS_Y);
    const float* lg = F.in[17] + l * 256; const float* lb = F.in[18] + l * 256; const float* sw = F.in[19] + (size_t)l * 4 * 128 * 128; const float* sb = F.in[20] + l * 4 * 128;
    const int lane = F.lane, r32 = lane & 31, hi = lane >> 5;
    const int c8 = (lane & 31) * 8;
    f32x4 g0 = *(const f32x4*)(lg + c8), g1 = *(const f32x4*)(lg + c8 + 4), b0 = *(const f32x4*)(lb + c8), b1 = *(const f32x4*)(lb + c8 + 4);
    const int nunits = nrows / 128;
    for (int un = (F.bx - rot + F.G) % F.G; un < nunits; un += F.G) {
        const int r0 = un * 128;
        __syncthreads();
#pragma unroll
        for (int i = 0; i < 8; ++i) { const int q = F.wave * 16 + 2 * i + hi; const u32x4 raw = *(const u32x4*)(Z + (size_t)(r0 + q) * ZP + 1440 + c8);
            float a[8]; float s = 0.f;
#pragma unroll
            for (int e = 0; e < 4; ++e) { a[2 * e] = gelu_tanh(__uint_as_float(raw[e] << 16)); a[2 * e + 1] = gelu_tanh(__uint_as_float(raw[e] & 0xffff0000u)); s += a[2 * e] + a[2 * e + 1]; }
#pragma unroll
            for (int o = 1; o < 32; o <<= 1) s += shx(s, o, lane);
            const float mu = s * (1.0f / 256.0f); float q2 = 0.f;
#pragma unroll
            for (int e = 0; e < 8; ++e) { a[e] -= mu; q2 += a[e] * a[e]; }
#pragma unroll
            for (int o = 1; o < 32; o <<= 1) q2 += shx(q2, o, lane);
            const float rstd = rsqrtf(q2 * (1.0f / 256.0f) + 1e-6f);
            u32x4 o4; o4.x = pk2(a[0] * rstd * g0[0] + b0[0], a[1] * rstd * g0[1] + b0[1]); o4.y = pk2(a[2] * rstd * g0[2] + b0[2], a[3] * rstd * g0[3] + b0[3]);
            o4.z = pk2(a[4] * rstd * g1[0] + b1[0], a[5] * rstd * g1[1] + b1[1]); o4.w = pk2(a[6] * rstd * g1[2] + b1[2], a[7] * rstd * g1[3] + b1[3]);
            *(u32x4*)(F.ldsg + (c8 >> 6) * 16384 + (q >> 6) * 8192 + att::v_st(q & 63, c8 & 63)) = o4; }
        __syncthreads();
        const int h = F.wave >> 1, ph = F.wave & 1;
        f32x16 o[2][2] = {};
#pragma unroll
        for (int kt = 0; kt < 2; ++kt) { const int vb = (int)(uintptr_t)F.ldsg + h * 16384 + kt * 8192 + att::v_rd_base(lane);
#pragma unroll
            for (int mt = 0; mt < 2; ++mt) { bf16x8 pa[4]; const float* wr_ = sw + ((size_t)h * 128 + ph * 64 + mt * 32 + r32) * 128 + kt * 64 + hi * 8;
#pragma unroll
                for (int ks = 0; ks < 4; ++ks) { const f32x4 w0 = *(const f32x4*)(wr_ + ks * 16), w1 = *(const f32x4*)(wr_ + ks * 16 + 4); const u32x4 pw = pg8::pack8(w0, w1); pa[ks] = *reinterpret_cast<const bf16x8*>(&pw); }
                att::pv_one<0>(o[mt][0], vb, pa[0], pa[1], pa[2], pa[3]); att::pv_one<1>(o[mt][1], vb, pa[0], pa[1], pa[2], pa[3]); } }
        {
            LAS bf16_t* mx = (LAS bf16_t*)(F.lds + 65536);
#pragma unroll
            for (int mt = 0; mt < 2; ++mt)
#pragma unroll
                for (int r = 0; r < 16; ++r) { const int p = ph * 64 + mt * 32 + att::crow(r, hi); const float bs = sb[h * 128 + p];
#pragma unroll
                    for (int d0 = 0; d0 < 2; ++d0) { const float v = o[mt][d0][r] + bs; mx[p * 256 + h * 64 + d0 * 32 + r32] = (bf16_t)(pk2(v, v) & 0xffffu); } }
            __syncthreads();
#pragma unroll
            for (int it_ = 0; it_ < 8; ++it_) { const int it = F.tid + it_ * NTHREADS; const int p = it >> 5, ch = it & 31;
                const u32x4 mraw = *(const LAS u32x4*)(mx + p * 256 + ch * 8);
                const u32x4 zraw = *(const u32x4*)(Z + (size_t)(r0 + p) * ZP + 1184 + ch * 8);
                float ov[8];
#pragma unroll
                for (int e = 0; e < 4; ++e) { ov[2 * e] = gelu_tanh(__uint_as_float(zraw[e] << 16)) * __uint_as_float(mraw[e] << 16); ov[2 * e + 1] = gelu_tanh(__uint_as_float(zraw[e] & 0xffff0000u)) * __uint_as_float(mraw[e] & 0xffff0000u); }
                u32x4 o4; o4.x = pk2(ov[0], ov[1]); o4.y = pk2(ov[2], ov[3]); o4.z = pk2(ov[4], ov[5]); o4.w = pk2(ov[6], ov[7]);
                *(u32x4*)(Y + (size_t)(r0 + p) * D + 768 + ch * 8) = o4; }
        }
    }
    __syncthreads();
}

__device__ __forceinline__ void phase_attn(const Ctx& F, bool with_ctx) {
    const bf16_t* Q = (const bf16_t*)(F.ws + WS_Q); const bf16_t* KN = (const bf16_t*)(F.ws + WS_KN); const bf16_t* KR = (const bf16_t*)(F.ws + WS_KR); const bf16_t* V = (const bf16_t*)(F.ws + WS_V);
    bf16_t* Y = (bf16_t*)(F.ws + WS_Y);
    const int nlat = BATCH * 8 * 32, ntot = nlat + (with_ctx ? BATCH * 8 : 0);
    __syncthreads();
    for (int U = F.vcu; U < ntot; U += F.G) {
        int bh, row0, nkeys;
        if (U < nlat) { bh = U >> 5; const int qb = U & 31; row0 = (bh >> 3) * SEQ + qb * 256; nkeys = LK; }
        else { bh = U - nlat; row0 = TL + (bh >> 3) * CTXL; nkeys = CTXL; }
        const int b = bh >> 3, h = bh & 7;
        att::attn_unit(Q + (size_t)row0 * 768 + h * 96, KN + (size_t)bh * LK * 64, KR + (size_t)b * LK * 32, V + (size_t)bh * LK * 64, Y + (size_t)row0 * D + h * 64, nkeys, (char*)F.ldsg, F.tid);
    }
}

__global__ void __launch_bounds__(NTHREADS, 2) mega_fwd(Args args) {
    extern __shared__ __attribute__((aligned(16))) unsigned char lds[];
    Ctx F; F.lds = (LAS unsigned char*)lds; F.ldsg = lds; F.in = args.in; F.out = args.out; F.ws = args.ws;
    const int wave_s = __builtin_amdgcn_readfirstlane((int)threadIdx.x >> 6); F.tid = 0; F.lane = 0; F.wave = wave_s; F.G = gridDim.x; F.bx = blockIdx.x;
    F.vcu = (F.G % 8 == 0) ? (F.bx % 8) * (F.G / 8) + F.bx / 8 : F.bx;
    const bool multi = (args.ph_hi - args.ph_lo) > 1;
    volatile LAS unsigned* bst = (volatile LAS unsigned*)(F.lds + LDS_BYTES - 64);
    if (threadIdx.x < 2) bst[threadIdx.x] = 0u;
    __syncthreads();
    XcdBarrier gbar; gbar.bar = (unsigned*)args.ws; gbar.x = 0; gbar.st = nullptr;
    if (multi) gbar = xcd_barrier_post((unsigned*)args.ws, bst);
    const int ph_lo_u = __builtin_amdgcn_readfirstlane(args.ph_lo), ph_hi_u = __builtin_amdgcn_readfirstlane(args.ph_hi);
    for (int ph = ph_lo_u; ph < ph_hi_u; ++ph) {
#define SETLANE() do { int l_; asm volatile("v_mbcnt_lo_u32_b32 %0, -1, 0\n\tv_mbcnt_hi_u32_b32 %0, -1, %0" : "=&v"(l_)); F.lane = l_; F.tid = wave_s * 64 + l_; F.wave = wave_s; } while (0)
        { int z_ = 0; asm volatile("s_mov_b32 %0, 0" : "=s"(z_)); F.ws = args.ws + z_; F.out = args.out + z_; F.in = args.in + z_; }
        float* mods = (float*)(F.ws + WS_MODS); float* ssq = (float*)(F.ws + WS_SSQ); float* cx = (float*)(F.ws + WS_CX); const float* rope = (const float*)(F.ws + WS_ROPE);
        bf16_t* XN = (bf16_t*)(F.ws + WS_XN); bf16_t* Z = (bf16_t*)(F.ws + WS_Z); bf16_t* Qb = (bf16_t*)(F.ws + WS_Q); bf16_t* Y = (bf16_t*)(F.ws + WS_Y); bf16_t* H = (bf16_t*)(F.ws + WS_H);
        float* ssqx = (float*)(F.ws + WS_SSQX); const float* shw = (const float*)(F.ws + WS_SHW); const float* stab = (const float*)(F.ws + WS_STAB);
        if (ph == 0) { if (PHM & 1) REPS(1) { SETLANE(); phase_prologue(F); } }
        else if (ph == 1) { if (PHM & 4) REPS(4) { SETLANE(); phase_norm0(F); } }
        else if (ph == 2 + 6 * DEPTH) { if (PHM & 2) REPS(2) { SETLANE(); phase_final_norm(F); } }
        else {
            const int l = (ph - 2) / 6, sub = (ph - 2) - 6 * l; const bool last = (l == DEPTH - 1); const float* mods_l = mods + (size_t)l * 9 * 6144;
            const int Mx = last ? TL : MALL;
            if (sub == 0) { if (PHM & 8) REPS(8) { SETLANE(); pg8::Gemm g{XN, (const bf16_t*)(F.ws + WS_WIN) + (size_t)l * ZP * D, MALL, ZP, D, D}; pg8::StaticOrder S; S.init(MALL, ZP, F.G, F.bx);
                pg8::EpiZ E{Z, ssq, ssqx, shw + (size_t)l * SHW_L}; pg8::gemm_phase<pg8::EpiZ, pg8::StaticOrder, true, true, 1024, 1024>(F.lds, g, S, E, F.tid); } }
            else if (sub == 1) {
                if (PHM & 16) REPS(16) { SETLANE(); pg8::Gemm g{Z, (const bf16_t*)(F.ws + WS_WUQ) + (size_t)l * 768 * 384, Mx, 768, 384, ZP}; pg8::StaticOrder S; S.init(Mx, 768, F.G, F.bx);
                  pg8::EpiQ E{Qb, ssq, rope}; pg8::gemm_phase<pg8::EpiQ, pg8::StaticOrder, true, true, 384, 1792>(F.lds, g, S, E, F.tid); }
                if (PHM & 32) REPS(32) { SETLANE(); pg8::Gemm g{Z + 384, (const bf16_t*)(F.ws + WS_WUKV) + (size_t)l * 1024 * 256, MALL, 1024, 256, ZP}; pg8::StaticOrder S; S.init(MALL, 1024, F.G, (F.bx - 24 + F.G) % F.G);
                  pg8::EpiKV E{(bf16_t*)(F.ws + WS_KN), (bf16_t*)(F.ws + WS_V), ssq}; pg8::gemm_phase<pg8::EpiKV, pg8::StaticOrder, true, true, 256, 1792>(F.lds, g, S, E, F.tid); }
                if (PHM & 64) REPS(64) { SETLANE(); phase_conv(F, l, Mx, 56); }
                if (PHM & 128) REPS(128) { SETLANE(); phase_sgu(F, l, Mx, 88); }
                if (PHM & 256) REPS(256) { SETLANE(); phase_krope(F); }
            }
            else if (sub == 2) { if (PHM & 512) REPS(512) { SETLANE(); phase_attn(F, !last); } }
            else if (sub == 3) { if (PHM & 1024) REPS(1024) { SETLANE(); pg8::Gemm g{Y, (const bf16_t*)(F.ws + WS_WOUT) + (size_t)l * D * D, Mx, D, D, D}; pg8::StaticOrder S; S.init(Mx, D, F.G, F.bx);
                pg8::EpiRes E{(bf16_t*)(F.ws + WS_XB), mods_l + 2048, XN, ssqx, stab + ((size_t)l * 2 + 1) * 9 * 1024};
                pg8::gemm_phase<pg8::EpiRes, pg8::StaticOrder, true, true, 1024, 1024>(F.lds, g, S, E, F.tid); } }
            else if (sub == 4) { if (PHM & 4096) REPS(4096) { SETLANE();
                unsigned* cnt = (unsigned*)F.ws + 3600 + 64 * l;
                const bf16_t* W1 = (const bf16_t*)(F.ws + WS_W1) + (size_t)l * DFF * D;
                if (!last) {
                    pg8::Gemm g{XN + (size_t)TL * D, W1, TC, DFF, D, D}; pg8::CountingOrder S; S.S.init(TC, DFF, F.G, F.bx); S.cnt = cnt;
                    pg8::EpiFF1 E{H, ssqx, shw + (size_t)l * SHW_L + 9 * SHW_IN, TL}; pg8::gemm_phase<pg8::EpiFF1, pg8::CountingOrder, true, true, 1024, 1024>(F.lds, g, S, E, F.tid); }
                {
                    pg8::Gemm g{XN, W1, TL, DFF, D, D}; pg8::StaticOrder S; S.init(TL, DFF, F.G, F.bx);
                    pg8::EpiFF1 E{H, ssqx, shw + (size_t)l * SHW_L + 9 * SHW_IN, 0}; pg8::gemm_phase<pg8::EpiFF1, pg8::StaticOrder, true, true, 1024, 1024>(F.lds, g, S, E, F.tid); }
                if (!last) {
                    const int q = F.bx - 128; const bool mine = q >= 0 && q < 128; const int ks = q >> 5, t = q & 31;
                    if (mine) {
                        if (F.tid == 0) { unsigned sp = 0; while (__hip_atomic_load(cnt, __ATOMIC_RELAXED, __HIP_MEMORY_SCOPE_AGENT) < 1024u) { __builtin_amdgcn_s_sleep(2); if (++sp > (1u << 22)) break; } }
                        __syncthreads(); __builtin_amdgcn_fence(__ATOMIC_ACQUIRE, "agent"); asm volatile("s_waitcnt vmcnt(0)" ::: "memory"); }
                    pg8::Gemm g{H + (size_t)TL * DFF + (mine ? ks : 0) * 1024, (const bf16_t*)(F.ws + WS_W2) + (size_t)l * D * DFF + (mine ? ks : 0) * 1024, TC, D, 1024, DFF};
                    pg8::OneUnit S{t >> 2, t & 3, mine};
                    pg8::EpiPart E{(float*)(F.ws + WS_PART) + (size_t)(mine ? ks : 0) * TC * D}; pg8::gemm_phase<pg8::EpiPart, pg8::OneUnit, true, true, 1024, 4096, 4096>(F.lds, g, S, E, F.tid); }
                } }
            else { if (PHM & 8192) REPS(8192) { SETLANE();
                if (!last) phase_ctx_finish(F, mods_l + 5120 + 8 * 6144, stab + ((size_t)(l + 1) * 2 + 0) * 9 * 1024 + 8 * 1024);
                pg8::Gemm g{H, (const bf16_t*)(F.ws + WS_W2) + (size_t)l * D * DFF, TL, D, DFF, DFF}; pg8::StaticOrder S; S.init(TL, D, F.G, F.bx, true);
                pg8::EpiRes E{(bf16_t*)(F.ws + WS_XB), mods_l + 5120, XN, ssqx, last ? (const float*)nullptr : stab + ((size_t)(l + 1) * 2 + 0) * 9 * 1024};
                pg8::gemm_phase<pg8::EpiRes, pg8::StaticOrder, true, true, 4096, 4096>(F.lds, g, S, E, F.tid); } }
        }
        if (ph + 1 < ph_hi_u) { if (ph == ph_lo_u) cg::this_grid().sync(); else xcd_barrier(gbar); }
    }
}

constexpr int NPHASES = 3 + 6 * DEPTH;
extern "C" void kernel_launch(void* const* d_in, const int* in_sizes, int n_in, void* d_out, int out_size, void* d_ws, size_t ws_size, hipStream_t stream) {
    static int grid = 0;
    if (grid == 0) {
        if (n_in != 25 || out_size != TL * D || ws_size < WS_END2) { fprintf(stderr, "kernel_launch: unexpected shapes: n_in %d out %d ws %zu (need %zu)\n", n_in, out_size, ws_size, (size_t)WS_END2); grid = -1; return; }
        int dev = 0, cus = 0, per_cu = 0;
        hipGetDevice(&dev); hipDeviceGetAttribute(&cus, hipDeviceAttributeMultiprocessorCount, dev);
        if (hipFuncSetAttribute((const void*)mega_fwd, hipFuncAttributeMaxDynamicSharedMemorySize, LDS_BYTES) != hipSuccess) { fprintf(stderr, "kernel_launch: hipFuncSetAttribute failed\n"); grid = -1; return; }
        if (hipOccupancyMaxActiveBlocksPerMultiprocessor(&per_cu, (const void*)mega_fwd, NTHREADS, LDS_BYTES) != hipSuccess || per_cu < 1) { fprintf(stderr, "kernel_launch: occupancy query says %d\n", per_cu); per_cu = 1; }
        (void)hipGetLastError();
        grid = cus * 1;
    }
    if (grid < 0) return;
    Args a{};
    for (int i = 0; i < 25; ++i) a.in[i] = (const float*)d_in[i];
    a.out = (float*)d_out; a.ws = (unsigned char*)d_ws;
#if ONE_LAUNCH
    if (hipMemsetAsync(d_ws, 0, 16384, stream) != hipSuccess) { fprintf(stderr, "kernel_launch: memset of barrier words failed\n"); return; }
    a.ph_lo = 0; a.ph_hi = NPHASES;
    void* kargs[] = {&a};
    hipError_t e = hipLaunchCooperativeKernel((const void*)mega_fwd, dim3(grid), dim3(NTHREADS), kargs, LDS_BYTES, stream);
    if (e != hipSuccess) fprintf(stderr, "cooperative launch failed: %s (grid %d)\n", hipGetErrorString(e), grid);
#else
    for (int ph = 0; ph < NPHASES; ++ph) { a.ph_lo = ph; a.ph_hi = ph + 1; hipLaunchKernelGGL(mega_fwd, dim3(grid), dim3(NTHREADS), LDS_BYTES, stream, a); }
#endif
}
```

```cpp
#include <hip/hip_runtime.h>
#include <hip/hip_bf16.h>
#include <hip/hip_cooperative_groups.h>
#include <cstdio>
#include <cstdint>
namespace cg = cooperative_groups;
#ifndef PHM
#define PHM 0xffff
#endif
#ifndef DUPM
#define DUPM 0
#endif
#define REPS(bit) for (int rep_ = 0, nrep_ = nrep_of((DUPM & (bit)) ? 2 : 1); rep_ < nrep_; ++rep_)
#ifndef ONE_LAUNCH
#define ONE_LAUNCH 1
#endif
typedef unsigned short bf16_t;
__device__ __forceinline__ float shx(float v, int o, int lane) { return __int_as_float(__builtin_amdgcn_ds_bpermute((lane ^ o) << 2, __float_as_int(v))); }
constexpr int T_LAT = 65536, ZP = 1792, LK = 8448;
namespace pg8 {
#define PG8_LAS __attribute__((address_space(3)))
typedef unsigned short bf16_t;
typedef short bf16x8 __attribute__((ext_vector_type(8)));
typedef float f32x4 __attribute__((ext_vector_type(4)));
typedef unsigned u32x4 __attribute__((ext_vector_type(4)));
constexpr int BM = 256, BK = 64, HALF = 128, HTB = HALF * BK * 2  , STAGE_BYTES = 8 * HTB, NXCD = 8, WGM = 8;

__host__ __device__ __forceinline__ int lds_byte(int r, int c) { const int st = (r >> 4) * 2 + (c >> 5), rr = r & 15, cc = c & 31, ob = rr * 64 + cc * 2; return st * 1024 + (ob ^ (((ob >> 9) & 1) << 5)); }
__host__ __device__ __forceinline__ void stage_rc(int b, int& R, int& C) { const int st = b / 1024, sb = b % 1024, swz = sb ^ (((sb >> 9) & 1) << 5); R = (st >> 1) * 16 + swz / 64; C = (st & 1) * 32 + (swz % 64) / 2; }
__host__ __device__ __forceinline__ int perm32(int rho) { const int n = rho >> 4, i = rho & 15; return 8 * (i >> 2) + 4 * n + (i & 3); }

struct Unit { int pm, pn; };
struct Gemm { const bf16_t* A; const bf16_t* Bt; int M, N, K, lda; };

struct StaticOrder {
    int nM, nN, nwg, G, c; bool rev;
    __host__ __device__ void init(int M, int N, int G_, int c_, bool rev_ = false) { nM = M / BM; nN = N / BM; nwg = nM * nN; G = G_; c = c_; rev = rev_; }
    __host__ __device__ bool next(int i, Unit& u) const {
        const long L = (long)i * G + c; if (L >= nwg) return false;
        int wgid = (int)L; { const int q = nwg / NXCD, r = nwg % NXCD, xcd = wgid % NXCD, off = wgid / NXCD; wgid = (xcd < r ? xcd * (q + 1) : r * (q + 1) + (xcd - r) * q) + off; }
        const int nig = WGM * nN, gid = wgid / nig, fm = gid * WGM, gsz = (nM - fm) < WGM ? (nM - fm) : WGM;
        u.pm = fm + ((wgid % nig) % gsz); u.pn = (wgid % nig) / gsz; if (rev) u.pm = nM - 1 - u.pm; return true;
    }
    __device__ __forceinline__ void a_ready(const Unit&) const {}
    __device__ __forceinline__ void done(const Unit&) const {}
};

struct OneUnit {
    int pm, pn; bool valid;
    __device__ __forceinline__ bool next(int i, Unit& u) const { if (i != 0 || !valid) return false; u.pm = pm; u.pn = pn; return true; }
    __device__ __forceinline__ void a_ready(const Unit&) const {}
    __device__ __forceinline__ void done(const Unit&) const {}
};
struct CountingOrder {
    StaticOrder S; unsigned* cnt;
    __device__ __forceinline__ bool next(int i, Unit& u) const { return S.next(i, u); }
    __device__ __forceinline__ void a_ready(const Unit&) const {}
    __device__ __forceinline__ void done(const Unit&) const {
        __builtin_amdgcn_fence(__ATOMIC_RELEASE, "agent"); asm volatile("s_waitcnt vmcnt(0)" ::: "memory");
        int ln_; asm volatile("v_mbcnt_lo_u32_b32 %0, -1, 0\n\tv_mbcnt_hi_u32_b32 %0, -1, %0" : "=&v"(ln_));
        if (ln_ == 0) __hip_atomic_fetch_add(cnt, 1u, __ATOMIC_RELAXED, __HIP_MEMORY_SCOPE_AGENT);
    }
};
__device__ __forceinline__ unsigned cvt_pk_bf16(float lo, float hi) { unsigned r; asm volatile("v_cvt_pk_bf16_f32 %0, %1, %2" : "=v"(r) : "v"(lo), "v"(hi)); return r; }
__device__ __forceinline__ u32x4 pack8(f32x4 v0, f32x4 v1) { u32x4 w; w.x = cvt_pk_bf16(v0[0], v0[1]); w.y = cvt_pk_bf16(v0[2], v0[3]); w.z = cvt_pk_bf16(v1[0], v1[1]); w.w = cvt_pk_bf16(v1[2], v1[3]); return w; }

__device__ __forceinline__ float sum_fq(float s) {
    { auto r = __builtin_amdgcn_permlane16_swap(__float_as_uint(s), __float_as_uint(s), false, false); s = __uint_as_float(r[0]) + __uint_as_float(r[1]); }
    { auto r = __builtin_amdgcn_permlane32_swap(__float_as_uint(s), __float_as_uint(s), false, false); s = __uint_as_float(r[0]) + __uint_as_float(r[1]); }
    return s;
}
__device__ __forceinline__ float row_rstd16_q(const float* ssqx, int row, int fq) {
    const f32x4 s0 = *(const f32x4*)(ssqx + (size_t)row * 16 + 4 * fq); float s = (s0[0] + s0[1]) + (s0[2] + s0[3]);
    { auto r = __builtin_amdgcn_permlane16_swap(__float_as_uint(s), __float_as_uint(s), false, false); s = __uint_as_float(r[0]) + __uint_as_float(r[1]); }
    { auto r = __builtin_amdgcn_permlane32_swap(__float_as_uint(s), __float_as_uint(s), false, false); s = __uint_as_float(r[0]) + __uint_as_float(r[1]); }
    return rsqrtf(s * (1.0f / 1024.0f) + 1e-6f);
}
__device__ __forceinline__ float row_rstd16(const float* ssqx, int row) {
    const f32x4* sp = (const f32x4*)(ssqx + (size_t)row * 16); const f32x4 s0 = sp[0], s1 = sp[1], s2 = sp[2], s3 = sp[3];
    const float ss = (((s0[0] + s0[1]) + (s0[2] + s0[3])) + ((s1[0] + s1[1]) + (s1[2] + s1[3]))) + (((s2[0] + s2[1]) + (s2[2] + s2[3])) + ((s3[0] + s3[1]) + (s3[2] + s3[3])));
    return rsqrtf(ss * (1.0f / 1024.0f) + 1e-6f);
}
struct EpiZ {
    static constexpr bool PERM = true, AFTER_DRAIN = false;
    bf16_t* Z; float* ssq; const float* ssqx; const float* shw;
    __device__ __forceinline__ void operator()(const f32x4 (&acc)[2][2][4][2], const Unit& u, int wr, int wc, int fr, int fq) const {
        const int row0 = u.pm * BM + wr * 64 + fr, col0 = u.pn * BM + wc * 32 + 8 * fq;
        const int mi = (u.pm * BM >= T_LAT) ? 8 : ((u.pm * BM) >> 13);
        float rs[2][4];
#pragma unroll
        for (int ai = 0; ai < 2; ++ai) {
#pragma unroll
            for (int m = 0; m < 4; ++m) { rs[ai][m] = row_rstd16_q(ssqx, row0 + ai * HALF + m * 16, fq); if (m & 1) asm volatile("" : "+v"(rs[ai][m - 1]), "+v"(rs[ai][m]) :: "memory"); } }
        f32x4 sw[2][2];
#pragma unroll
        for (int bj = 0; bj < 2; ++bj) { sw[bj][0] = *(const f32x4*)(shw + mi * 1792 + col0 + bj * HALF); sw[bj][1] = *(const f32x4*)(shw + mi * 1792 + col0 + bj * HALF + 4); }
#pragma unroll
        for (int ai = 0; ai < 2; ++ai)
#pragma unroll
            for (int m = 0; m < 4; ++m) { const int row = row0 + ai * HALF + m * 16; bf16_t* rowp = Z + (size_t)row * ZP + col0; const float r_ = rs[ai][m];
#pragma unroll
                for (int bj = 0; bj < 2; ++bj) { const f32x4 v0 = acc[ai][bj][m][0] * r_ + sw[bj][0], v1 = acc[ai][bj][m][1] * r_ + sw[bj][1];
                    *(u32x4*)(rowp + bj * HALF) = pack8(v0, v1);
                    const int hh = u.pn * 2 + bj;
                    if (hh < 5) { float s = (v0[0] * v0[0] + v0[1] * v0[1]) + (v0[2] * v0[2] + v0[3] * v0[3]) + (v1[0] * v1[0] + v1[1] * v1[1]) + (v1[2] * v1[2] + v1[3] * v1[3]);
                        s = sum_fq(s);
                        if (fq == 0) ssq[(size_t)row * 20 + hh * 4 + wc] = s; } }
                asm volatile("" ::: "memory"); }
    }
};
struct EpiQ {
    static constexpr bool PERM = true, AFTER_DRAIN = false;
    bf16_t* Q; const float* ssq; const float* rope;
    __device__ __forceinline__ void operator()(const f32x4 (&acc)[2][2][4][2], const Unit& u, int wr, int wc, int fr, int fq) const {
        const int row0 = u.pm * BM + wr * 64 + fr, col0 = u.pn * BM + wc * 32 + 8 * fq;
        float rsq[2][4];
#pragma unroll
        for (int ai = 0; ai < 2; ++ai) {
#pragma unroll
            for (int m = 0; m < 4; ++m) { f32x4 s0 = {0.f, 0.f, 0.f, 0.f}; if (fq < 3) s0 = *(const f32x4*)(ssq + (size_t)(row0 + ai * HALF + m * 16) * 20 + 4 * fq);
                const float ss = sum_fq((s0[0] + s0[1]) + (s0[2] + s0[3]));
                rsq[ai][m] = rsqrtf(ss * (1.0f / 384.0f) + 1e-6f) * 0.14724444653041276f;
                if (m & 1) asm volatile("" : "+v"(rsq[ai][m - 1]), "+v"(rsq[ai][m]) :: "memory"); } }
#pragma unroll
        for (int ai = 0; ai < 2; ++ai)
#pragma unroll
            for (int m = 0; m < 4; ++m) { const int row = row0 + ai * HALF + m * 16;
                const float rstd = rsq[ai][m];
                const bool lat = row < T_LAT; const int t = row & 8191;
#pragma unroll
                for (int bj = 0; bj < 2; ++bj) { const int c = col0 + bj * HALF; const int d = c % 96;
                    f32x4 v0 = acc[ai][bj][m][0] * rstd, v1 = acc[ai][bj][m][1] * rstd;
                    if (lat && d >= 64) { const int p0 = d - 64, g = p0 >> 4, j0 = (p0 & 15) >> 1; const int pos = g ? (t & 63) : (t >> 6);
                        const f32x4* tb = (const f32x4*)(rope + (pos * 8 + j0) * 2); const f32x4 c0 = tb[0], c1 = tb[1];
                        f32x4 r0, r1;
                        r0[0] = v0[0] * c0[0] - v0[1] * c0[1]; r0[1] = v0[1] * c0[0] + v0[0] * c0[1];
                        r0[2] = v0[2] * c0[2] - v0[3] * c0[3]; r0[3] = v0[3] * c0[2] + v0[2] * c0[3];
                        r1[0] = v1[0] * c1[0] - v1[1] * c1[1]; r1[1] = v1[1] * c1[0] + v1[0] * c1[1];
                        r1[2] = v1[2] * c1[2] - v1[3] * c1[3]; r1[3] = v1[3] * c1[2] + v1[2] * c1[3];
                        v0 = r0; v1 = r1; }
                    *(u32x4*)(Q + (size_t)row * 768 + c) = pack8(v0, v1); }
                asm volatile("" ::: "memory"); }
    }
};
struct EpiKV {
    static constexpr bool PERM = true, AFTER_DRAIN = false;
    bf16_t* KN; bf16_t* V; const float* ssq;
    __device__ __forceinline__ void operator()(const f32x4 (&acc)[2][2][4][2], const Unit& u, int wr, int wc, int fr, int fq) const {
        const int row0 = u.pm * BM + wr * 64 + fr; const int d = (wc & 1) * 32 + 8 * fq; bf16_t* dst = (wc < 2) ? KN : V;
        float rsq[2][4];
#pragma unroll
        for (int ai = 0; ai < 2; ++ai)
#pragma unroll
            for (int m = 0; m < 4; ++m) { f32x4 s0 = {0.f, 0.f, 0.f, 0.f}; if (fq < 2) s0 = *(const f32x4*)(ssq + (size_t)(row0 + ai * HALF + m * 16) * 20 + 12 + 4 * fq);
                const float ss = sum_fq((s0[0] + s0[1]) + (s0[2] + s0[3]));
                rsq[ai][m] = rsqrtf(ss * (1.0f / 256.0f) + 1e-6f); if (m == 3) asm volatile("" : "+v"(rsq[ai][0]), "+v"(rsq[ai][1]), "+v"(rsq[ai][2]), "+v"(rsq[ai][3]) :: "memory"); }
#pragma unroll
        for (int ai = 0; ai < 2; ++ai)
#pragma unroll
            for (int m = 0; m < 4; ++m) { const int row = row0 + ai * HALF + m * 16;
                const float rstd = rsq[ai][m];
                int b, kpos; if (row < T_LAT) { b = row >> 13; kpos = 256 + (row & 8191); } else { const int rc = row - T_LAT; b = rc >> 8; kpos = rc & 255; }
#pragma unroll
                for (int bj = 0; bj < 2; ++bj) { const int head = u.pn * 2 + bj;
                    const f32x4 v0 = acc[ai][bj][m][0] * rstd, v1 = acc[ai][bj][m][1] * rstd;
                    *(u32x4*)(dst + ((size_t)(b * 8 + head) * LK + kpos) * 64 + d) = pack8(v0, v1); }
                asm volatile("" ::: "memory"); }
    }
};
struct EpiRes {
    static constexpr bool PERM = true, AFTER_DRAIN = false;
    bf16_t* XB; const float* gate;
    bf16_t* XS; float* ssqx; const float* stab;
    __device__ __forceinline__ void operator()(const f32x4 (&acc)[2][2][4][2], const Unit& u, int wr, int wc, int fr, int fq) const {
        const int trow = u.pm * BM; const int mi = (trow >= T_LAT) ? 8 : (trow >> 13);
        const int row0 = trow + wr * 64 + fr, col0 = u.pn * BM + wc * 32 + 8 * fq;
        f32x4 gv[2][2];
#pragma unroll
        for (int bj = 0; bj < 2; ++bj) { gv[bj][0] = *(const f32x4*)(gate + mi * 6144 + col0 + bj * HALF); gv[bj][1] = *(const f32x4*)(gate + mi * 6144 + col0 + bj * HALF + 4); }
        f32x4 tv[2][2] = {};
        if (stab) {
#pragma unroll
            for (int bj = 0; bj < 2; ++bj) { tv[bj][0] = *(const f32x4*)(stab + mi * 1024 + col0 + bj * HALF); tv[bj][1] = *(const f32x4*)(stab + mi * 1024 + col0 + bj * HALF + 4); } }
#pragma unroll
        for (int ai = 0; ai < 2; ++ai) {
            u32x4 xv[4][2];
#pragma unroll
            for (int m = 0; m < 4; ++m) { const size_t off = (size_t)(row0 + ai * HALF + m * 16) * 1024 + col0;
#pragma unroll
                for (int bj = 0; bj < 2; ++bj) xv[m][bj] = *(const u32x4*)(XB + off + bj * HALF); }
#pragma unroll
            for (int m = 0; m < 4; ++m) { const size_t off = (size_t)(row0 + ai * HALF + m * 16) * 1024 + col0;
                float sq = 0.f;
#pragma unroll
                for (int bj = 0; bj < 2; ++bj) { const u32x4 xr = xv[m][bj];
                    const f32x4 x0 = {__uint_as_float(xr[0] << 16), __uint_as_float(xr[0] & 0xffff0000u), __uint_as_float(xr[1] << 16), __uint_as_float(xr[1] & 0xffff0000u)};
                    const f32x4 x1 = {__uint_as_float(xr[2] << 16), __uint_as_float(xr[2] & 0xffff0000u), __uint_as_float(xr[3] << 16), __uint_as_float(xr[3] & 0xffff0000u)};
                    const f32x4 y0 = x0 + gv[bj][0] * acc[ai][bj][m][0], y1 = x1 + gv[bj][1] * acc[ai][bj][m][1];
                    *(u32x4*)(XB + off + bj * HALF) = pack8(y0, y1);
                    if (stab) { *(u32x4*)(XS + off + bj * HALF) = pack8(y0 * tv[bj][0], y1 * tv[bj][1]);
                        sq += ((y0[0] * y0[0] + y0[1] * y0[1]) + (y0[2] * y0[2] + y0[3] * y0[3])) + ((y1[0] * y1[0] + y1[1] * y1[1]) + (y1[2] * y1[2] + y1[3] * y1[3])); } }
                if (stab) { sq = sum_fq(sq); if (fq == 0) ssqx[(size_t)(row0 + ai * HALF + m * 16) * 16 + u.pn * 4 + wc] = sq; } }
            asm volatile("" ::: "memory"); }
    }
};
struct EpiPart {
    static constexpr bool PERM = true, AFTER_DRAIN = false;
    float* P;
    __device__ __forceinline__ void operator()(const f32x4 (&acc)[2][2][4][2], const Unit& u, int wr, int wc, int fr, int fq) const {
        const int row0 = u.pm * BM + wr * 64 + fr, col0 = u.pn * BM + wc * 32 + 8 * fq;
#pragma unroll
        for (int ai = 0; ai < 2; ++ai)
#pragma unroll
            for (int m = 0; m < 4; ++m) { float* rowp = P + (size_t)(row0 + ai * HALF + m * 16) * 1024 + col0;
#pragma unroll
                for (int bj = 0; bj < 2; ++bj) { *(f32x4*)(rowp + bj * HALF) = acc[ai][bj][m][0]; *(f32x4*)(rowp + bj * HALF + 4) = acc[ai][bj][m][1]; }
                asm volatile("" ::: "memory"); }
    }
};
struct EpiFF1 {
    static constexpr bool PERM = true, AFTER_DRAIN = false;
    bf16_t* H; const float* ssqx; const float* shw; int row_base;
    __device__ __forceinline__ void operator()(const f32x4 (&acc)[2][2][4][2], const Unit& u, int wr, int wc, int fr, int fq) const {
        const int row0 = row_base + u.pm * BM + wr * 64 + fr, col0 = u.pn * BM + wc * 32 + 8 * fq;
        const int mi = (row_base + u.pm * BM >= T_LAT) ? 8 : ((row_base + u.pm * BM) >> 13);
        f32x4 sw[2][2];
#pragma unroll
        for (int bj = 0; bj < 2; ++bj) { sw[bj][0] = *(const f32x4*)(shw + mi * 4096 + col0 + bj * HALF); sw[bj][1] = *(const f32x4*)(shw + mi * 4096 + col0 + bj * HALF + 4); }
        float rsv[2][4];
#pragma unroll
        for (int ai = 0; ai < 2; ++ai) {
#pragma unroll
            for (int m = 0; m < 4; ++m) { rsv[ai][m] = row_rstd16_q(ssqx, row0 + ai * HALF + m * 16, fq); if (m & 1) asm volatile("" : "+v"(rsv[ai][m - 1]), "+v"(rsv[ai][m]) :: "memory"); } }
#pragma unroll
        for (int ai = 0; ai < 2; ++ai)
#pragma unroll
            for (int m = 0; m < 4; ++m) { const int row = row0 + ai * HALF + m * 16; bf16_t* rowp = H + (size_t)row * 4096 + col0; const float rs = rsv[ai][m];
#pragma unroll
                for (int bj = 0; bj < 2; ++bj) { f32x4 v0 = acc[ai][bj][m][0] * rs + sw[bj][0], v1 = acc[ai][bj][m][1] * rs + sw[bj][1];
#pragma unroll
                    for (int e = 0; e < 4; ++e) { const float a = fmaxf(v0[e], 0.f), b = fmaxf(v1[e], 0.f); v0[e] = a * a; v1[e] = b * b; }
                    *(u32x4*)(rowp + bj * HALF) = pack8(v0, v1); }
                asm volatile("" ::: "memory"); }
    }
};
template <class Epi, class Sched, bool ALIGN_EPI, bool SP2, int KC, int LDAC, int LDBC = KC>
__device__ __forceinline__ void gemm_phase(PG8_LAS unsigned char* lds, const Gemm g, const Sched& S, const Epi& E, int tid_in) {
    int tid_l = tid_in; asm volatile("" : "+v"(tid_l));
    const int tid = tid_l, wid = __builtin_amdgcn_readfirstlane(tid >> 6), lane = tid & 63, wr = wid >> 2, wc = wid & 3, fr = lane & 15, fq = lane >> 4;
    constexpr int K = KC, nt = KC / BK;
    unsigned voffA[2], voffB[2];
#pragma unroll
    for (int i = 0; i < 2; ++i) { int R, C; stage_rc(tid * 16 + i * 8192, R, C); const int Rb = Epi::PERM ? ((R & ~31) + perm32(R & 31)) : R;
        voffA[i] = (unsigned)(R * LDAC + C) * 2u; voffB[i] = (unsigned)(Rb * LDBC + C) * 2u; }
    constexpr size_t kstep = (size_t)(BK * 2);
    constexpr size_t hstepA = (size_t)HALF * LDAC * 2, hstepB = (size_t)HALF * LDBC * 2;
    constexpr size_t tstepA = 2 * hstepA, tstepB = 2 * hstepB;
    const unsigned ldsw = (unsigned)wid * 1024u;
    const int aoff = lds_byte(wr * 64 + fr, fq * 8), boff = lds_byte(wc * 32 + fr, fq * 8);
#define PG8_SA(b, h) (((b) * 2 + (h)) * HTB)
#define PG8_SB(b, h) ((4 + (b) * 2 + (h)) * HTB)
#define PG8_STAGE(bufoff, gbase, voff) do { _Pragma("unroll") for (int _i = 0; _i < 2; ++_i) \
        __builtin_amdgcn_global_load_lds((const unsigned*)((const char*)(gbase) + (voff)[_i]), (PG8_LAS unsigned*)(lds + (bufoff) + ldsw + _i * 8192), 16, 0, 0); } while (0)
#define PG8_LDA(dst, b, h) do { _Pragma("unroll") for (int m = 0; m < 4; ++m) _Pragma("unroll") for (int k = 0; k < 2; ++k) dst[m][k] = *(const PG8_LAS bf16x8*)(lds + PG8_SA(b, h) + aoff + m * 2048 + k * 1024); } while (0)
#define PG8_LDB(dst, b, h) do { _Pragma("unroll") for (int n = 0; n < 2; ++n) _Pragma("unroll") for (int k = 0; k < 2; ++k) dst[n][k] = *(const PG8_LAS bf16x8*)(lds + PG8_SB(b, h) + boff + n * 2048 + k * 1024); } while (0)
#define PG8_MMA(ai, bj, At, Bt) do { __builtin_amdgcn_s_setprio(1); _Pragma("unroll") for (int m = 0; m < 4; ++m) _Pragma("unroll") for (int n = 0; n < 2; ++n) _Pragma("unroll") for (int k = 0; k < 2; ++k) \
        acc[ai][bj][m][n] = __builtin_amdgcn_mfma_f32_16x16x32_bf16(Bt[n][k], At[m][k], acc[ai][bj][m][n], 0, 0, 0); __builtin_amdgcn_s_setprio(0); } while (0)
#define PG8_WAIT_V(n) asm volatile("s_waitcnt vmcnt(" #n ")" ::: "memory")
#define PG8_WAIT_L(n) asm volatile("s_waitcnt lgkmcnt(" #n ")" ::: "memory")
#define PG8_BAR __builtin_amdgcn_s_barrier()
#define PG8_SCHED __builtin_amdgcn_sched_barrier(0)
    Unit cur, nxt; int ui = 0;
    if (!S.next(0, cur)) return;
    f32x4 acc[2][2][4][2];
#pragma unroll
    for (int a = 0; a < 2; ++a)
#pragma unroll
        for (int b = 0; b < 2; ++b)
#pragma unroll
            for (int m = 0; m < 4; ++m)
#pragma unroll
                for (int n = 0; n < 2; ++n) acc[a][b][m][n] = (f32x4){0.f, 0.f, 0.f, 0.f};
    bf16x8 At[4][2], B0[2][2], B1[2][2];
    const char* cA = (const char*)g.A + (size_t)cur.pm * tstepA; const char* cB = (const char*)g.Bt + (size_t)cur.pn * tstepB;
    S.a_ready(cur);
    if constexpr (SP2) {
        PG8_STAGE(PG8_SB(0, 0), cB, voffB); PG8_STAGE(PG8_SB(0, 1), cB + hstepB, voffB); PG8_STAGE(PG8_SA(0, 0), cA, voffA); PG8_STAGE(PG8_SA(0, 1), cA + hstepA, voffA);
        if (wr == 1) PG8_BAR;
        PG8_WAIT_V(2); PG8_BAR;
        PG8_STAGE(PG8_SB(1, 0), cB + kstep, voffB); PG8_STAGE(PG8_SA(1, 0), cA + kstep, voffA); PG8_STAGE(PG8_SB(1, 1), cB + hstepB + kstep, voffB);
        PG8_WAIT_V(6); PG8_BAR;
    } else {
        PG8_STAGE(PG8_SB(0, 0), cB, voffB); PG8_STAGE(PG8_SA(0, 0), cA, voffA); PG8_STAGE(PG8_SB(0, 1), cB + hstepB, voffB); PG8_STAGE(PG8_SA(0, 1), cA + hstepA, voffA);
        if (wr == 1) PG8_BAR;
        PG8_WAIT_V(4); PG8_BAR;
        PG8_STAGE(PG8_SB(1, 0), cB + kstep, voffB); PG8_STAGE(PG8_SA(1, 0), cA + kstep, voffA); PG8_STAGE(PG8_SB(1, 1), cB + hstepB + kstep, voffB);
        PG8_WAIT_V(6); PG8_BAR;
    }
    for (;;) {
        const bool has_next = S.next(ui + 1, nxt);
        const char* nA = has_next ? (const char*)g.A + (size_t)nxt.pm * tstepA : cA; const char* nB = has_next ? (const char*)g.Bt + (size_t)nxt.pn * tstepB : cB;
        for (int t = 0; t < nt; t += 2) {
            const bool last = (t == nt - 2);
            const char* a1 = cA + (size_t)(t + 1) * kstep;
            const char* a2 = last ? nA : cA + (size_t)(t + 2) * kstep; const char* b2 = last ? nB : cB + (size_t)(t + 2) * kstep;
            const char* a3 = a2 + kstep; const char* b3 = b2 + kstep;
            if (last && has_next) S.a_ready(nxt);
            if constexpr (SP2) {
            PG8_LDB(B0, 0, 0); PG8_LDB(B1, 0, 1); PG8_SCHED; PG8_LDA(At, 0, 0); PG8_STAGE(PG8_SA(1, 1), a1 + hstepA, voffA);
            PG8_WAIT_V(8); PG8_WAIT_L(0); PG8_BAR; PG8_MMA(0, 0, At, B0); PG8_MMA(0, 1, At, B1); PG8_BAR; PG8_SCHED;
            PG8_LDA(At, 0, 1); PG8_STAGE(PG8_SB(0, 0), b2, voffB); PG8_STAGE(PG8_SB(0, 1), b2 + hstepB, voffB); PG8_STAGE(PG8_SA(0, 0), a2, voffA);
            PG8_WAIT_V(8); PG8_WAIT_L(0); PG8_BAR; PG8_MMA(1, 0, At, B0); PG8_MMA(1, 1, At, B1); PG8_BAR; PG8_SCHED;
            PG8_LDB(B0, 1, 0); PG8_LDB(B1, 1, 1); PG8_SCHED; PG8_LDA(At, 1, 0); PG8_STAGE(PG8_SA(0, 1), a2 + hstepA, voffA);
            PG8_WAIT_V(8); PG8_WAIT_L(0); PG8_BAR; PG8_MMA(0, 0, At, B0); PG8_MMA(0, 1, At, B1); PG8_BAR; PG8_SCHED;
            PG8_LDA(At, 1, 1); PG8_STAGE(PG8_SB(1, 0), b3, voffB); PG8_STAGE(PG8_SB(1, 1), b3 + hstepB, voffB); PG8_STAGE(PG8_SA(1, 0), a3, voffA);
            PG8_WAIT_V(8); PG8_WAIT_L(0); PG8_BAR; PG8_MMA(1, 0, At, B0); PG8_MMA(1, 1, At, B1); PG8_BAR; PG8_SCHED;
            } else {
            PG8_LDB(B0, 0, 0); PG8_SCHED; PG8_LDA(At, 0, 0); PG8_STAGE(PG8_SA(1, 1), a1 + hstepA, voffA);
            PG8_WAIT_L(8); PG8_BAR; PG8_WAIT_L(0); PG8_MMA(0, 0, At, B0); PG8_BAR; PG8_SCHED;
            PG8_LDB(B1, 0, 1); PG8_STAGE(PG8_SB(0, 0), b2, voffB);
            PG8_BAR; PG8_WAIT_L(0); PG8_MMA(0, 1, At, B1); PG8_BAR;
            PG8_LDA(At, 0, 1); PG8_STAGE(PG8_SA(0, 0), a2, voffA);
            PG8_BAR; PG8_WAIT_L(0); PG8_MMA(1, 0, At, B0); PG8_BAR; PG8_SCHED;
            PG8_STAGE(PG8_SB(0, 1), b2 + hstepB, voffB);
            PG8_WAIT_V(6); PG8_BAR; PG8_MMA(1, 1, At, B1); PG8_BAR;
            PG8_LDB(B0, 1, 0); PG8_SCHED; PG8_LDA(At, 1, 0); PG8_STAGE(PG8_SA(0, 1), a2 + hstepA, voffA);
            PG8_WAIT_L(8); PG8_BAR; PG8_WAIT_L(0); PG8_MMA(0, 0, At, B0); PG8_BAR; PG8_SCHED;
            PG8_LDB(B1, 1, 1); PG8_STAGE(PG8_SB(1, 0), b3, voffB);
            PG8_BAR; PG8_WAIT_L(0); PG8_MMA(0, 1, At, B1); PG8_BAR;
            PG8_LDA(At, 1, 1); PG8_STAGE(PG8_SA(1, 0), a3, voffA);
            PG8_BAR; PG8_WAIT_L(0); PG8_MMA(1, 0, At, B0); PG8_BAR; PG8_SCHED;
            PG8_STAGE(PG8_SB(1, 1), b3 + hstepB, voffB);
            PG8_WAIT_V(6); PG8_BAR; PG8_MMA(1, 1, At, B1); PG8_BAR;
            }
        }
        if constexpr (ALIGN_EPI) { if (wr == 0) PG8_BAR; }
        if constexpr (!Epi::AFTER_DRAIN) { Unit ue = cur; int ln_; asm volatile("v_mbcnt_lo_u32_b32 %0, -1, 0\n\tv_mbcnt_hi_u32_b32 %0, -1, %0" : "=&v"(ln_), "+s"(ue.pm), "+s"(ue.pn)); E(acc, ue, wr, wc, ln_ & 15, ln_ >> 4); S.done(cur); }
        if (!has_next) break;
#pragma unroll
        for (int a = 0; a < 2; ++a)
#pragma unroll
            for (int b = 0; b < 2; ++b)
#pragma unroll
                for (int m = 0; m < 4; ++m)
#pragma unroll
                    for (int n = 0; n < 2; ++n) acc[a][b][m][n] = (f32x4){0.f, 0.f, 0.f, 0.f};
        cur = nxt; cA = nA; cB = nB; ++ui;
        if constexpr (ALIGN_EPI) { if (wr == 1) PG8_BAR; }
    }
    PG8_WAIT_V(0);
    if constexpr (!ALIGN_EPI) { if (wr == 0) PG8_BAR; }
    PG8_BAR;
    if constexpr (Epi::AFTER_DRAIN) { E.fused(acc, cur, wr, wc, fr, fq, lds, wid, lane); S.done(cur); }
#undef PG8_SA
#undef PG8_SB
#undef PG8_STAGE
#undef PG8_LDA
#undef PG8_LDB
#undef PG8_MMA
#undef PG8_WAIT_V
#undef PG8_WAIT_L
#undef PG8_BAR
#undef PG8_SCHED
}
}
namespace att {
using bf16x8 = __attribute__((ext_vector_type(8))) short;
using s16x4  = __attribute__((ext_vector_type(4))) short;
using f32x16 = __attribute__((ext_vector_type(16))) float;
using u32x4  = __attribute__((ext_vector_type(4))) unsigned;
constexpr int NW = 8, QBLK = 32, KVBLK = 64;
constexpr float SCALE = 0.10206207261596575f;
constexpr float THR2 = 11.0f;
constexpr int SHM_V = KVBLK * 64 * 2, SHM_K = KVBLK * 208, SHM_ATTN = 3 * SHM_V + 2 * SHM_K + NW * 64 * 4;
#define KSWZ(row, colB) ((row) * 208 + (colB))
#define SBAR() __builtin_amdgcn_sched_barrier(0)
__device__ __forceinline__ int crow(int r, int hi) { return (r & 3) + 8 * (r >> 2) + 4 * hi; }
__device__ __forceinline__ unsigned cvtpk(float lo, float hi) { unsigned r; asm volatile("v_cvt_pk_bf16_f32 %0, %1, %2" : "=v"(r) : "v"(lo), "v"(hi)); return r; }
#define MX3(a, b, c) __builtin_fmaxf(__builtin_fmaxf((a), (b)), (c))
template <bool FIRST>
__device__ __forceinline__ void partialSM(f32x16& p0, f32x16& p1, float& m_reg, f32x16& negm, float& alpha) {
  float a = MX3(p0[0], p0[1], p1[0]), b = MX3(p0[2], p0[3], p1[1]); a = MX3(a, p1[2], p1[3]);
#pragma unroll
  for (int r = 4; r < 16; r += 4) { a = MX3(a, p0[r], p0[r + 1]); b = MX3(b, p0[r + 2], p0[r + 3]); a = MX3(a, p1[r], p1[r + 1]); b = MX3(b, p1[r + 2], p1[r + 3]); }
  float pmax = __builtin_fmaxf(a, b);
  { auto rr = __builtin_amdgcn_permlane32_swap(__float_as_uint(pmax), __float_as_uint(pmax), false, false);
    pmax = __builtin_fmaxf(__uint_as_float(rr[0]), __uint_as_float(rr[1])); }
  alpha = 1.f;
  if (FIRST || __builtin_expect(__any(pmax > THR2), 0)) {
    const float dl = FIRST ? pmax : __builtin_fmaxf(pmax, 0.f); m_reg += dl;
#pragma unroll
    for (int r = 0; r < 16; ++r) { p0[r] -= dl; p1[r] -= dl; }
#pragma unroll
    for (int r = 0; r < 16; ++r) negm[r] = -m_reg;
    if (!FIRST) alpha = __builtin_amdgcn_exp2f(-dl);
  }
#pragma unroll
  for (int r = 0; r < 16; ++r) p0[r] = __builtin_amdgcn_exp2f(p0[r]);
}
__device__ __forceinline__ void finishSM(f32x16& p0, f32x16& p1, float& l_reg, bf16x8& pa0, bf16x8& pa1, bf16x8& pa2, bf16x8& pa3) {
#pragma unroll
  for (int r = 0; r < 16; ++r) { p0[r] = __builtin_amdgcn_exp2f(p0[r]); p1[r] = __builtin_amdgcn_exp2f(p1[r]); }
#pragma unroll
  for (int r = 0; r < 16; ++r) l_reg += p0[r] + p1[r];
#define PK4(P, BASE, OUT) do { u32x4 w = {cvtpk(P[BASE + 0], P[BASE + 1]), cvtpk(P[BASE + 2], P[BASE + 3]), cvtpk(P[BASE + 4], P[BASE + 5]), cvtpk(P[BASE + 6], P[BASE + 7])}; OUT = *reinterpret_cast<bf16x8*>(&w); } while (0)
  PK4(p0, 0, pa0); PK4(p0, 8, pa1); PK4(p1, 0, pa2); PK4(p1, 8, pa3);
#undef PK4
}
__device__ __forceinline__ void qkt(f32x16& p0, f32x16& p1, const char* Ks, const bf16x8* qr, const f32x16& negm, int r32, int hi) {
#pragma unroll
  for (int d0 = 0; d0 < 6; ++d0) { int cb = (d0 * 16 + hi * 8) * 2;
    bf16x8 b0 = *reinterpret_cast<const bf16x8*>(Ks + KSWZ(r32, cb));
    bf16x8 b1 = *reinterpret_cast<const bf16x8*>(Ks + KSWZ(32 + r32, cb));
    if (d0 == 0) { p0 = __builtin_amdgcn_mfma_f32_32x32x16_bf16(b0, qr[0], negm, 0, 0, 0); p1 = __builtin_amdgcn_mfma_f32_32x32x16_bf16(b1, qr[0], negm, 0, 0, 0); }
    else { p0 = __builtin_amdgcn_mfma_f32_32x32x16_bf16(b0, qr[d0], p0, 0, 0, 0); p1 = __builtin_amdgcn_mfma_f32_32x32x16_bf16(b1, qr[d0], p1, 0, 0, 0); } }
}
__device__ __forceinline__ int v_st(int k, int c) { const int kk = (k & ~0xC) | ((k & 4) << 1) | ((k & 8) >> 1); return ((kk >> 3) * 2 + (c >> 5)) * 512 + ((kk & 7) * 32 + (c & 31)) * 2; }
__device__ __forceinline__ int v_st_nat(int k, int c) { return ((k >> 3) * 2 + (c >> 5)) * 512 + ((k & 7) * 32 + (c & 31)) * 2; }
__device__ __forceinline__ int v_rd_base(int lane) { return ((lane & 3) << 3) | (((lane >> 2) & 3) << 6) | (((lane >> 4) & 1) << 5) | (((lane >> 5) & 1) << 8); }
constexpr int v_rd_off(int d0, int ks, int half) { return d0 * 512 + ks * 2048 + half * 1024; }
template <int OFF> __device__ __forceinline__ s16x4 tr_read(int vb) {
  s16x4 r; asm volatile("ds_read_b64_tr_b16 %0, %1 offset:%2" : "=&v"(r) : "v"(vb), "i"(OFF) : "memory"); return r;
}
template <int D0> __device__ __forceinline__ void pv_one(f32x16& od, int vb, bf16x8 pa0, bf16x8 pa1, bf16x8 pa2, bf16x8 pa3) {
  const s16x4 l0 = tr_read<v_rd_off(D0, 0, 0)>(vb), h0 = tr_read<v_rd_off(D0, 0, 1)>(vb), l1 = tr_read<v_rd_off(D0, 1, 0)>(vb), h1 = tr_read<v_rd_off(D0, 1, 1)>(vb);
  const s16x4 l2 = tr_read<v_rd_off(D0, 2, 0)>(vb), h2 = tr_read<v_rd_off(D0, 2, 1)>(vb), l3 = tr_read<v_rd_off(D0, 3, 0)>(vb), h3 = tr_read<v_rd_off(D0, 3, 1)>(vb);
  asm volatile("s_waitcnt lgkmcnt(0)" ::: "memory"); SBAR();
#define PK(L, H) (bf16x8){L[0], L[1], L[2], L[3], H[0], H[1], H[2], H[3]}
  od = __builtin_amdgcn_mfma_f32_32x32x16_bf16(pa0, PK(l0, h0), od, 0, 0, 0);
  od = __builtin_amdgcn_mfma_f32_32x32x16_bf16(pa1, PK(l1, h1), od, 0, 0, 0);
  od = __builtin_amdgcn_mfma_f32_32x32x16_bf16(pa2, PK(l2, h2), od, 0, 0, 0);
  od = __builtin_amdgcn_mfma_f32_32x32x16_bf16(pa3, PK(l3, h3), od, 0, 0, 0);
}
__device__ __forceinline__ void pv_d0(f32x16* o, int vb, bf16x8 ones, bf16x8 pa0, bf16x8 pa1, bf16x8 pa2, bf16x8 pa3) {
  s16x4 a0 = tr_read<v_rd_off(0, 0, 0)>(vb), b0 = tr_read<v_rd_off(0, 0, 1)>(vb), c0 = tr_read<v_rd_off(1, 0, 0)>(vb), d0 = tr_read<v_rd_off(1, 0, 1)>(vb);
  s16x4 a1 = tr_read<v_rd_off(0, 1, 0)>(vb), b1 = tr_read<v_rd_off(0, 1, 1)>(vb), c1 = tr_read<v_rd_off(1, 1, 0)>(vb), d1 = tr_read<v_rd_off(1, 1, 1)>(vb);
  s16x4 a2 = tr_read<v_rd_off(0, 2, 0)>(vb), b2 = tr_read<v_rd_off(0, 2, 1)>(vb), c2 = tr_read<v_rd_off(1, 2, 0)>(vb), d2 = tr_read<v_rd_off(1, 2, 1)>(vb);
  s16x4 a3 = tr_read<v_rd_off(0, 3, 0)>(vb), b3 = tr_read<v_rd_off(0, 3, 1)>(vb), c3 = tr_read<v_rd_off(1, 3, 0)>(vb), d3 = tr_read<v_rd_off(1, 3, 1)>(vb);
  asm volatile("s_waitcnt lgkmcnt(0)" : "+v"(a0), "+v"(b0), "+v"(c0), "+v"(d0), "+v"(a1), "+v"(b1), "+v"(c1), "+v"(d1), "+v"(a2), "+v"(b2), "+v"(c2), "+v"(d2), "+v"(a3), "+v"(b3), "+v"(c3), "+v"(d3) :: "memory");
  o[2] = __builtin_amdgcn_mfma_f32_32x32x16_bf16(pa0, ones, o[2], 0, 0, 0); o[0] = __builtin_amdgcn_mfma_f32_32x32x16_bf16(pa0, PK(a0, b0), o[0], 0, 0, 0); o[1] = __builtin_amdgcn_mfma_f32_32x32x16_bf16(pa0, PK(c0, d0), o[1], 0, 0, 0);
  o[2] = __builtin_amdgcn_mfma_f32_32x32x16_bf16(pa1, ones, o[2], 0, 0, 0); o[0] = __builtin_amdgcn_mfma_f32_32x32x16_bf16(pa1, PK(a1, b1), o[0], 0, 0, 0); o[1] = __builtin_amdgcn_mfma_f32_32x32x16_bf16(pa1, PK(c1, d1), o[1], 0, 0, 0);
  o[2] = __builtin_amdgcn_mfma_f32_32x32x16_bf16(pa2, ones, o[2], 0, 0, 0); o[0] = __builtin_amdgcn_mfma_f32_32x32x16_bf16(pa2, PK(a2, b2), o[0], 0, 0, 0); o[1] = __builtin_amdgcn_mfma_f32_32x32x16_bf16(pa2, PK(c2, d2), o[1], 0, 0, 0);
  o[2] = __builtin_amdgcn_mfma_f32_32x32x16_bf16(pa3, ones, o[2], 0, 0, 0); o[0] = __builtin_amdgcn_mfma_f32_32x32x16_bf16(pa3, PK(a3, b3), o[0], 0, 0, 0); o[1] = __builtin_amdgcn_mfma_f32_32x32x16_bf16(pa3, PK(c3, d3), o[1], 0, 0, 0);
#undef PK
}
template <int OFF> __device__ __forceinline__ bf16x8 rd128(int addr) { bf16x8 r; asm volatile("ds_read_b128 %0, %1 offset:%2" : "=v"(r) : "v"(addr), "i"(OFF) : "memory"); return r; }
#define WAIT4(a, b, c, d) asm volatile("s_waitcnt lgkmcnt(0)" : "+v"(a), "+v"(b), "+v"(c), "+v"(d) :: "memory")
#define EXP4(P, B) do { P[B] = __builtin_amdgcn_exp2f(P[B]); P[B + 1] = __builtin_amdgcn_exp2f(P[B + 1]); P[B + 2] = __builtin_amdgcn_exp2f(P[B + 2]); P[B + 3] = __builtin_amdgcn_exp2f(P[B + 3]); } while (0)
struct VFr { s16x4 a0, b0, c0, d0, a1, b1, c1, d1; };
template <int KS0> __device__ __forceinline__ void vfr_issue(VFr& f, int vb) {
  f.a0 = tr_read<v_rd_off(0, KS0, 0)>(vb); f.b0 = tr_read<v_rd_off(0, KS0, 1)>(vb); f.c0 = tr_read<v_rd_off(1, KS0, 0)>(vb); f.d0 = tr_read<v_rd_off(1, KS0, 1)>(vb);
  f.a1 = tr_read<v_rd_off(0, KS0 + 1, 0)>(vb); f.b1 = tr_read<v_rd_off(0, KS0 + 1, 1)>(vb); f.c1 = tr_read<v_rd_off(1, KS0 + 1, 0)>(vb); f.d1 = tr_read<v_rd_off(1, KS0 + 1, 1)>(vb);
}
#define MF(A, B, C) __builtin_amdgcn_mfma_f32_32x32x16_bf16(A, B, C, 0, 0, 0)
#define KOFF(KB, hb, d0) ((KB) * SHM_K + (hb) * 32 * 208 + (d0) * 32)
#define SUM4(P, B) do { ls += (P[B] + P[B + 1]) + (P[B + 2] + P[B + 3]); } while (0)
#define PACK8(P, B, OUT) do { u32x4 w_ = {cvtpk(P[B + 0], P[B + 1]), cvtpk(P[B + 2], P[B + 3]), cvtpk(P[B + 4], P[B + 5]), cvtpk(P[B + 6], P[B + 7])}; OUT = *reinterpret_cast<bf16x8*>(&w_); } while (0)
template <int KB, bool HASY>
__device__ __forceinline__ void phaseA(f32x16& X0, f32x16& X1, f32x16& Y0, f32x16& Y1, bf16x8& pa0, bf16x8& pa1, bf16x8& pa2, bf16x8& pa3,
                                       const bf16x8* qr, const f32x16& negm, int kaddr, VFr& vf, int vb, float& l_reg) {
  SBAR();
  float ls = 0.f;
  bf16x8 k0 = rd128<KOFF(KB, 0, 0)>(kaddr), k1 = rd128<KOFF(KB, 1, 0)>(kaddr), k2 = rd128<KOFF(KB, 0, 1)>(kaddr), k3 = rd128<KOFF(KB, 1, 1)>(kaddr);
  if (HASY) { EXP4(Y0, 0); EXP4(Y0, 4); }
  SBAR(); WAIT4(k0, k1, k2, k3);
  bf16x8 k4 = rd128<KOFF(KB, 0, 2)>(kaddr), k5 = rd128<KOFF(KB, 1, 2)>(kaddr), k6 = rd128<KOFF(KB, 0, 3)>(kaddr), k7 = rd128<KOFF(KB, 1, 3)>(kaddr);
  SBAR();
  X0 = MF(k0, qr[0], negm); if (HASY) { EXP4(Y0, 8); SUM4(Y0, 0); } SBAR();
  X1 = MF(k1, qr[0], negm); if (HASY) { EXP4(Y0, 12); SUM4(Y0, 4); } SBAR();
  X0 = MF(k2, qr[1], X0); if (HASY) { PACK8(Y0, 0, pa0); } SBAR();
  X1 = MF(k3, qr[1], X1); if (HASY) { EXP4(Y1, 0); SUM4(Y0, 8); } SBAR();
  WAIT4(k4, k5, k6, k7);
  bf16x8 k8 = rd128<KOFF(KB, 0, 4)>(kaddr), k9 = rd128<KOFF(KB, 1, 4)>(kaddr), k10 = rd128<KOFF(KB, 0, 5)>(kaddr), k11 = rd128<KOFF(KB, 1, 5)>(kaddr);
  SBAR();
  X0 = MF(k4, qr[2], X0); if (HASY) { EXP4(Y1, 4); SUM4(Y0, 12); } SBAR();
  X1 = MF(k5, qr[2], X1); if (HASY) { PACK8(Y0, 8, pa1); } SBAR();
  X0 = MF(k6, qr[3], X0); if (HASY) { EXP4(Y1, 8); SUM4(Y1, 0); } SBAR();
  X1 = MF(k7, qr[3], X1); if (HASY) { EXP4(Y1, 12); SUM4(Y1, 4); } SBAR();
  WAIT4(k8, k9, k10, k11);
  SBAR();
  X0 = MF(k8, qr[4], X0); if (HASY) { PACK8(Y1, 0, pa2); } SBAR();
  X1 = MF(k9, qr[4], X1); if (HASY) { SUM4(Y1, 8); SUM4(Y1, 12); } SBAR();
  X0 = MF(k10, qr[5], X0); if (HASY) { PACK8(Y1, 8, pa3); } SBAR();
  X1 = MF(k11, qr[5], X1); if (HASY) vfr_issue<0>(vf, vb);
  l_reg += ls;
  SBAR();
}
#define PKV(L, H) (bf16x8){L[0], L[1], L[2], L[3], H[0], H[1], H[2], H[3]}
#define VWAIT(f) asm volatile("s_waitcnt lgkmcnt(0)" : "+v"(f.a0), "+v"(f.b0), "+v"(f.c0), "+v"(f.d0), "+v"(f.a1), "+v"(f.b1), "+v"(f.c1), "+v"(f.d1) :: "memory")
template <bool HASX>
__device__ __forceinline__ float phaseB(f32x16* o, bf16x8 pa0, bf16x8 pa1, bf16x8 pa2, bf16x8 pa3, VFr& f, int vb, const f32x16& X0, const f32x16& X1) {
  SBAR(); VWAIT(f); VFr g; vfr_issue<2>(g, vb); SBAR();
  float a = 0.f, b = 0.f;
  o[0] = MF(pa0, PKV(f.a0, f.b0), o[0]); SBAR(); o[1] = MF(pa0, PKV(f.c0, f.d0), o[1]);
  if (HASX) { a = MX3(X0[0], X0[1], X1[0]); b = MX3(X0[2], X0[3], X1[1]); a = MX3(a, X1[2], X1[3]); b = MX3(b, X0[4], X0[5]); } SBAR();
  o[0] = MF(pa1, PKV(f.a1, f.b1), o[0]); if (HASX) { a = MX3(a, X0[6], X0[7]); b = MX3(b, X1[4], X1[5]); } SBAR();
  o[1] = MF(pa1, PKV(f.c1, f.d1), o[1]); if (HASX) { a = MX3(a, X1[6], X1[7]); b = MX3(b, X0[8], X0[9]); a = MX3(a, X0[10], X0[11]); } SBAR();
  VWAIT(g); SBAR();
  o[0] = MF(pa2, PKV(g.a0, g.b0), o[0]); if (HASX) { b = MX3(b, X1[8], X1[9]); a = MX3(a, X1[10], X1[11]); } SBAR();
  o[1] = MF(pa2, PKV(g.c0, g.d0), o[1]); if (HASX) { b = MX3(b, X0[12], X0[13]); a = MX3(a, X0[14], X0[15]); } SBAR();
  o[0] = MF(pa3, PKV(g.a1, g.b1), o[0]); if (HASX) { b = MX3(b, X1[12], X1[13]); a = MX3(a, X1[14], X1[15]); } SBAR();
  o[1] = MF(pa3, PKV(g.c1, g.d1), o[1]); SBAR();
  float pmax = __builtin_fmaxf(a, b);
  if (HASX) { auto rr = __builtin_amdgcn_permlane32_swap(__float_as_uint(pmax), __float_as_uint(pmax), false, false); pmax = __builtin_fmaxf(__uint_as_float(rr[0]), __uint_as_float(rr[1])); }
  return pmax;
}
__device__ __forceinline__ float rowmax32(const f32x16& p0, const f32x16& p1) {
  float a = MX3(p0[0], p0[1], p1[0]), b = MX3(p0[2], p0[3], p1[1]); a = MX3(a, p1[2], p1[3]);
#pragma unroll
  for (int r = 4; r < 16; r += 4) { a = MX3(a, p0[r], p0[r + 1]); b = MX3(b, p0[r + 2], p0[r + 3]); a = MX3(a, p1[r], p1[r + 1]); b = MX3(b, p1[r + 2], p1[r + 3]); }
  float pmax = __builtin_fmaxf(a, b);
  auto rr = __builtin_amdgcn_permlane32_swap(__float_as_uint(pmax), __float_as_uint(pmax), false, false);
  return __builtin_fmaxf(__uint_as_float(rr[0]), __uint_as_float(rr[1]));
}
template <bool FIRST>
__device__ __forceinline__ float decide(float pmax, f32x16& p0, f32x16& p1, float& m_reg, f32x16& negm) {
  float alpha = 1.f;
  if (FIRST || __builtin_expect(__any(pmax > THR2), 0)) {
    const float dl = FIRST ? pmax : __builtin_fmaxf(pmax, 0.f); m_reg += dl;
#pragma unroll
    for (int r = 0; r < 16; ++r) { p0[r] -= dl; p1[r] -= dl; }
#pragma unroll
    for (int r = 0; r < 16; ++r) negm[r] = -m_reg;
    if (!FIRST) alpha = __builtin_amdgcn_exp2f(-dl);
  }
  return alpha;
}
__device__ __forceinline__ void attn_unit(const bf16_t* __restrict__ Qb, const bf16_t* __restrict__ KNh, const bf16_t* __restrict__ KRb, const bf16_t* __restrict__ Vh,
                                          bf16_t* __restrict__ Ob, int nkeys, char* lds, int tid_in) {
  int tid_l = tid_in; asm volatile("" : "+v"(tid_l));
  const int tid = tid_l, wid = tid >> 6, lane = tid & 63, r32 = lane & 31, hi = lane >> 5;
  char* V_lds = lds; char* K_lds = lds + 3 * SHM_V;
  float* ws = (float*)(lds + 3 * SHM_V + 2 * SHM_K) + wid * 64; float* li_l = ws; float* al_l = ws + 32;
  float m_reg = 0.f, l_reg = 0.f; f32x16 o[2] = {}; f32x16 negm = {}; bf16x8 qr[6];
  const bf16_t* Qw = Qb + (long)(wid * QBLK + r32) * 768 + hi * 8;
#pragma unroll
  for (int d0 = 0; d0 < 6; ++d0) qr[d0] = *reinterpret_cast<const bf16x8*>(Qw + d0 * 16);
  const int sr = tid >> 3, sc = (tid & 7) * 8, vst0 = v_st_nat(sr, sc), kst0 = KSWZ(sr, sc * 2);
  const bool krt = tid < 256; const int rr_ = (tid >> 2) & 63, rc_ = (tid & 3) * 8, kst1 = KSWZ(rr_, 128 + rc_ * 2);
  const int vb0 = (int)(uintptr_t)V_lds + v_rd_base(lane);
  const int kaddr = (int)(uintptr_t)K_lds + r32 * 208 + hi * 16;
  struct { bf16x8 vs, ks, kr; } sr_[2];
  typedef unsigned v4u_t __attribute__((ext_vector_type(4)));
  const __amdgpu_buffer_rsrc_t rV = __builtin_amdgcn_make_buffer_rsrc((void*)Vh, 0, LK * 64 * 2, 0x00020000);
  const __amdgpu_buffer_rsrc_t rK = __builtin_amdgcn_make_buffer_rsrc((void*)KNh, 0, LK * 64 * 2, 0x00020000);
  const __amdgpu_buffer_rsrc_t rR = __builtin_amdgcn_make_buffer_rsrc((void*)KRb, 0, LK * 32 * 2, 0x00020000);
  const int goff_kv = (sr * 64 + sc) * 2, goff_kr = (rr_ * 32 + rc_) * 2;
#define BLD(R, VO, SO) __builtin_bit_cast(bf16x8, __builtin_amdgcn_raw_buffer_load_b128(R, VO, SO, 0))
#define SLOAD(i, k0) do { sr_[i].vs = BLD(rV, goff_kv, (k0) * 128); sr_[i].ks = BLD(rK, goff_kv, (k0) * 128); if (krt) sr_[i].kr = BLD(rR, goff_kr, (k0) * 64); } while (0)
#define SWRITE(b, voff, i) do { *(bf16x8*)(V_lds + (voff) + vst0) = sr_[i].vs; *(bf16x8*)(K_lds + (b) * SHM_K + kst0) = sr_[i].ks; \
    if (krt) *(bf16x8*)(K_lds + (b) * SHM_K + kst1) = sr_[i].kr; } while (0)
#define SWAIT() do { asm volatile("s_waitcnt vmcnt(3)" ::: "memory"); } while (0)
#define RESC(a) do { if (__any((a) < 1.f)) { if (hi == 0) al_l[r32] = (a); asm volatile("s_waitcnt lgkmcnt(0)" ::: "memory"); l_reg *= (a); \
    _Pragma("unroll") for (int d = 0; d < 2; ++d) _Pragma("unroll") for (int r = 0; r < 16; ++r) o[d][r] *= al_l[crow(r, hi)]; } } while (0)
  f32x16 pA0, pA1, pB0, pB1; float alA, alB; bf16x8 pa0, pa1, pa2, pa3; VFr vf; const int NT = nkeys / KVBLK;
  constexpr int SE = 0, SO = 1;
  int vprev = 0, vcur = SHM_V, vnext = 2 * SHM_V;
#define ROT() do { const int t_ = vprev; vprev = vcur; vcur = vnext; vnext = t_; } while (0)
  SLOAD(SE, 0); asm volatile("s_waitcnt vmcnt(0)" ::: "memory"); SWRITE(0, 0, SE); __syncthreads();
  phaseA<0, false>(pA0, pA1, pB0, pB1, pa0, pa1, pa2, pa3, qr, negm, kaddr, vf, vb0, l_reg);
  alA = decide<true>(rowmax32(pA0, pA1), pA0, pA1, m_reg, negm);
  SLOAD(SO, KVBLK); if (2 < NT) SLOAD(SE, 2 * KVBLK);
  SWAIT(); SWRITE(1, SHM_V, SO); __syncthreads();
  for (int j = 1; j + 1 < NT; j += 2) {
    phaseA<1, true>(pB0, pB1, pA0, pA1, pa0, pa1, pa2, pa3, qr, negm, kaddr, vf, vb0 + vprev, l_reg);
    SLOAD(SO, (j + 2) * KVBLK); SBAR();
    alB = decide<false>(phaseB<true>(o, pa0, pa1, pa2, pa3, vf, vb0 + vprev, pB0, pB1), pB0, pB1, m_reg, negm);
    SWAIT(); SWRITE(0, vnext, SE);
    RESC(alB); __syncthreads(); ROT();
    phaseA<0, true>(pA0, pA1, pB0, pB1, pa0, pa1, pa2, pa3, qr, negm, kaddr, vf, vb0 + vprev, l_reg);
    if (j + 3 < NT) SLOAD(SE, (j + 3) * KVBLK); SBAR();
    alA = decide<false>(phaseB<true>(o, pa0, pa1, pa2, pa3, vf, vb0 + vprev, pA0, pA1), pA0, pA1, m_reg, negm);
    SWAIT(); SWRITE(1, vnext, SO);
    RESC(alA); __syncthreads(); ROT();
  }
  phaseA<1, true>(pB0, pB1, pA0, pA1, pa0, pa1, pa2, pa3, qr, negm, kaddr, vf, vb0 + vprev, l_reg);
  alB = decide<false>(phaseB<true>(o, pa0, pa1, pa2, pa3, vf, vb0 + vprev, pB0, pB1), pB0, pB1, m_reg, negm);
  RESC(alB);
  finishSM(pB0, pB1, l_reg, pa0, pa1, pa2, pa3);
  vfr_issue<0>(vf, vb0 + vcur);
  (void)phaseB<false>(o, pa0, pa1, pa2, pa3, vf, vb0 + vcur, pB0, pB1);
#undef ROT
  { auto rr = __builtin_amdgcn_permlane32_swap(__float_as_uint(l_reg), __float_as_uint(l_reg), false, false); l_reg = __uint_as_float(rr[0]) + __uint_as_float(rr[1]); }
  if (hi == 0) li_l[r32] = l_reg;
  asm volatile("s_waitcnt lgkmcnt(0)" ::: "memory");
  float rli[16];
#pragma unroll
  for (int r = 0; r < 16; ++r) rli[r] = __builtin_amdgcn_rcpf(li_l[crow(r, hi)]);
  bf16_t* Ow = Ob + (long)(wid * QBLK) * 1024;
#pragma unroll
  for (int r = 0; r < 16; ++r) { int orow = crow(r, hi);
#pragma unroll
    for (int d0 = 0; d0 < 2; ++d0) { const float v = o[d0][r] * rli[r]; Ow[(long)orow * 1024 + d0 * 32 + r32] = (bf16_t)(cvtpk(v, v) & 0xffffu); } }
  __syncthreads();
#undef SLOAD
#undef BLD
#undef SWRITE
#undef SWAIT
#undef RESC
}
}
#define LAS __attribute__((address_space(3)))
typedef unsigned short bf16_t;
typedef float f32x4 __attribute__((ext_vector_type(4)));
typedef unsigned u32x4 __attribute__((ext_vector_type(4)));
typedef unsigned u32x2 __attribute__((ext_vector_type(2)));
typedef short bf16x8 __attribute__((ext_vector_type(8)));
using att::f32x16;
#define LDS_WAIT() asm volatile("s_waitcnt lgkmcnt(0)" ::: "memory")

constexpr int NWAVES = 8, NTHREADS = 512;
constexpr int D = 1024, BATCH = 8, SEQ = 8192, DEPTH = 4, CTXL = 256, DFF = 4096, DIN = 1696;
constexpr int TL = BATCH * SEQ, TC = BATCH * CTXL, MALL = TL + TC;
constexpr size_t MiB = 1u << 20;
constexpr size_t WS_ROPE = 64 * 1024, WS_MODS = 1 * MiB, WS_SSQ = 2 * MiB, WS_WIN = 8 * MiB, WS_WUQ = 22 * MiB, WS_WUKV = 25 * MiB, WS_WOUT = 27 * MiB,
                 WS_W1 = 35 * MiB, WS_W2 = 67 * MiB, WS_CX = 99 * MiB, WS_XN = 107 * MiB, WS_Z = 239 * MiB, WS_Q = 470 * MiB, WS_KN = 569 * MiB, WS_KR = 635 * MiB,
                 WS_V = 640 * MiB, WS_Y = 706 * MiB, WS_H = 239 * MiB, WS_END = 838 * MiB,
                 WS_SSQX = 838 * MiB, WS_SHW = 843 * MiB, WS_STAB = 844 * MiB, WS_XB = 845 * MiB, WS_PART = 977 * MiB, WS_END2 = 1009 * MiB;
static_assert(WS_SSQ + (size_t)MALL * 20 * 4 <= WS_WIN && WS_XN + (size_t)MALL * D * 2 <= WS_Z && WS_Z + (size_t)MALL * ZP * 2 <= WS_Q && WS_Q + (size_t)MALL * 768 * 2 <= WS_KN &&
              WS_KN + (size_t)64 * LK * 64 * 2 <= WS_KR && WS_KR + (size_t)8 * LK * 32 * 2 <= WS_V && WS_V + (size_t)64 * LK * 64 * 2 <= WS_Y && WS_Y + (size_t)MALL * D * 2 <= WS_END &&
              WS_H + (size_t)MALL * DFF * 2 <= WS_END && WS_MODS + (size_t)DEPTH * 9 * 6144 * 4 <= WS_SSQ, "ws map");
constexpr int SHW_IN = 1792, SHW_L = 9 * (1792 + 4096);
static_assert(WS_SSQX + (size_t)MALL * 16 * 4 <= WS_SHW && WS_SHW + (size_t)DEPTH * SHW_L * 4 <= WS_STAB && WS_STAB + (size_t)DEPTH * 2 * 9 * 1024 * 4 <= WS_XB && WS_XB + (size_t)MALL * D * 2 <= WS_PART && WS_PART + (size_t)4 * TC * D * 4 <= WS_END2, "ws map 2");
constexpr int LDS_BYTES = 147456;

struct Args { const float* in[25]; float* out; unsigned char* ws; int ph_lo, ph_hi; };

__device__ __forceinline__ float wave_sum(float v, int lane) {
#pragma unroll
    for (int o = 1; o < 64; o <<= 1) v += shx(v, o, lane);
    return v;
}
__device__ __forceinline__ float sigmoid_f(float x) { return __builtin_amdgcn_rcpf(1.f + __expf(-x)); }
__device__ __forceinline__ float gelu_tanh(float x) { const float u = 0.7978845608028654f * (x + 0.044715f * x * x * x); return x * __builtin_amdgcn_rcpf(1.f + __expf(-2.f * u)); }
__device__ __forceinline__ float bf2f(unsigned short h) { return __uint_as_float((unsigned)h << 16); }
__device__ __forceinline__ unsigned pk2(float lo, float hi) { return pg8::cvt_pk_bf16(lo, hi); }
__device__ __forceinline__ int rope_new(int i) { const int g = i >> 4, w = i & 15; return 16 * g + 2 * (w & 7) + (w >> 3); }
__device__ __forceinline__ int rowmap(int mode, int n) {
    if (mode == 1) return (n >= 640 && n < 672) ? 640 + rope_new(n - 640) : n;
    if (mode == 2) { const int h = n / 96, d = n - h * 96; return d >= 64 ? h * 96 + 64 + rope_new(d - 64) : n; }
    return n;
}
__device__ __forceinline__ void transpose_item(const float* W, int K, int N, bf16_t* WT, const float* kscale, int mode, LAS float* scr, int item, int lane) {
    const int nblk = N / 32, kb = item / nblk, nb = item % nblk, k0 = 64 * kb, n0 = 32 * nb;
#pragma unroll 8
    for (int i = 0; i < 32; ++i) { const int kk = 2 * i + (lane >> 5); float w = W[(size_t)(k0 + kk) * N + n0 + (lane & 31)]; if (kscale) w *= kscale[k0 + kk]; scr[kk * 33 + (lane & 31)] = w; }
    LDS_WAIT(); asm volatile("" ::: "memory");
    const int c = lane & 7;
#pragma unroll
    for (int j = 0; j < 4; ++j) { const int n = (lane >> 3) + 8 * j; const LAS float* s = scr + (8 * c) * 33 + n;
        u32x4 o; o.x = pk2(s[0 * 33], s[1 * 33]); o.y = pk2(s[2 * 33], s[3 * 33]); o.z = pk2(s[4 * 33], s[5 * 33]); o.w = pk2(s[6 * 33], s[7 * 33]);
        *(u32x4*)(WT + (size_t)rowmap(mode, n0 + n) * K + k0 + 8 * c) = o; }
    LDS_WAIT(); asm volatile("" ::: "memory");
}

typedef __attribute__((address_space(1))) unsigned gu32;
#define RLX_AGENT __ATOMIC_RELAXED, __HIP_MEMORY_SCOPE_AGENT
#define XB_TMO      128
#define XB_XCNT(j)  (256  + 64 * (j))
#define XB_XSUB(j)  (1280 + 64 * (j))
#define XB_XGEN(j)  (2304 + 64 * (j))
#define XB_TOP      3328
#define XB_TOPGEN   3392
#define XCD_BAR_WORDS 3456
#define XB_SPIN_CAP (1u << 18)

__device__ __forceinline__ unsigned xb_ld(unsigned* p)              { return __hip_atomic_load(p, __ATOMIC_RELAXED, __HIP_MEMORY_SCOPE_AGENT); }
__device__ __forceinline__ unsigned xb_add(unsigned* p, unsigned v) { return __hip_atomic_fetch_add(p, v, __ATOMIC_RELAXED, __HIP_MEMORY_SCOPE_AGENT); }
__device__ __forceinline__ unsigned xb_xcc_id() { return (unsigned)__builtin_amdgcn_s_getreg((3 << 11) | 20) & 0xFu; }
#define XB_SPIN(cond, bar) do { unsigned _sp = 0; while (cond) { __builtin_amdgcn_s_sleep(1); \
    if ((++_sp & 255u) == 0u) { if (xb_ld(&(bar)[XB_TMO])) break; if (_sp > XB_SPIN_CAP) { atomicAdd(&(bar)[XB_TMO], 1u); break; } } } } while (0)

struct XcdBarrier {
    unsigned* bar; unsigned x;
    volatile LAS unsigned* st;
};

__device__ __forceinline__ XcdBarrier xcd_barrier_post(unsigned* bar, volatile LAS unsigned* st) {
    XcdBarrier b; b.bar = bar; b.x = xb_xcc_id(); b.st = st;
    if (threadIdx.x == 0) (void)xb_add(&bar[XB_XCNT(b.x)], 1u);
    return b;
}
__device__ __forceinline__ void xcd_barrier_complete(unsigned* bar, unsigned x, unsigned& nloc, unsigned& nx) {
    const unsigned G = gridDim.x * gridDim.y * gridDim.z;
    unsigned sum, cnt, mine, sp = 0u;
    for (;;) {
        sum = 0u; cnt = 0u; mine = 0u;
#pragma unroll
        for (unsigned j = 0; j < 16; ++j) { const unsigned c = xb_ld(&bar[XB_XCNT(j)]); sum += c; cnt += (c > 0u) ? 1u : 0u; mine = (j == x) ? c : mine; }
        if (sum == G) break;
        __builtin_amdgcn_s_sleep(1);
        if ((++sp & 255u) == 0u) { if (xb_ld(&bar[XB_TMO])) break; if (sp > XB_SPIN_CAP) { atomicAdd(&bar[XB_TMO], 1u); break; } }
    }
    nloc = mine > 0u ? mine : 1u; nx = cnt > 0u ? cnt : 1u;
}

__device__ __forceinline__ void xcd_barrier(const XcdBarrier& b) {
    asm volatile("s_waitcnt vmcnt(0)" ::: "memory");
    __syncthreads();
    if (threadIdx.x == 0) {
        unsigned* bar = b.bar;
        __builtin_amdgcn_s_waitcnt(0);
        unsigned nloc = b.st[0], nx = b.st[1];
        if (nloc == 0u) { xcd_barrier_complete(bar, b.x, nloc, nx); b.st[0] = nloc; b.st[1] = nx; }
        const unsigned old = xb_add(&bar[XB_XSUB(b.x)], 1u);
        const unsigned gen = old / nloc;
        if (old + 1u == (gen + 1u) * nloc) {
            __builtin_amdgcn_fence(__ATOMIC_RELEASE, "agent");
            asm volatile("s_waitcnt vmcnt(0)" ::: "memory");
            const unsigned og = xb_add(&bar[XB_TOP], 1u);
            const unsigned tg = og / nx;
            if (og + 1u == (tg + 1u) * nx) xb_add(&bar[XB_TOPGEN], 1u);
            else XB_SPIN(xb_ld(&bar[XB_TOPGEN]) == tg, bar);
            __builtin_amdgcn_fence(__ATOMIC_ACQUIRE, "agent");
            xb_add(&bar[XB_XGEN(b.x)], 1u);
            asm volatile("s_waitcnt vmcnt(0)" ::: "memory");
        } else {
            XB_SPIN(xb_ld(&bar[XB_XGEN(b.x)]) == gen, bar);
            __builtin_amdgcn_fence(__ATOMIC_ACQUIRE, "agent");
            asm volatile("s_waitcnt vmcnt(0)" ::: "memory");
        }
    }
    __syncthreads();
}
__device__ __forceinline__ int nrep_of(int n) { asm volatile("" : "+s"(n)); return n; }
struct Ctx {
    LAS unsigned char* lds; unsigned char* ldsg; const float* const* in; float* out; unsigned char* ws;
    int tid, lane, wave, G, bx, vcu;
};

__device__ __forceinline__ void phase_prologue(const Ctx& F) {
    LAS float* scr = (LAS float*)(F.lds + F.wave * 16384);
    const int gw = F.bx * NWAVES + F.wave, NGW = F.G * NWAVES;
    constexpr int I_IN = 16 * 53, I_UQ = 6 * 24, I_UKV = 4 * 32, I_OUT = 16 * 32, I_1 = 16 * 128, I_2 = 64 * 32, I_L = I_IN + I_UQ + I_UKV + I_OUT + I_1 + I_2;
    for (int it = gw; it < DEPTH * I_L; it += NGW) {
        const int l = it / I_L; int r = it - l * I_L;
        if (r < I_IN) { transpose_item(F.in[8] + (size_t)l * D * DIN, D, DIN, (bf16_t*)(F.ws + WS_WIN) + (size_t)l * ZP * D, nullptr, 1, scr, r, F.lane); continue; } r -= I_IN;
        if (r < I_UQ) { transpose_item(F.in[10] + (size_t)l * 384 * 768, 384, 768, (bf16_t*)(F.ws + WS_WUQ) + (size_t)l * 768 * 384, F.in[9] + l * 384, 2, scr, r, F.lane); continue; } r -= I_UQ;
        if (r < I_UKV) { transpose_item(F.in[12] + (size_t)l * 256 * 1024, 256, 1024, (bf16_t*)(F.ws + WS_WUKV) + (size_t)l * 1024 * 256, F.in[11] + l * 256, 0, scr, r, F.lane); continue; } r -= I_UKV;
        if (r < I_OUT) { transpose_item(F.in[21] + (size_t)l * D * D, D, D, (bf16_t*)(F.ws + WS_WOUT) + (size_t)l * D * D, nullptr, 0, scr, r, F.lane); continue; } r -= I_OUT;
        if (r < I_1) { transpose_item(F.in[22] + (size_t)l * D * DFF, D, DFF, (bf16_t*)(F.ws + WS_W1) + (size_t)l * DFF * D, nullptr, 0, scr, r, F.lane); continue; } r -= I_1;
        transpose_item(F.in[23] + (size_t)l * DFF * D, DFF, D, (bf16_t*)(F.ws + WS_W2) + (size_t)l * D * DFF, nullptr, 0, scr, r, F.lane);
    }
    for (int i = F.bx * NTHREADS + F.tid; i < DEPTH * 96 * D / 8; i += F.G * NTHREADS) { const int l = i / (96 * D / 8), r = i - l * (96 * D / 8);
        unsigned zz_ = 0u; asm volatile("" : "+v"(zz_)); *(u32x4*)((bf16_t*)(F.ws + WS_WIN) + ((size_t)l * ZP + DIN) * D + (size_t)r * 8) = (u32x4){zz_, zz_, zz_, zz_}; }
    if (F.bx == 0) for (int i = F.tid; i < 128 * 8; i += NTHREADS) { const int pos = i >> 3, j = i & 7; const float inv = 1.0f / powf(10000.0f, (float)j / 8.0f); const float ang = (float)pos * inv;
        float* rp = (float*)(F.ws + WS_ROPE) + i * 2; rp[0] = cosf(ang); rp[1] = sinf(ang); }
    __syncthreads();
    LAS float* sv = (LAS float*)F.lds;
    LAS float* red = (LAS float*)(F.lds + 40960);
    for (int i = F.tid; i < 9 * 1024; i += NTHREADS) { const int j = i >> 10, k = i & 1023; const float cvl = j < 8 ? F.in[1][j * 1024 + k] : F.in[3][k]; sv[i] = cvl * sigmoid_f(cvl); }
    __syncthreads();
    float* mods = (float*)(F.ws + WS_MODS);
    for (int it = F.bx; it < DEPTH * 96; it += F.G) {
        const int l = it / 96, cg_ = it - l * 96, col = F.tid & 63, kg = F.tid >> 6;
        const float* wp = F.in[4] + (size_t)l * D * 6144 + (size_t)(kg * 128) * 6144 + cg_ * 64 + col;
        float acc[9];
#pragma unroll
        for (int j = 0; j < 9; ++j) acc[j] = 0.f;
#pragma unroll 16
        for (int k = 0; k < 128; ++k) { const float w = wp[(size_t)k * 6144];
#pragma unroll
            for (int j = 0; j < 9; ++j) acc[j] += sv[j * 1024 + kg * 128 + k] * w; }
#pragma unroll
        for (int j = 0; j < 9; ++j) red[(kg * 9 + j) * 64 + col] = acc[j];
        __syncthreads();
        for (int i = F.tid; i < 9 * 64; i += NTHREADS) { const int j = i >> 6, c2 = i & 63; float s = F.in[5][l * 6144 + cg_ * 64 + c2];
#pragma unroll
            for (int g = 0; g < 8; ++g) s += red[(g * 9 + j) * 64 + c2];
            mods[((size_t)l * 9 + j) * 6144 + cg_ * 64 + c2] = s;
            const int cidx = cg_ * 64 + c2;
            if (cidx >= 1024 && cidx < 2048) ((float*)(F.ws + WS_STAB))[(((size_t)l * 2 + 0) * 9 + j) * 1024 + cidx - 1024] = F.in[6][l * 1024 + cidx - 1024] * (1.f + s);
            if (cidx >= 4096 && cidx < 5120) ((float*)(F.ws + WS_STAB))[(((size_t)l * 2 + 1) * 9 + j) * 1024 + cidx - 4096] = F.in[7][l * 1024 + cidx - 4096] * (1.f + s); }
        __syncthreads();
    }
}

__device__ __forceinline__ void phase_norm0(const Ctx& F) {
    const int gw = F.bx * NWAVES + F.wave, NGW = F.G * NWAVES; bf16_t* XS = (bf16_t*)(F.ws + WS_XN); float* ssqx = (float*)(F.ws + WS_SSQX);
    const float* stab = (const float*)(F.ws + WS_STAB);
    for (int wu = gw; wu < MALL / 16; wu += NGW) {
        const int r0 = wu * 16; const bool isctx = r0 >= TL; const int mi = isctx ? 8 : (r0 >> 13);
        const float* base = isctx ? F.in[2] + (size_t)(r0 - TL) * D : F.in[0] + (size_t)r0 * D;
        f32x4 S[4];
#pragma unroll
        for (int j = 0; j < 4; ++j) S[j] = *(const f32x4*)(stab + (size_t)mi * 1024 + 4 * F.lane + 256 * j);
        for (int i = 0; i < 16; ++i) {
            const f32x4* xr = (const f32x4*)(base + (size_t)i * D) + F.lane;
            f32x4 v[4]; float s = 0.f;
#pragma unroll
            for (int j = 0; j < 4; ++j) { v[j] = xr[64 * j]; s += (v[j][0] * v[j][0] + v[j][1] * v[j][1]) + (v[j][2] * v[j][2] + v[j][3] * v[j][3]); }
            bf16_t* orow = XS + (size_t)(r0 + i) * D + 4 * F.lane;
#pragma unroll
            for (int j = 0; j < 4; ++j) { const f32x4 o = v[j] * S[j]; u32x2 w; w.x = pk2(o[0], o[1]); w.y = pk2(o[2], o[3]); *(u32x2*)(orow + 256 * j) = w;
                u32x2 wb; wb.x = pk2(v[j][0], v[j][1]); wb.y = pk2(v[j][2], v[j][3]); *(u32x2*)((bf16_t*)(F.ws + WS_XB) + (size_t)(r0 + i) * D + 4 * F.lane + 256 * j) = wb; }
            const float tot = wave_sum(s, F.lane);
            if (F.lane < 4) { f32x4 q = {0.f, 0.f, 0.f, 0.f}; if (F.lane == 0) q[0] = tot; *(f32x4*)(ssqx + (size_t)(r0 + i) * 16 + 4 * F.lane) = q; }
        }
    }
    __syncthreads();
    LAS float* sv = (LAS float*)F.lds;
    LAS float* red = (LAS float*)(F.lds + 40960);
    const float* mods = (const float*)(F.ws + WS_MODS); float* shw = (float*)(F.ws + WS_SHW);
    constexpr int G_IN = 28, G_FF = 64, G_L = G_IN + G_FF;
    for (int it = F.bx; it < DEPTH * G_L; it += F.G) {
        const int l = it / G_L, gi = it - l * G_L; const bool isin = gi < G_IN; const int cg_ = isin ? gi : gi - G_IN;
        const int shoff = isin ? 0 : 3072, N = isin ? DIN : DFF; const float* W = isin ? F.in[8] + (size_t)l * D * DIN : F.in[22] + (size_t)l * D * DFF;
        __syncthreads();
        for (int i = F.tid; i < 9 * 1024; i += NTHREADS) { const int j = i >> 10, k = i & 1023; sv[i] = mods[((size_t)l * 9 + j) * 6144 + shoff + k]; }
        __syncthreads();
        const int col = F.tid & 63, kg = F.tid >> 6, n = cg_ * 64 + col; const bool valid = n < N;
        float acc[9];
#pragma unroll
        for (int j = 0; j < 9; ++j) acc[j] = 0.f;
        if (valid) { const float* wp = W + (size_t)(kg * 128) * N + n;
#pragma unroll 16
            for (int k = 0; k < 128; ++k) { const float w = wp[(size_t)k * N];
#pragma unroll
                for (int j = 0; j < 9; ++j) acc[j] += sv[j * 1024 + kg * 128 + k] * w; } }
#pragma unroll
        for (int j = 0; j < 9; ++j) red[(kg * 9 + j) * 64 + col] = acc[j];
        __syncthreads();
        for (int i = F.tid; i < 9 * 64; i += NTHREADS) { const int j = i >> 6, c2 = i & 63, n2 = cg_ * 64 + c2; float sm = 0.f;
#pragma unroll
            for (int g = 0; g < 8; ++g) sm += red[(g * 9 + j) * 64 + c2];
            if (isin) { if (n2 < DIN) shw[(size_t)l * SHW_L + j * SHW_IN + rowmap(1, n2)] = sm; else shw[(size_t)l * SHW_L + j * SHW_IN + n2] = 0.f; }
            else shw[(size_t)l * SHW_L + 9 * SHW_IN + j * DFF + n2] = sm; }
    }
    __syncthreads();
}
__device__ __forceinline__ void phase_final_norm(const Ctx& F) {
    const int gw = F.bx * NWAVES + F.wave, NGW = F.G * NWAVES; const float* g = F.in[24]; const bf16_t* XB = (const bf16_t*)(F.ws + WS_XB);
    f32x4 S[4];
#pragma unroll
    for (int j = 0; j < 4; ++j) S[j] = *(const f32x4*)(g + 4 * F.lane + 256 * j);
    for (int r = gw; r < TL; r += NGW) {
        f32x4* orow = (f32x4*)(F.out + (size_t)r * D) + F.lane;
        f32x4 v[4]; float s = 0.f;
#pragma unroll
        for (int j = 0; j < 4; ++j) { const u32x2 w = *(const u32x2*)(XB + (size_t)r * D + 4 * F.lane + 256 * j);
            v[j] = (f32x4){__uint_as_float(w.x << 16), __uint_as_float(w.x & 0xffff0000u), __uint_as_float(w.y << 16), __uint_as_float(w.y & 0xffff0000u)};
            s += (v[j][0] * v[j][0] + v[j][1] * v[j][1]) + (v[j][2] * v[j][2] + v[j][3] * v[j][3]); }
        const float rstd = rsqrtf(wave_sum(s, F.lane) * (1.0f / D) + 1e-6f);
#pragma unroll
        for (int j = 0; j < 4; ++j) orow[64 * j] = v[j] * rstd * S[j];
    }
}

__device__ __forceinline__ void phase_ctx_finish(const Ctx& F, const float* gate  , const float* stab  ) {
    const int gw = F.bx * NWAVES + F.wave, NGW = F.G * NWAVES; bf16_t* XB = (bf16_t*)(F.ws + WS_XB); bf16_t* XS = (bf16_t*)(F.ws + WS_XN); float* ssqx = (float*)(F.ws + WS_SSQX);
    const float* P = (const float*)(F.ws + WS_PART);
    for (int rc = gw; rc < TC; rc += NGW) {
        const int row = TL + rc; float s = 0.f;
#pragma unroll
        for (int j = 0; j < 4; ++j) { const int c = 4 * F.lane + 256 * j; const size_t po = (size_t)rc * D + c;
            const f32x4 p = (*(const f32x4*)(P + po) + *(const f32x4*)(P + (size_t)TC * D + po)) + (*(const f32x4*)(P + (size_t)2 * TC * D + po) + *(const f32x4*)(P + (size_t)3 * TC * D + po));
            const u32x2 xr = *(const u32x2*)(XB + (size_t)row * D + c);
            const f32x4 x = {__uint_as_float(xr.x << 16), __uint_as_float(xr.x & 0xffff0000u), __uint_as_float(xr.y << 16), __uint_as_float(xr.y & 0xffff0000u)};
            const f32x4 y = x + *(const f32x4*)(gate + c) * p, t = y * *(const f32x4*)(stab + c);
            u32x2 w; w.x = pk2(y[0], y[1]); w.y = pk2(y[2], y[3]); *(u32x2*)(XB + (size_t)row * D + c) = w;
            u32x2 w2; w2.x = pk2(t[0], t[1]); w2.y = pk2(t[2], t[3]); *(u32x2*)(XS + (size_t)row * D + c) = w2;
            s += (y[0] * y[0] + y[1] * y[1]) + (y[2] * y[2] + y[3] * y[3]); }
        const float tot = wave_sum(s, F.lane);
        if (F.lane < 4) { f32x4 q = {0.f, 0.f, 0.f, 0.f}; if (F.lane == 0) q[0] = tot; *(f32x4*)(ssqx + (size_t)row * 16 + 4 * F.lane) = q; }
    }
}

__device__ __forceinline__ void phase_krope(const Ctx& F) {
    const bf16_t* Z = (const bf16_t*)(F.ws + WS_Z); bf16_t* KR = (bf16_t*)(F.ws + WS_KR); const float* rope = (const float*)(F.ws + WS_ROPE);
    for (int i = F.bx * NTHREADS + F.tid; i < MALL * 4; i += F.G * NTHREADS) {
        const int row = i >> 2, ch = i & 3;
        const u32x4 raw = *(const u32x4*)(Z + (size_t)row * ZP + 640 + ch * 8);
        float a[8];
#pragma unroll
        for (int e = 0; e < 4; ++e) { a[2 * e] = __uint_as_float(raw[e] << 16); a[2 * e + 1] = __uint_as_float(raw[e] & 0xffff0000u); }
        int b, kpos;
        if (row < TL) { b = row >> 13; const int t = row & 8191; kpos = 256 + t; const int g = ch >> 1, j0 = (ch & 1) * 4; const int pos = g ? (t & 63) : (t >> 6);
            const f32x4* tb = (const f32x4*)(rope + (pos * 8 + j0) * 2); const f32x4 c0 = tb[0], c1 = tb[1];
            const float cs[8] = {c0[0], c0[1], c0[2], c0[3], c1[0], c1[1], c1[2], c1[3]};
#pragma unroll
            for (int p = 0; p < 4; ++p) { const float x1 = a[2 * p], x2 = a[2 * p + 1], c = cs[2 * p], s = cs[2 * p + 1]; a[2 * p] = x1 * c - x2 * s; a[2 * p + 1] = x2 * c + x1 * s; } }
        else { const int rc = row - TL; b = rc >> 8; kpos = rc & 255; }
        u32x4 o; o.x = pk2(a[0], a[1]); o.y = pk2(a[2], a[3]); o.z = pk2(a[4], a[5]); o.w = pk2(a[6], a[7]);
        *(u32x4*)(KR + ((size_t)b * LK + kpos) * 32 + ch * 8) = o;
    }
}

__device__ __forceinline__ void phase_conv(const Ctx& F, int l, int nrows, int rot) {
    const bf16_t* Z = (const bf16_t*)(F.ws + WS_Z); bf16_t* Y = (bf16_t*)(F.ws + WS_Y);
    LAS float* yin = (LAS float*)F.lds;
    LAS float* yout = (LAS float*)(F.lds + 65536);
    const float* cw = F.in[13] + (size_t)l * 31 * 256; const float* cb = F.in[14] + l * 256; const float* lg = F.in[15] + l * 256; const float* lb = F.in[16] + l * 256;
    const int c = F.tid & 255, th = F.tid >> 8;
    float w[31];
#pragma unroll
    for (int j = 0; j < 31; ++j) w[j] = cw[j * 256 + c];
    const float bias = cb[c];
    const f32x4 g4 = *(const f32x4*)(lg + 4 * F.lane), b4 = *(const f32x4*)(lb + 4 * F.lane);
    const int nunits = nrows / 32;
    for (int un = (F.bx - rot + F.G) % F.G; un < nunits; un += F.G) {
        const int r0 = un * 32; int s0, s1;
        if (r0 < TL) { s0 = r0 & ~8191; s1 = s0 + 8192; } else { s0 = TL + ((r0 - TL) & ~255); s1 = s0 + 256; }
        __syncthreads();
#pragma unroll
        for (int it_ = 0; it_ < 4; ++it_) { const int it = F.tid + it_ * NTHREADS; if (it >= 62 * 32) break; const int i = it >> 5, ch = it & 31; const int row = r0 - 15 + i;
            f32x4 o0 = {0.f, 0.f, 0.f, 0.f}, o1 = o0;
            if (row >= s0 && row < s1) { const u32x4 ra = *(const u32x4*)(Z + (size_t)row * ZP + 672 + ch * 8), rg = *(const u32x4*)(Z + (size_t)row * ZP + 928 + ch * 8);
#pragma unroll
                for (int e = 0; e < 4; ++e) { const float a0 = __uint_as_float(ra[e] << 16), a1 = __uint_as_float(ra[e] & 0xffff0000u), g0 = __uint_as_float(rg[e] << 16), g1 = __uint_as_float(rg[e] & 0xffff0000u);
                    const float y0 = a0 * sigmoid_f(g0), y1 = a1 * sigmoid_f(g1);
                    if (e < 2) { o0[2 * e] = y0; o0[2 * e + 1] = y1; } else { o1[2 * e - 4] = y0; o1[2 * e - 3] = y1; } } }
            *(LAS f32x4*)(yin + i * 256 + ch * 8) = o0; *(LAS f32x4*)(yin + i * 256 + ch * 8 + 4) = o1; }
        __syncthreads();
        for (int ob = 0; ob < 2; ++ob) {
            const LAS float* xp = yin + (16 * th + 8 * ob) * 256 + c;
            float x[38];
#pragma unroll
            for (int k = 0; k < 38; ++k) x[k] = xp[k * 256];
#pragma unroll
            for (int oo = 0; oo < 8; ++oo) { float a = bias;
#pragma unroll
                for (int j = 0; j < 31; ++j) a += x[oo + j] * w[j];
                yout[(16 * th + 8 * ob + oo) * 256 + c] = a; }
        }
        __syncthreads();
#pragma unroll
        for (int i = 0; i < 4; ++i) { const int tk = F.wave * 4 + i; const f32x4 v = *(LAS f32x4*)(yout + tk * 256 + 4 * F.lane);
            const float mu = wave_sum((v[0] + v[1]) + (v[2] + v[3]), F.lane) * (1.0f / 256.0f); const f32x4 dv = v - mu;
            const float var = wave_sum((dv[0] * dv[0] + dv[1] * dv[1]) + (dv[2] * dv[2] + dv[3] * dv[3]), F.lane) * (1.0f / 256.0f);
            const float rstd = rsqrtf(var + 1e-6f); f32x4 y = dv * rstd * g4 + b4;
#pragma unroll
            for (int e = 0; e < 4; ++e) y[e] = y[e] * sigmoid_f(y[e]);
            u32x2 wv; wv.x = pk2(y[0], y[1]); wv.y = pk2(y[2], y[3]); *(u32x2*)(Y + (size_t)(r0 + tk) * D + 512 + 4 * F.lane) = wv; }
    }
    __syncthreads();
}

__device__ __forceinline__ void phase_sgu(const Ctx& F, int l, int nrows, int rot) {
    const bf16_t* Z = (const bf16_t*)(F.ws + WS_Z); bf16_t* Y = (bf16_t*)(F.ws + WS_Y);
    const float* lg = F.in[17] + l * 256; const float* lb = F.in[18] + l * 256; const float* sw = F.in[19] + (size_t)l * 4 * 128 * 128; const float* sb = F.in[20] + l * 4 * 128;
    const int lane = F.lane, r32 = lane & 31, hi = lane >> 5;
    const int c8 = (lane & 31) * 8;
    f32x4 g0 = *(const f32x4*)(lg + c8), g1 = *(const f32x4*)(lg + c8 + 4), b0 = *(const f32x4*)(lb + c8), b1 = *(const f32x4*)(lb + c8 + 4);
    const int nunits = nrows / 128;
    for (int un = (F.bx - rot + F.G) % F.G; un < nunits; un += F.G) {
        const int r0 = un * 128;
        __syncthreads();
#pragma unroll
        for (int i = 0; i < 8; ++i) { const int q = F.wave * 16 + 2 * i + hi; const u32x4 raw = *(const u32x4*)(Z + (size_t)(r0 + q) * ZP + 1440 + c8);
            float a[8]; float s = 0.f;
#pragma unroll
            for (int e = 0; e < 4; ++e) { a[2 * e] = gelu_tanh(__uint_as_float(raw[e] << 16)); a[2 * e + 1] = gelu_tanh(__uint_as_float(raw[e] & 0xffff0000u)); s += a[2 * e] + a[2 * e + 1]; }
#pragma unroll
            for (int o = 1; o < 32; o <<= 1) s += shx(s, o, lane);
            const float mu = s * (1.0f / 256.0f); float q2 = 0.f;
#pragma unroll
            for (int e = 0; e < 8; ++e) { a[e] -= mu; q2 += a[e] * a[e]; }
#pragma unroll
            for (int o = 1; o < 32; o <<= 1) q2 += shx(q2, o, lane);
            const float rstd = rsqrtf(q2 * (1.0f / 256.0f) + 1e-6f);
            u32x4 o4; o4.x = pk2(a[0] * rstd * g0[0] + b0[0], a[1] * rstd * g0[1] + b0[1]); o4.y = pk2(a[2] * rstd * g0[2] + b0[2], a[3] * rstd * g0[3] + b0[3]);
            o4.z = pk2(a[4] * rstd * g1[0] + b1[0], a[5] * rstd * g1[1] + b1[1]); o4.w = pk2(a[6] * rstd * g1[2] + b1[2], a[7] * rstd * g1[3] + b1[3]);
            *(u32x4*)(F.ldsg + (c8 >> 6) * 16384 + (q >> 6) * 8192 + att::v_st(q & 63, c8 & 63)) = o4; }
        __syncthreads();
        const int h = F.wave >> 1, ph = F.wave & 1;
        f32x16 o[2][2] = {};
#pragma unroll
        for (int kt = 0; kt < 2; ++kt) { const int vb = (int)(uintptr_t)F.ldsg + h * 16384 + kt * 8192 + att::v_rd_base(lane);
#pragma unroll
            for (int mt = 0; mt < 2; ++mt) { bf16x8 pa[4]; const float* wr_ = sw + ((size_t)h * 128 + ph * 64 + mt * 32 + r32) * 128 + kt * 64 + hi * 8;
#pragma unroll
                for (int ks = 0; ks < 4; ++ks) { const f32x4 w0 = *(const f32x4*)(wr_ + ks * 16), w1 = *(const f32x4*)(wr_ + ks * 16 + 4); const u32x4 pw = pg8::pack8(w0, w1); pa[ks] = *reinterpret_cast<const bf16x8*>(&pw); }
                att::pv_one<0>(o[mt][0], vb, pa[0], pa[1], pa[2], pa[3]); att::pv_one<1>(o[mt][1], vb, pa[0], pa[1], pa[2], pa[3]); } }
        {
            LAS bf16_t* mx = (LAS bf16_t*)(F.lds + 65536);
#pragma unroll
            for (int mt = 0; mt < 2; ++mt)
#pragma unroll
                for (int r = 0; r < 16; ++r) { const int p = ph * 64 + mt * 32 + att::crow(r, hi); const float bs = sb[h * 128 + p];
#pragma unroll
                    for (int d0 = 0; d0 < 2; ++d0) { const float v = o[mt][d0][r] + bs; mx[p * 256 + h * 64 + d0 * 32 + r32] = (bf16_t)(pk2(v, v) & 0xffffu); } }
            __syncthreads();
#pragma unroll
            for (int it_ = 0; it_ < 8; ++it_) { const int it = F.tid + it_ * NTHREADS; const int p = it >> 5, ch = it & 31;
                const u32x4 mraw = *(const LAS u32x4*)(mx + p * 256 + ch * 8);
                const u32x4 zraw = *(const u32x4*)(Z + (size_t)(r0 + p) * ZP + 1184 + ch * 8);
                float ov[8];
#pragma unroll
                for (int e = 0; e < 4; ++e) { ov[2 * e] = gelu_tanh(__uint_as_float(zraw[e] << 16)) * __uint_as_float(mraw[e] << 16); ov[2 * e + 1] = gelu_tanh(__uint_as_float(zraw[e] & 0xffff0000u)) * __uint_as_float(mraw[e] & 0xffff0000u); }
                u32x4 o4; o4.x = pk2(ov[0], ov[1]); o4.y = pk2(ov[2], ov[3]); o4.z = pk2(ov[4], ov[5]); o4.w = pk2(ov[6], ov[7]);
                *(u32x4*)(Y + (size_t)(r0 + p) * D + 768 + ch * 8) = o4; }
        }
    }
    __syncthreads();
}

__device__ __forceinline__ void phase_attn(const Ctx& F, bool with_ctx) {
    const bf16_t* Q = (const bf16_t*)(F.ws + WS_Q); const bf16_t* KN = (const bf16_t*)(F.ws + WS_KN); const bf16_t* KR = (const bf16_t*)(F.ws + WS_KR); const bf16_t* V = (const bf16_t*)(F.ws + WS_V);
    bf16_t* Y = (bf16_t*)(F.ws + WS_Y);
    const int nlat = BATCH * 8 * 32, ntot = nlat + (with_ctx ? BATCH * 8 : 0);
    __syncthreads();
    for (int U = F.vcu; U < ntot; U += F.G) {
        int bh, row0, nkeys;
        if (U < nlat) { bh = U >> 5; const int qb = U & 31; row0 = (bh >> 3) * SEQ + qb * 256; nkeys = LK; }
        else { bh = U - nlat; row0 = TL + (bh >> 3) * CTXL; nkeys = CTXL; }
        const int b = bh >> 3, h = bh & 7;
        att::attn_unit(Q + (size_t)row0 * 768 + h * 96, KN + (size_t)bh * LK * 64, KR + (size_t)b * LK * 32, V + (size_t)bh * LK * 64, Y + (size_t)row0 * D + h * 64, nkeys, (char*)F.ldsg, F.tid);
    }
}

__global__ void __launch_bounds__(NTHREADS, 2) mega_fwd(Args args) {
    extern __shared__ __attribute__((aligned(16))) unsigned char lds[];
    Ctx F; F.lds = (LAS unsigned char*)lds; F.ldsg = lds; F.in = args.in; F.out = args.out; F.ws = args.ws;
    const int wave_s = __builtin_amdgcn_readfirstlane((int)threadIdx.x >> 6); F.tid = 0; F.lane = 0; F.wave = wave_s; F.G = gridDim.x; F.bx = blockIdx.x;
    F.vcu = (F.G % 8 == 0) ? (F.bx % 8) * (F.G / 8) + F.bx / 8 : F.bx;
    const bool multi = (args.ph_hi - args.ph_lo) > 1;
    volatile LAS unsigned* bst = (volatile LAS unsigned*)(F.lds + LDS_BYTES - 64);
    if (threadIdx.x < 2) bst[threadIdx.x] = 0u;
    __syncthreads();
    XcdBarrier gbar; gbar.bar = (unsigned*)args.ws; gbar.x = 0; gbar.st = nullptr;
    if (multi) gbar = xcd_barrier_post((unsigned*)args.ws, bst);
    const int ph_lo_u = __builtin_amdgcn_readfirstlane(args.ph_lo), ph_hi_u = __builtin_amdgcn_readfirstlane(args.ph_hi);
    for (int ph = ph_lo_u; ph < ph_hi_u; ++ph) {
#define SETLANE() do { int l_; asm volatile("v_mbcnt_lo_u32_b32 %0, -1, 0\n\tv_mbcnt_hi_u32_b32 %0, -1, %0" : "=&v"(l_)); F.lane = l_; F.tid = wave_s * 64 + l_; F.wave = wave_s; } while (0)
        { int z_ = 0; asm volatile("s_mov_b32 %0, 0" : "=s"(z_)); F.ws = args.ws + z_; F.out = args.out + z_; F.in = args.in + z_; }
        float* mods = (float*)(F.ws + WS_MODS); float* ssq = (float*)(F.ws + WS_SSQ); float* cx = (float*)(F.ws + WS_CX); const float* rope = (const float*)(F.ws + WS_ROPE);
        bf16_t* XN = (bf16_t*)(F.ws + WS_XN); bf16_t* Z = (bf16_t*)(F.ws + WS_Z); bf16_t* Qb = (bf16_t*)(F.ws + WS_Q); bf16_t* Y = (bf16_t*)(F.ws + WS_Y); bf16_t* H = (bf16_t*)(F.ws + WS_H);
        float* ssqx = (float*)(F.ws + WS_SSQX); const float* shw = (const float*)(F.ws + WS_SHW); const float* stab = (const float*)(F.ws + WS_STAB);
        if (ph == 0) { if (PHM & 1) REPS(1) { SETLANE(); phase_prologue(F); } }
        else if (ph == 1) { if (PHM & 4) REPS(4) { SETLANE(); phase_norm0(F); } }
        else if (ph == 2 + 6 * DEPTH) { if (PHM & 2) REPS(2) { SETLANE(); phase_final_norm(F); } }
        else {
            const int l = (ph - 2) / 6, sub = (ph - 2) - 6 * l; const bool last = (l == DEPTH - 1); const float* mods_l = mods + (size_t)l * 9 * 6144;
            const int Mx = last ? TL : MALL;
            if (sub == 0) { if (PHM & 8) REPS(8) { SETLANE(); pg8::Gemm g{XN, (const bf16_t*)(F.ws + WS_WIN) + (size_t)l * ZP * D, MALL, ZP, D, D}; pg8::StaticOrder S; S.init(MALL, ZP, F.G, F.bx);
                pg8::EpiZ E{Z, ssq, ssqx, shw + (size_t)l * SHW_L}; pg8::gemm_phase<pg8::EpiZ, pg8::StaticOrder, true, true, 1024, 1024>(F.lds, g, S, E, F.tid); } }
            else if (sub == 1) {
                if (PHM & 16) REPS(16) { SETLANE(); pg8::Gemm g{Z, (const bf16_t*)(F.ws + WS_WUQ) + (size_t)l * 768 * 384, Mx, 768, 384, ZP}; pg8::StaticOrder S; S.init(Mx, 768, F.G, F.bx);
                  pg8::EpiQ E{Qb, ssq, rope}; pg8::gemm_phase<pg8::EpiQ, pg8::StaticOrder, true, true, 384, 1792>(F.lds, g, S, E, F.tid); }
                if (PHM & 32) REPS(32) { SETLANE(); pg8::Gemm g{Z + 384, (const bf16_t*)(F.ws + WS_WUKV) + (size_t)l * 1024 * 256, MALL, 1024, 256, ZP}; pg8::StaticOrder S; S.init(MALL, 1024, F.G, (F.bx - 24 + F.G) % F.G);
                  pg8::EpiKV E{(bf16_t*)(F.ws + WS_KN), (bf16_t*)(F.ws + WS_V), ssq}; pg8::gemm_phase<pg8::EpiKV, pg8::StaticOrder, true, true, 256, 1792>(F.lds, g, S, E, F.tid); }
                if (PHM & 64) REPS(64) { SETLANE(); phase_conv(F, l, Mx, 56); }
                if (PHM & 128) REPS(128) { SETLANE(); phase_sgu(F, l, Mx, 88); }
                if (PHM & 256) REPS(256) { SETLANE(); phase_krope(F); }
            }
            else if (sub == 2) { if (PHM & 512) REPS(512) { SETLANE(); phase_attn(F, !last); } }
            else if (sub == 3) { if (PHM & 1024) REPS(1024) { SETLANE(); pg8::Gemm g{Y, (const bf16_t*)(F.ws + WS_WOUT) + (size_t)l * D * D, Mx, D, D, D}; pg8::StaticOrder S; S.init(Mx, D, F.G, F.bx);
                pg8::EpiRes E{(bf16_t*)(F.ws + WS_XB), mods_l + 2048, XN, ssqx, stab + ((size_t)l * 2 + 1) * 9 * 1024};
                pg8::gemm_phase<pg8::EpiRes, pg8::StaticOrder, true, true, 1024, 1024>(F.lds, g, S, E, F.tid); } }
            else if (sub == 4) { if (PHM & 4096) REPS(4096) { SETLANE();
                unsigned* cnt = (unsigned*)F.ws + 3600 + 64 * l;
                const bf16_t* W1 = (const bf16_t*)(F.ws + WS_W1) + (size_t)l * DFF * D;
                if (!last) {
                    pg8::Gemm g{XN + (size_t)TL * D, W1, TC, DFF, D, D}; pg8::CountingOrder S; S.S.init(TC, DFF, F.G, F.bx); S.cnt = cnt;
                    pg8::EpiFF1 E{H, ssqx, shw + (size_t)l * SHW_L + 9 * SHW_IN, TL}; pg8::gemm_phase<pg8::EpiFF1, pg8::CountingOrder, true, true, 1024, 1024>(F.lds, g, S, E, F.tid); }
                {
                    pg8::Gemm g{XN, W1, TL, DFF, D, D}; pg8::StaticOrder S; S.init(TL, DFF, F.G, F.bx, true);
                    pg8::EpiFF1 E{H, ssqx, shw + (size_t)l * SHW_L + 9 * SHW_IN, 0}; pg8::gemm_phase<pg8::EpiFF1, pg8::StaticOrder, true, true, 1024, 1024>(F.lds, g, S, E, F.tid); }
                if (!last) {
                    const int q = F.bx - 128; const bool mine = q >= 0 && q < 128; const int ks = q >> 5, t = q & 31;
                    if (mine) {
                        if (F.tid == 0) { unsigned sp = 0; while (__hip_atomic_load(cnt, __ATOMIC_RELAXED, __HIP_MEMORY_SCOPE_AGENT) < 1024u) { __builtin_amdgcn_s_sleep(2); if (++sp > (1u << 22)) break; } }
                        __syncthreads(); __builtin_amdgcn_fence(__ATOMIC_ACQUIRE, "agent"); asm volatile("s_waitcnt vmcnt(0)" ::: "memory"); }
                    pg8::Gemm g{H + (size_t)TL * DFF + (mine ? ks : 0) * 1024, (const bf16_t*)(F.ws + WS_W2) + (size_t)l * D * DFF + (mine ? ks : 0) * 1024, TC, D, 1024, DFF};
                    pg8::OneUnit S{t >> 2, t & 3, mine};
                    pg8::EpiPart E{(float*)(F.ws + WS_PART) + (size_t)(mine ? ks : 0) * TC * D}; pg8::gemm_phase<pg8::EpiPart, pg8::OneUnit, true, true, 1024, 4096, 4096>(F.lds, g, S, E, F.tid); }
                } }
            else { if (PHM & 8192) REPS(8192) { SETLANE();
                if (!last) phase_ctx_finish(F, mods_l + 5120 + 8 * 6144, stab + ((size_t)(l + 1) * 2 + 0) * 9 * 1024 + 8 * 1024);
                pg8::Gemm g{H, (const bf16_t*)(F.ws + WS_W2) + (size_t)l * D * DFF, TL, D, DFF, DFF}; pg8::StaticOrder S; S.init(TL, D, F.G, F.bx, false);
                pg8::EpiRes E{(bf16_t*)(F.ws + WS_XB), mods_l + 5120, XN, ssqx, last ? (const float*)nullptr : stab + ((size_t)(l + 1) * 2 + 0) * 9 * 1024};
                pg8::gemm_phase<pg8::EpiRes, pg8::StaticOrder, true, true, 4096, 4096>(F.lds, g, S, E, F.tid); } }
        }
        if (ph + 1 < ph_hi_u) { if (ph == ph_lo_u) cg::this_grid().sync(); else xcd_barrier(gbar); }
    }
}

constexpr int NPHASES = 3 + 6 * DEPTH;
extern "C" void kernel_launch(void* const* d_in, const int* in_sizes, int n_in, void* d_out, int out_size, void* d_ws, size_t ws_size, hipStream_t stream) {
    static int grid = 0;
    if (grid == 0) {
        if (n_in != 25 || out_size != TL * D || ws_size < WS_END2) { fprintf(stderr, "kernel_launch: unexpected shapes: n_in %d out %d ws %zu (need %zu)\n", n_in, out_size, ws_size, (size_t)WS_END2); grid = -1; return; }
        int dev = 0, cus = 0, per_cu = 0;
        hipGetDevice(&dev); hipDeviceGetAttribute(&cus, hipDeviceAttributeMultiprocessorCount, dev);
        if (hipFuncSetAttribute((const void*)mega_fwd, hipFuncAttributeMaxDynamicSharedMemorySize, LDS_BYTES) != hipSuccess) { fprintf(stderr, "kernel_launch: hipFuncSetAttribute failed\n"); grid = -1; return; }
        if (hipOccupancyMaxActiveBlocksPerMultiprocessor(&per_cu, (const void*)mega_fwd, NTHREADS, LDS_BYTES) != hipSuccess || per_cu < 1) { fprintf(stderr, "kernel_launch: occupancy query says %d\n", per_cu); per_cu = 1; }
        (void)hipGetLastError();
        grid = cus * 1;
    }
    if (grid < 0) return;
    Args a{};
    for (int i = 0; i < 25; ++i) a.in[i] = (const float*)d_in[i];
    a.out = (float*)d_out; a.ws = (unsigned char*)d_ws;
#if ONE_LAUNCH
    if (hipMemsetAsync(d_ws, 0, 16384, stream) != hipSuccess) { fprintf(stderr, "kernel_launch: memset of barrier words failed\n"); return; }
    a.ph_lo = 0; a.ph_hi = NPHASES;
    void* kargs[] = {&a};
    hipError_t e = hipLaunchCooperativeKernel((const void*)mega_fwd, dim3(grid), dim3(NTHREADS), kargs, LDS_BYTES, stream);
    if (e != hipSuccess) fprintf(stderr, "cooperative launch failed: %s (grid %d)\n", hipGetErrorString(e), grid);
#else
    for (int ph = 0; ph < NPHASES; ++ph) { a.ph_lo = ph; a.ph_hi = ph + 1; hipLaunchKernelGGL(mega_fwd, dim3(grid), dim3(NTHREADS), LDS_BYTES, stream, a); }
#endif
}
```
